# Optimizing an MI355X kernel written in HIP

```python
import math
import jax, jax.numpy as jnp
from jax import lax
import numpy as np

D_MODEL = 2048
BATCH = 16
SEQ = 2048
DEPTH = 2

EPS = 1e-6
NEG_INF = -1e30
ROPE_BASE = 10000.0

RET_HEADS = 8
RET_DIM = 128
RET_WIDTH = RET_HEADS * RET_DIM
RET_CHUNK = 128
LRU_WIDTH = D_MODEL // 2
LRU_BLOCKS = 8
LRU_BLOCK_DIM = LRU_WIDTH // LRU_BLOCKS
LRU_CONV = 4
LRU_C = 8.0
E_SPLITS = (RET_WIDTH, 2 * RET_WIDTH, 3 * RET_WIDTH, 4 * RET_WIDTH, 4 * RET_WIDTH + LRU_WIDTH)
E_IN = 4 * RET_WIDTH + 2 * LRU_WIDTH
E_MIX = RET_WIDTH + LRU_WIDTH

ATT_HEADS = 16
ATT_DIM = D_MODEL // ATT_HEADS
KV_HEADS = 4
IDX_HEADS = 16
IDX_DIM = 64
TOPK_MAX = 256
Q_BLOCK = 128
O_Q = ATT_HEADS * ATT_DIM
O_KV = KV_HEADS * ATT_DIM
O_QI = IDX_HEADS * IDX_DIM
O_SPLITS = (O_Q, O_Q + O_KV, O_Q + 2 * O_KV, O_Q + 2 * O_KV + O_QI, O_Q + 2 * O_KV + O_QI + IDX_DIM)
O_IN = O_SPLITS[-1] + IDX_HEADS

REL_BUCKETS = 32
REL_MAX_DIST = 128

D_FF = 5632
FFN_CONV = 3

N_EVEN = (DEPTH + 1) // 2
N_ODD = DEPTH // 2

kernel_name = 'hybrid_retention_rglru_dsa_convffn'


def rmsnorm(x, g):
    xf = x.astype(jnp.float32)
    y = xf * lax.rsqrt(jnp.mean(xf * xf, axis=-1, keepdims=True) + EPS)
    return (y * g.astype(jnp.float32)).astype(x.dtype)


def causal_dwconv(x, w, b):
    width = w.shape[0]
    S = x.shape[1]
    xp = jnp.pad(x, ((0, 0), (width - 1, 0), (0, 0)))
    out = b
    for j in range(width):
        out = out + w[j] * xp[:, j:j + S]
    return out


def rotary(x, pos):
    half = x.shape[-1] // 2
    freqs = ROPE_BASE ** (-jnp.arange(half, dtype=jnp.float32) / half)
    ang = pos.astype(jnp.float32)[:, None] * freqs[None, :]
    cos = jnp.cos(ang)[None, :, None, :]
    sin = jnp.sin(ang)[None, :, None, :]
    x1, x2 = x[..., :half], x[..., half:]
    return jnp.concatenate([x1 * cos - x2 * sin, x2 * cos + x1 * sin], axis=-1)


def retention_chunkwise(q, k, v):
    B, S, H, Dh = q.shape
    C = RET_CHUNK
    NC = S // C
    log_g = jnp.log1p(-jnp.exp2(-5.0 - jnp.arange(H, dtype=jnp.float32)))
    pos = jnp.arange(C, dtype=jnp.float32)
    diff = pos[:, None] - pos[None, :]
    inner_decay = jnp.where(diff[None] >= 0, jnp.exp(jnp.maximum(diff, 0.0)[None] * log_g[:, None, None]), 0.0)
    q_decay = jnp.exp((pos[None, :] + 1.0) * log_g[:, None])
    k_decay = jnp.exp((C - 1.0 - pos[None, :]) * log_g[:, None])
    chunk_decay = jnp.exp(C * log_g)
    qc = q.reshape(B, NC, C, H, Dh)
    kc = k.reshape(B, NC, C, H, Dh)
    vc = v.reshape(B, NC, C, H, Dh)
    scores = jnp.einsum('bnihd,bnjhd->bnhij', qc, kc) * inner_decay
    y_inner = jnp.einsum('bnhij,bnjhd->bnihd', scores, vc)
    kv = jnp.einsum('bnjhd,hj,bnjhe->bnhde', kc, k_decay, vc)

    def step(state, kv_n):
        return chunk_decay[None, :, None, None] * state + kv_n, state

    _, prev = lax.scan(step, jnp.zeros((B, H, Dh, Dh), jnp.float32), jnp.moveaxis(kv, 1, 0))
    prev = jnp.moveaxis(prev, 0, 1)
    y_cross = jnp.einsum('bnihd,hi,bnhde->bnihe', qc, q_decay, prev)
    return (y_inner + y_cross).reshape(B, S, H, Dh)


def rg_lru(x, wa, ba, wx, bx, lam):
    B, S, W = x.shape
    xf = x.astype(jnp.float32)
    xb = xf.reshape(B, S, LRU_BLOCKS, LRU_BLOCK_DIM)
    r = jax.nn.sigmoid(jnp.einsum('bsnd,nde->bsne', xb, wa).reshape(B, S, W) + ba)
    i = jax.nn.sigmoid(jnp.einsum('bsnd,nde->bsne', xb, wx).reshape(B, S, W) + bx)
    log_a = -LRU_C * r * jax.nn.softplus(-lam)
    a = jnp.exp(log_a)
    mult = jnp.sqrt(jnp.maximum(-jnp.expm1(2.0 * log_a), 0.0))
    b = mult * (i * xf)

    def combine(c1, c2):
        a1, b1 = c1
        a2, b2 = c2
        return a1 * a2, a2 * b1 + b2

    _, h = lax.associative_scan(combine, (a, b), axis=1)
    return h


def hybrid_even_mixer(h, w_in, ret_gn, conv_w, conv_b, wa, ba, wx, bx, lam, w_out):
    B, S, _ = h.shape
    proj = h @ w_in
    q, k, v, g, xr, yr = jnp.split(proj, E_SPLITS, axis=-1)
    pos = jnp.arange(S)
    q = rotary(q.astype(jnp.float32).reshape(B, S, RET_HEADS, RET_DIM), pos)
    k = rotary(k.astype(jnp.float32).reshape(B, S, RET_HEADS, RET_DIM), pos) * (RET_DIM ** -0.5)
    v = v.astype(jnp.float32).reshape(B, S, RET_HEADS, RET_DIM)
    y = retention_chunkwise(q, k, v)
    y = y * lax.rsqrt(jnp.mean(y * y, axis=-1, keepdims=True) + EPS)
    y = y.reshape(B, S, RET_WIDTH) * ret_gn.astype(jnp.float32)
    ret_out = y * jax.nn.silu(g.astype(jnp.float32))
    xc = causal_dwconv(xr, conv_w, conv_b)
    lru_out = rg_lru(xc, wa, ba, wx, bx, lam) * jax.nn.gelu(yr.astype(jnp.float32))
    mixed = jnp.concatenate([ret_out, lru_out], axis=-1).astype(h.dtype)
    return mixed @ w_out


def t5_bucket(rel):
    n = jnp.maximum(rel, 0)
    max_exact = REL_BUCKETS // 2
    nf = jnp.maximum(n, max_exact).astype(jnp.float32)
    large = max_exact + (jnp.log(nf / max_exact) / math.log(REL_MAX_DIST / max_exact)
                         * (REL_BUCKETS - max_exact)).astype(jnp.int32)
    large = jnp.minimum(large, REL_BUCKETS - 1)
    return jnp.where(n < max_exact, n, large)


def dsa_attention(h, w_in, w_out, rel_bias):
    B, S, _ = h.shape
    topk = min(TOPK_MAX, S // 4)
    nb = S // Q_BLOCK
    G = ATT_HEADS // KV_HEADS
    proj = h @ w_in
    q, k, v, qi, ki, wi = jnp.split(proj, O_SPLITS, axis=-1)
    q = q.reshape(B, S, KV_HEADS, G, ATT_DIM)
    k = k.reshape(B, S, KV_HEADS, ATT_DIM)
    v = v.reshape(B, S, KV_HEADS, ATT_DIM)
    qi = qi.reshape(B, S, IDX_HEADS, IDX_DIM)
    wi = wi * (IDX_HEADS ** -0.5 * IDX_DIM ** -0.5)
    kpos = jnp.arange(S)

    def to_blocks(t):
        return jnp.moveaxis(t.reshape((B, nb, Q_BLOCK) + t.shape[2:]), 1, 0)

    def attend_block(blk):
        qb, qib, wib, qpos = blk
        s = jax.nn.relu(jnp.einsum('bqhd,bsd->bqhs', qib, ki).astype(jnp.float32))
        score = jnp.einsum('bqhs,bqh->bqs', s, wib.astype(jnp.float32))
        score = jnp.where(kpos[None, None, :] <= qpos[None, :, None], score, NEG_INF)
        _, idx = lax.top_k(score, topk)
        kg = jax.vmap(lambda kk, ii: kk[ii])(k, idx)
        vg = jax.vmap(lambda vv, ii: vv[ii])(v, idx)
        logits = jnp.einsum('bqkgd,bqjkd->bqkgj', qb, kg).astype(jnp.float32) * (ATT_DIM ** -0.5)
        bias = rel_bias[t5_bucket(qpos[None, :, None] - idx)]
        bias = jnp.transpose(bias.reshape(B, Q_BLOCK, topk, KV_HEADS, G), (0, 1, 3, 4, 2))
        valid = (idx <= qpos[None, :, None])[:, :, None, None, :]
        logits = jnp.where(valid, logits + bias.astype(jnp.float32), NEG_INF)
        p = jax.nn.softmax(logits, axis=-1)
        out = jnp.einsum('bqkgj,bqjkd->bqkgd', p.astype(vg.dtype), vg)
        return out.reshape(B, Q_BLOCK, O_Q)

    qpos_blocks = jnp.arange(S).reshape(nb, Q_BLOCK)
    out = lax.map(attend_block, (to_blocks(q), to_blocks(qi), to_blocks(wi), qpos_blocks))
    out = jnp.moveaxis(out, 0, 1).reshape(B, S, O_Q)
    return out @ w_out


def conv_ffn(h, w_gu, conv_w, conv_b, w_down):
    gu = h @ w_gu
    g, u = jnp.split(gu, [D_FF], axis=-1)
    g = causal_dwconv(g, conv_w, conv_b)
    return (jax.nn.silu(g) * u) @ w_down


def setup_inputs(seed: int = 0) -> dict:
    key = jax.random.key(seed)
    ks = jax.random.split(key, 21)
    f32 = jnp.float32

    def nrm(k, shape, fan_in):
        return jax.random.normal(k, shape, f32) * (fan_in ** -0.5)

    def gain(k, shape):
        return 1.0 + 0.02 * jax.random.normal(k, shape, f32)

    def small(k, shape):
        return 0.02 * jax.random.normal(k, shape, f32)

    u = jax.random.uniform(ks[11], (N_EVEN, LRU_WIDTH), f32, 0.9, 0.999)
    s = u ** (1.0 / LRU_C)
    e_lambda = jnp.log(s) - jnp.log1p(-s)
    return {
        'x': jax.random.normal(ks[0], (BATCH, SEQ, D_MODEL), f32),
        'norm_mix': gain(ks[1], (DEPTH, D_MODEL)),
        'norm_ffn': gain(ks[2], (DEPTH, D_MODEL)),
        'e_w_in': nrm(ks[3], (N_EVEN, D_MODEL, E_IN), D_MODEL),
        'e_ret_gn': gain(ks[4], (N_EVEN, RET_WIDTH)),
        'e_conv_w': nrm(ks[5], (N_EVEN, LRU_CONV, LRU_WIDTH), LRU_CONV),
        'e_conv_b': small(ks[6], (N_EVEN, LRU_WIDTH)),
        'e_gate_a_w': nrm(ks[7], (N_EVEN, LRU_BLOCKS, LRU_BLOCK_DIM, LRU_BLOCK_DIM), LRU_BLOCK_DIM),
        'e_gate_a_b': small(ks[8], (N_EVEN, LRU_WIDTH)),
        'e_gate_x_w': nrm(ks[9], (N_EVEN, LRU_BLOCKS, LRU_BLOCK_DIM, LRU_BLOCK_DIM), LRU_BLOCK_DIM),
        'e_gate_x_b': small(ks[10], (N_EVEN, LRU_WIDTH)),
        'e_lambda': e_lambda,
        'e_w_out': nrm(ks[12], (N_EVEN, E_MIX, D_MODEL), E_MIX),
        'o_w_in': nrm(ks[13], (N_ODD, D_MODEL, O_IN), D_MODEL),
        'o_w_out': nrm(ks[14], (N_ODD, O_Q, D_MODEL), O_Q),
        'rel_bias': 0.5 * jax.random.normal(ks[15], (REL_BUCKETS, ATT_HEADS), f32),
        'ffn_w_gu': nrm(ks[16], (DEPTH, D_MODEL, 2 * D_FF), D_MODEL),
        'ffn_conv_w': nrm(ks[17], (DEPTH, FFN_CONV, D_FF), FFN_CONV),
        'ffn_conv_b': small(ks[18], (DEPTH, D_FF)),
        'ffn_w_down': nrm(ks[19], (DEPTH, D_FF, D_MODEL), D_FF),
        'final_norm': gain(ks[20], (D_MODEL,)),
    }


def reference(x, norm_mix, norm_ffn, e_w_in, e_ret_gn, e_conv_w, e_conv_b, e_gate_a_w, e_gate_a_b,
              e_gate_x_w, e_gate_x_b, e_lambda, e_w_out, o_w_in, o_w_out, rel_bias,
              ffn_w_gu, ffn_conv_w, ffn_conv_b, ffn_w_down, final_norm):
    for layer in range(DEPTH):
        h = rmsnorm(x, norm_mix[layer])
        if layer % 2 == 0:
            e = layer // 2
            mix = hybrid_even_mixer(h, e_w_in[e], e_ret_gn[e], e_conv_w[e], e_conv_b[e],
                                    e_gate_a_w[e], e_gate_a_b[e], e_gate_x_w[e], e_gate_x_b[e],
                                    e_lambda[e], e_w_out[e])
        else:
            o = layer // 2
            mix = dsa_attention(h, o_w_in[o], o_w_out[o], rel_bias)
        x = x + mix.astype(x.dtype)
        h = rmsnorm(x, norm_ffn[layer])
        x = x + conv_ffn(h, ffn_w_gu[layer], ffn_conv_w[layer], ffn_conv_b[layer], ffn_w_down[layer]).astype(x.dtype)
    return rmsnorm(x, final_norm)
```

```cpp
#include <hip/hip_runtime.h>
#include <cstdio>
#include <cstdint>
#define ONE_LAUNCH 1
namespace pg8 {
#define PG8_LAS __attribute__((address_space(3)))
typedef unsigned short bf16_t;
typedef short bf16x8 __attribute__((ext_vector_type(8)));
typedef float f32x4 __attribute__((ext_vector_type(4)));
typedef unsigned u32x4 __attribute__((ext_vector_type(4)));
constexpr int BM = 256, BK = 64, HALF = 128, HTB = HALF * BK * 2  , STAGE_BYTES = 8 * HTB, NXCD = 8, WGM = 8;

__host__ __device__ __forceinline__ int lds_byte(int r, int c) { const int st = (r >> 4) * 2 + (c >> 5), rr = r & 15, cc = c & 31, ob = rr * 64 + cc * 2; return st * 1024 + (ob ^ (((ob >> 9) & 1) << 5)); }
__host__ __device__ __forceinline__ void stage_rc(int b, int& R, int& C) { const int st = b / 1024, sb = b % 1024, swz = sb ^ (((sb >> 9) & 1) << 5); R = (st >> 1) * 16 + swz / 64; C = (st & 1) * 32 + (swz % 64) / 2; }
__host__ __device__ __forceinline__ int perm32(int rho) { const int n = rho >> 4, i = rho & 15; return 8 * (i >> 2) + 4 * n + (i & 3); }

struct Unit { int pm, pn; };
struct Gemm { const bf16_t* A; const bf16_t* Bt; int M, N, K; };

struct StaticOrder {
    int nM, nN, nwg, G, c;
    __host__ __device__ void init(int M, int N, int G_, int c_) { nM = M / BM; nN = N / BM; nwg = nM * nN; G = G_; c = c_; }
    __host__ __device__ bool next(int i, Unit& u) const {
        const long L = (long)i * G + c; if (L >= nwg) return false;
        int wgid = (int)L; { const int q = nwg / NXCD, r = nwg % NXCD, xcd = wgid % NXCD, off = wgid / NXCD; wgid = (xcd < r ? xcd * (q + 1) : r * (q + 1) + (xcd - r) * q) + off; }
        const int nig = WGM * nN, gid = wgid / nig, fm = gid * WGM, gsz = (nM - fm) < WGM ? (nM - fm) : WGM;
        u.pm = fm + ((wgid % nig) % gsz); u.pn = (wgid % nig) / gsz; return true;
    }
    __device__ __forceinline__ void a_ready(const Unit&) const {}
    __device__ __forceinline__ void done(const Unit&) const {}
};
__device__ __forceinline__ unsigned cvt_pk_bf16(float lo, float hi) { unsigned r; asm volatile("v_cvt_pk_bf16_f32 %0, %1, %2" : "=v"(r) : "v"(lo), "v"(hi)); return r; }
typedef float f32x2 __attribute__((ext_vector_type(2)));
template <class E_> struct RowsLds { static constexpr bool value = false; };
template <class Epi, class Sched, bool ALIGN_EPI = false, bool SP2 = false, bool A_BLK = false, bool B_BLK = false>
__device__ __forceinline__ void gemm_phase(PG8_LAS unsigned char* lds, const Gemm g, const Sched& S, const Epi& E) {
    const int tid = threadIdx.x, wid = __builtin_amdgcn_readfirstlane(tid >> 6), lane = tid & 63, wr = wid >> 2, wc = wid & 3, fr = lane & 15, fq = lane >> 4;
    const int K = g.K, nt = K / BK;
    unsigned voffA[2], voffB[2];
#pragma unroll
    for (int i = 0; i < 2; ++i) { int R, C; stage_rc(tid * 16 + i * 8192, R, C); const int Rb = Epi::PERM ? ((R & ~31) + perm32(R & 31)) : R;
        voffA[i] = A_BLK ? (unsigned)((((R >> 4) * (K >> 5) + (C >> 5)) * 512 + (R & 15) * 32 + (C & 31)) * 2) : (unsigned)(R * K + C) * 2u;
        voffB[i] = B_BLK ? (unsigned)((((R >> 4) * (K >> 5) + (C >> 5)) * 512 + (R & 15) * 32 + (C & 31)) * 2) : (unsigned)(Rb * K + C) * 2u; }
    const size_t kstep = (size_t)(BK * 2), kstepA = A_BLK ? (size_t)2048 : kstep, kstepB = B_BLK ? (size_t)2048 : kstep;
    const size_t hstep = (size_t)HALF * K * 2;
    const size_t tstep = 2 * hstep;
    const unsigned ldsw = (unsigned)wid * 1024u;
    const int aoff = lds_byte(wr * 64 + fr, fq * 8), boff = lds_byte(wc * 32 + fr, fq * 8);
#define PG8_SA(b, h) (((b) * 2 + (h)) * HTB)
#define PG8_SB(b, h) ((4 + (b) * 2 + (h)) * HTB)
#define PG8_STAGE(bufoff, gbase, voff) do { _Pragma("unroll") for (int _i = 0; _i < 2; ++_i) \
        __builtin_amdgcn_global_load_lds((const unsigned*)((const char*)(gbase) + (voff)[_i]), (PG8_LAS unsigned*)(lds + (bufoff) + ldsw + _i * 8192), 16, 0, 0); } while (0)
#define PG8_LDA(dst, b, h) do { _Pragma("unroll") for (int m = 0; m < 4; ++m) _Pragma("unroll") for (int k = 0; k < 2; ++k) dst[m][k] = *(const PG8_LAS bf16x8*)(lds + PG8_SA(b, h) + aoff + m * 2048 + k * 1024); } while (0)
#define PG8_LDB(dst, b, h) do { _Pragma("unroll") for (int n = 0; n < 2; ++n) _Pragma("unroll") for (int k = 0; k < 2; ++k) dst[n][k] = *(const PG8_LAS bf16x8*)(lds + PG8_SB(b, h) + boff + n * 2048 + k * 1024); } while (0)
#define PG8_MMA(ai, bj, At, Bt) do { __builtin_amdgcn_s_setprio(1); _Pragma("unroll") for (int m = 0; m < 4; ++m) _Pragma("unroll") for (int n = 0; n < 2; ++n) _Pragma("unroll") for (int k = 0; k < 2; ++k) \
        acc[ai][bj][m][n] = __builtin_amdgcn_mfma_f32_16x16x32_bf16(Bt[n][k], At[m][k], acc[ai][bj][m][n], 0, 0, 0); __builtin_amdgcn_s_setprio(0); } while (0)
#define PG8_WAIT_V(n) asm volatile("s_waitcnt vmcnt(" #n ")" ::: "memory")
#define PG8_WAIT_L(n) asm volatile("s_waitcnt lgkmcnt(" #n ")" ::: "memory")
#define PG8_BAR __builtin_amdgcn_s_barrier()
#define PG8_SCHED __builtin_amdgcn_sched_barrier(0)
    Unit cur, nxt; int ui = 0; int prev_pm = -1;
    if (!S.next(0, cur)) return;
    f32x4 acc[2][2][4][2];
#pragma unroll
    for (int a = 0; a < 2; ++a)
#pragma unroll
        for (int b = 0; b < 2; ++b)
#pragma unroll
            for (int m = 0; m < 4; ++m)
#pragma unroll
                for (int n = 0; n < 2; ++n) acc[a][b][m][n] = (f32x4){0.f, 0.f, 0.f, 0.f};
    bf16x8 At[4][2], B0[2][2], B1[2][2];
    const char* cA = (const char*)g.A + (size_t)cur.pm * tstep; const char* cB = (const char*)g.Bt + (size_t)cur.pn * tstep;
    S.a_ready(cur);
    if constexpr (SP2) {
        PG8_STAGE(PG8_SB(0, 0), cB, voffB); PG8_STAGE(PG8_SB(0, 1), cB + hstep, voffB); PG8_STAGE(PG8_SA(0, 0), cA, voffA); PG8_STAGE(PG8_SA(0, 1), cA + hstep, voffA);
        if (wr == 1) PG8_BAR;
        PG8_WAIT_V(2); PG8_BAR;
        PG8_STAGE(PG8_SB(1, 0), cB + kstepB, voffB); PG8_STAGE(PG8_SA(1, 0), cA + kstepA, voffA); PG8_STAGE(PG8_SB(1, 1), cB + hstep + kstepB, voffB);
        PG8_WAIT_V(6); PG8_BAR;
    } else {
        PG8_STAGE(PG8_SB(0, 0), cB, voffB); PG8_STAGE(PG8_SA(0, 0), cA, voffA); PG8_STAGE(PG8_SB(0, 1), cB + hstep, voffB); PG8_STAGE(PG8_SA(0, 1), cA + hstep, voffA);
        if (wr == 1) PG8_BAR;
        PG8_WAIT_V(4); PG8_BAR;
        PG8_STAGE(PG8_SB(1, 0), cB + kstepB, voffB); PG8_STAGE(PG8_SA(1, 0), cA + kstepA, voffA); PG8_STAGE(PG8_SB(1, 1), cB + hstep + kstepB, voffB);
        PG8_WAIT_V(6); PG8_BAR;
    }
    for (;;) {
        const bool has_next = S.next(ui + 1, nxt);
        const char* nA = has_next ? (const char*)g.A + (size_t)nxt.pm * tstep : cA; const char* nB = has_next ? (const char*)g.Bt + (size_t)nxt.pn * tstep : cB;
        for (int t = 0; t < nt; t += 2) {
            const bool last = (t == nt - 2);
            const char* a1 = cA + (size_t)(t + 1) * kstepA;
            const char* a2 = last ? nA : cA + (size_t)(t + 2) * kstepA; const char* b2 = last ? nB : cB + (size_t)(t + 2) * kstepB;
            const char* a3 = a2 + kstepA; const char* b3 = b2 + kstepB;
            if (last && has_next) S.a_ready(nxt);
            if constexpr (SP2) {
            PG8_LDB(B0, 0, 0); PG8_LDB(B1, 0, 1); PG8_SCHED; PG8_LDA(At, 0, 0); PG8_STAGE(PG8_SA(1, 1), a1 + hstep, voffA);
            PG8_WAIT_V(8); PG8_WAIT_L(0); PG8_BAR; PG8_MMA(0, 0, At, B0); PG8_MMA(0, 1, At, B1); PG8_BAR; PG8_SCHED;
            PG8_LDA(At, 0, 1); PG8_STAGE(PG8_SB(0, 0), b2, voffB); PG8_STAGE(PG8_SB(0, 1), b2 + hstep, voffB); PG8_STAGE(PG8_SA(0, 0), a2, voffA);
            PG8_WAIT_V(8); PG8_WAIT_L(0); PG8_BAR; PG8_MMA(1, 0, At, B0); PG8_MMA(1, 1, At, B1); PG8_BAR; PG8_SCHED;
            PG8_LDB(B0, 1, 0); PG8_LDB(B1, 1, 1); PG8_SCHED; PG8_LDA(At, 1, 0); PG8_STAGE(PG8_SA(0, 1), a2 + hstep, voffA);
            PG8_WAIT_V(8); PG8_WAIT_L(0); PG8_BAR; PG8_MMA(0, 0, At, B0); PG8_MMA(0, 1, At, B1); PG8_BAR; PG8_SCHED;
            PG8_LDA(At, 1, 1); PG8_STAGE(PG8_SB(1, 0), b3, voffB); PG8_STAGE(PG8_SB(1, 1), b3 + hstep, voffB); PG8_STAGE(PG8_SA(1, 0), a3, voffA);
            PG8_WAIT_V(8); PG8_WAIT_L(0); PG8_BAR; PG8_MMA(1, 0, At, B0); PG8_MMA(1, 1, At, B1); PG8_BAR; PG8_SCHED;
            } else {
            PG8_LDB(B0, 0, 0); PG8_SCHED; PG8_LDA(At, 0, 0); PG8_STAGE(PG8_SA(1, 1), a1 + hstep, voffA);
            PG8_WAIT_L(8); PG8_BAR; PG8_WAIT_L(0); PG8_MMA(0, 0, At, B0); PG8_BAR; PG8_SCHED;
            PG8_LDB(B1, 0, 1); PG8_STAGE(PG8_SB(0, 0), b2, voffB);
            PG8_BAR; PG8_WAIT_L(0); PG8_MMA(0, 1, At, B1); PG8_BAR;
            PG8_LDA(At, 0, 1); PG8_STAGE(PG8_SA(0, 0), a2, voffA);
            PG8_BAR; PG8_WAIT_L(0); PG8_MMA(1, 0, At, B0); PG8_BAR; PG8_SCHED;
            PG8_STAGE(PG8_SB(0, 1), b2 + hstep, voffB);
            PG8_WAIT_V(6); PG8_BAR; PG8_MMA(1, 1, At, B1); PG8_BAR;
            PG8_LDB(B0, 1, 0); PG8_SCHED; PG8_LDA(At, 1, 0); PG8_STAGE(PG8_SA(0, 1), a2 + hstep, voffA);
            PG8_WAIT_L(8); PG8_BAR; PG8_WAIT_L(0); PG8_MMA(0, 0, At, B0); PG8_BAR; PG8_SCHED;
            PG8_LDB(B1, 1, 1); PG8_STAGE(PG8_SB(1, 0), b3, voffB);
            PG8_BAR; PG8_WAIT_L(0); PG8_MMA(0, 1, At, B1); PG8_BAR;
            PG8_LDA(At, 1, 1); PG8_STAGE(PG8_SA(1, 0), a3, voffA);
            PG8_BAR; PG8_WAIT_L(0); PG8_MMA(1, 0, At, B0); PG8_BAR; PG8_SCHED;
            PG8_STAGE(PG8_SB(1, 1), b3 + hstep, voffB);
            PG8_WAIT_V(6); PG8_BAR; PG8_MMA(1, 1, At, B1); PG8_BAR;
            }
        }
        if constexpr (ALIGN_EPI) { if (wr == 0) PG8_BAR; }
        if constexpr (RowsLds<Epi>::value) { static_assert(ALIGN_EPI, "row-scale tile: all eight waves must be in the epilogue together");
            if (cur.pm != prev_pm) { E.load_rows(cur.pm, tid, lds); prev_pm = cur.pm; } }
        if constexpr (!Epi::AFTER_DRAIN) { E(acc, cur, wr, wc, fr, fq); S.done(cur); }
        if (!has_next) break;
#pragma unroll
        for (int a = 0; a < 2; ++a)
#pragma unroll
            for (int b = 0; b < 2; ++b)
#pragma unroll
                for (int m = 0; m < 4; ++m)
#pragma unroll
                    for (int n = 0; n < 2; ++n) acc[a][b][m][n] = (f32x4){0.f, 0.f, 0.f, 0.f};
        cur = nxt; cA = nA; cB = nB; ++ui;
        if constexpr (ALIGN_EPI) { if (wr == 1) PG8_BAR; }
    }
    PG8_WAIT_V(0);
    if constexpr (!ALIGN_EPI) { if (wr == 0) PG8_BAR; }
    PG8_BAR;
    if constexpr (Epi::AFTER_DRAIN) { E.fused(acc, cur, wr, wc, fr, fq, lds, wid, lane); S.done(cur); }
#undef PG8_SA
#undef PG8_SB
#undef PG8_STAGE
#undef PG8_LDA
#undef PG8_LDB
#undef PG8_MMA
#undef PG8_WAIT_V
#undef PG8_WAIT_L
#undef PG8_BAR
#undef PG8_SCHED
}
}
#define LAS __attribute__((address_space(3)))
#define XB_TMO      128
#define XB_XCNT(j)  (256  + 64 * (j))
#define XB_XSUB(j)  (1280 + 64 * (j))
#define XB_XGEN(j)  (2304 + 64 * (j))
#define XB_TOP      3328
#define XB_TOPGEN   3392
#define XCD_BAR_WORDS 3456
#define XB_SPIN_CAP (1u << 18)

__device__ __forceinline__ unsigned xb_ld(unsigned* p)              { return __hip_atomic_load(p, __ATOMIC_RELAXED, __HIP_MEMORY_SCOPE_AGENT); }
__device__ __forceinline__ unsigned xb_add(unsigned* p, unsigned v) { return __hip_atomic_fetch_add(p, v, __ATOMIC_RELAXED, __HIP_MEMORY_SCOPE_AGENT); }
__device__ __forceinline__ unsigned xb_xcc_id() { return (unsigned)__builtin_amdgcn_s_getreg((3 << 11) | 20) & 0xFu; }
#define XB_SPIN(cond, bar) do { unsigned _sp = 0; while (cond) { __builtin_amdgcn_s_sleep(1); \
    if ((++_sp & 255u) == 0u) { if (xb_ld(&(bar)[XB_TMO])) break; if (_sp > XB_SPIN_CAP) { atomicAdd(&(bar)[XB_TMO], 1u); break; } } } } while (0)

struct XcdBarrier {
    unsigned* bar; unsigned x;
    volatile LAS unsigned* st;
};

__device__ __forceinline__ XcdBarrier xcd_barrier_post(unsigned* bar, volatile LAS unsigned* st) {
    XcdBarrier b; b.bar = bar; b.x = xb_xcc_id(); b.st = st;
    if (threadIdx.x == 0) (void)xb_add(&bar[XB_XCNT(b.x)], 1u);
    return b;
}
__device__ __forceinline__ void xcd_barrier_complete(unsigned* bar, unsigned x, unsigned& nloc, unsigned& nx) {
    const unsigned G = gridDim.x * gridDim.y * gridDim.z;
    unsigned sum, cnt, mine, sp = 0u;
    for (;;) {
        sum = 0u; cnt = 0u; mine = 0u;
#pragma unroll
        for (unsigned j = 0; j < 16; ++j) { const unsigned c = xb_ld(&bar[XB_XCNT(j)]); sum += c; cnt += (c > 0u) ? 1u : 0u; mine = (j == x) ? c : mine; }
        if (sum == G) break;
        __builtin_amdgcn_s_sleep(1);
        if ((++sp & 255u) == 0u) { if (xb_ld(&bar[XB_TMO])) break; if (sp > XB_SPIN_CAP) { atomicAdd(&bar[XB_TMO], 1u); break; } }
    }
    nloc = mine > 0u ? mine : 1u; nx = cnt > 0u ? cnt : 1u;
}

__device__ __forceinline__ void xcd_barrier(const XcdBarrier& b) {
    asm volatile("s_waitcnt vmcnt(0)" ::: "memory");
    __syncthreads();
    if (threadIdx.x == 0) {
        unsigned* bar = b.bar;
        __builtin_amdgcn_s_waitcnt(0);
        unsigned nloc = b.st[0], nx = b.st[1];
        if (nloc == 0u) { xcd_barrier_complete(bar, b.x, nloc, nx); b.st[0] = nloc; b.st[1] = nx; }
        const unsigned old = xb_add(&bar[XB_XSUB(b.x)], 1u);
        const unsigned gen = old / nloc;
        if (old + 1u == (gen + 1u) * nloc) {
            __builtin_amdgcn_fence(__ATOMIC_RELEASE, "agent");
            asm volatile("s_waitcnt vmcnt(0)" ::: "memory");
            const unsigned og = xb_add(&bar[XB_TOP], 1u);
            const unsigned tg = og / nx;
            if (og + 1u == (tg + 1u) * nx) xb_add(&bar[XB_TOPGEN], 1u);
            else XB_SPIN(xb_ld(&bar[XB_TOPGEN]) == tg, bar);
            __builtin_amdgcn_fence(__ATOMIC_ACQUIRE, "agent");
            xb_add(&bar[XB_XGEN(b.x)], 1u);
            asm volatile("s_waitcnt vmcnt(0)" ::: "memory");
        } else {
            XB_SPIN(xb_ld(&bar[XB_XGEN(b.x)]) == gen, bar);
            __builtin_amdgcn_fence(__ATOMIC_ACQUIRE, "agent");
            asm volatile("s_waitcnt vmcnt(0)" ::: "memory");
        }
    }
    __syncthreads();
}
#define GAS __attribute__((address_space(1)))
typedef unsigned short bf16;
typedef unsigned v4u __attribute__((ext_vector_type(4)));
typedef unsigned v2u __attribute__((ext_vector_type(2)));
typedef float f32x4 __attribute__((ext_vector_type(4)));
typedef float f32x2 __attribute__((ext_vector_type(2)));

constexpr int NB = 16, SEQ = 2048, DM = 2048, MTOK = NB * SEQ;
constexpr int E_IN = 6144, O_IN = 4176, O_INP = 4352, DFF = 5632, GUW = 2 * DFF;
constexpr int NWAVES = 8, NTHR = 512;
constexpr float EPS = 1e-6f;
constexpr int C0_Q = 0, C0_K = 1024, C0_V = 2048, C0_G = 3072, C0_XR = 4096, C0_YR = 5120;
constexpr int C1_Q = 0, C1_K = 2048, C1_V = 2560, C1_QI = 3072, C1_KI = 4096, C1_WI = 4160;

constexpr size_t MiB = 1u << 20;
constexpr size_t WS_CTL = 0, CTL_ZERO_BYTES = 1 * MiB;
constexpr size_t WS_ROT = 1 * MiB;
constexpr size_t WS_GT = 2 * MiB;
constexpr size_t WS_TB = 2 * MiB + 512 * 1024;
constexpr size_t WS_SP = WS_TB + 8192;
constexpr size_t WS_WIN0 = 4 * MiB, WS_WOUT0 = 28 * MiB, WS_WGU0 = 36 * MiB, WS_WDN0 = 80 * MiB;
constexpr size_t WS_WIN1 = 102 * MiB, WS_WOUT1 = 119 * MiB, WS_WGU1 = 127 * MiB, WS_WDN1 = 171 * MiB;
constexpr size_t WS_H = 194 * MiB;
constexpr size_t WS_PROJ = 322 * MiB;
constexpr size_t WS_SEL = 594 * MiB;
constexpr size_t WS_ACTF = WS_PROJ;
constexpr size_t WS_XB = 706 * MiB;
constexpr size_t WS_SIDEG = 834 * MiB;
constexpr size_t WS_SIDEU = 878 * MiB;
constexpr size_t WS_RSS = 900 * MiB;
constexpr size_t RSW = (size_t)32768 * 32;
constexpr size_t WS_RSTD = 3 * MiB;
constexpr size_t WS_ACT = 706 * MiB;
constexpr size_t WS_END = 920 * MiB;
constexpr int CW_BAR = 4096;

#ifndef FOLD
#define FOLD 1
#endif
#ifndef DEFER_L1
#define DEFER_L1 1
#endif
constexpr int LDS_BYTES = 147456;
constexpr int MISC_OFF = LDS_BYTES - 128;

__device__ __forceinline__ float bf2f(bf16 b) { return __uint_as_float(((unsigned)b) << 16); }
__device__ __forceinline__ unsigned f2bf(float f) { unsigned u = __float_as_uint(f); return (u + 0x7fffu + ((u >> 16) & 1u)) >> 16; }
__device__ __forceinline__ unsigned pk2(float lo, float hi) { return f2bf(lo) | (f2bf(hi) << 16); }
__device__ __forceinline__ float wave_sum(float v) {
#pragma unroll
    for (int o = 1; o < 64; o <<= 1) v += __shfl_xor(v, o);
    return v;
}
__device__ __forceinline__ float wave_max(float v) {
#pragma unroll
    for (int o = 1; o < 64; o <<= 1) v = fmaxf(v, __shfl_xor(v, o));
    return v;
}
__device__ __forceinline__ int wave_sum_i(int v) {
#pragma unroll
    for (int o = 1; o < 64; o <<= 1) v += __shfl_xor(v, o);
    return v;
}
__device__ __forceinline__ float sigmoidf_(float x) { return __builtin_amdgcn_rcpf(1.0f + __builtin_amdgcn_exp2f(-1.4426950408889634f * x)); }
__device__ __forceinline__ float siluf_(float x) { return x * __builtin_amdgcn_rcpf(1.0f + __builtin_amdgcn_exp2f(-1.4426950408889634f * x)); }
__device__ __forceinline__ float gelu_tanh(float y) { const float u = 0.7978845608028654f * (y + 0.044715f * y * y * y); return 0.5f * y * (1.0f + tanhf(u)); }

#ifndef USE_NT
#define USE_NT 0
#endif
#if USE_NT
#define NT_STORE(p, v) __builtin_nontemporal_store((v), (p))
#else
#define NT_STORE(p, v) (*(p) = (v))
#endif
struct EpiBf16P {
    static constexpr bool PERM = true, AFTER_DRAIN = false;
    bf16* O; int ldc;
    __device__ __forceinline__ void operator()(const pg8::f32x4 (&acc)[2][2][4][2], const pg8::Unit& u, int wr, int wc, int fr, int fq) const {
        const int row0 = u.pm * 256 + wr * 64 + fr, col0 = u.pn * 256 + wc * 32 + 8 * fq;
#pragma unroll
        for (int ai = 0; ai < 2; ++ai)
#pragma unroll
            for (int m = 0; m < 4; ++m) { bf16* rowp = O + (size_t)(row0 + ai * 128 + m * 16) * ldc + col0;
#pragma unroll
                for (int bj = 0; bj < 2; ++bj) { const pg8::f32x4 v0 = acc[ai][bj][m][0], v1 = acc[ai][bj][m][1];
                    pg8::u32x4 w; w.x = pg8::cvt_pk_bf16(v0[0], v0[1]); w.y = pg8::cvt_pk_bf16(v0[2], v0[3]); w.z = pg8::cvt_pk_bf16(v1[0], v1[1]); w.w = pg8::cvt_pk_bf16(v1[2], v1[3]);
                    NT_STORE((pg8::u32x4*)(rowp + bj * 128), w); } }
    }
};
struct EpiResF32 {
    static constexpr bool PERM = false, AFTER_DRAIN = false;
    const float* base; float* out; int ldc;
    __device__ __forceinline__ void operator()(const pg8::f32x4 (&acc)[2][2][4][2], const pg8::Unit& u, int wr, int wc, int fr, int fq) const {
        const int row0 = u.pm * 256 + wr * 64 + fr, col0 = u.pn * 256 + wc * 32 + 4 * fq;
#pragma unroll
        for (int ai = 0; ai < 2; ++ai)
#pragma unroll
            for (int m = 0; m < 4; ++m) { const size_t off = (size_t)(row0 + ai * 128 + m * 16) * ldc + col0;
#pragma unroll
                for (int bj = 0; bj < 2; ++bj)
#pragma unroll
                    for (int n = 0; n < 2; ++n) { const size_t i = off + bj * 128 + n * 16; const pg8::f32x4 b = *(const pg8::f32x4*)(base + i); *(pg8::f32x4*)(out + i) = b + acc[ai][bj][m][n]; } }
    }
};

__device__ __forceinline__ size_t blk_off(int R, int C, int ld) { return ((size_t)(R >> 4) * (ld >> 5) + (C >> 5)) * 512 + (R & 15) * 32 + (C & 31); }
__device__ __forceinline__ float rstd_of(float ss) { return __builtin_amdgcn_rsqf(ss * (1.0f / DM) + EPS); }
__device__ __forceinline__ float rstd_row(const float* rssp, int row, int fq) {
    const f32x4* p = (const f32x4*)(rssp + (size_t)row * 32) + 2 * fq; const f32x4 a = p[0], b = p[1];
    float s = ((a.x + a.y) + (a.z + a.w)) + ((b.x + b.y) + (b.z + b.w)); s += __shfl_xor(s, 16); s += __shfl_xor(s, 32); return rstd_of(s);
}
__device__ __forceinline__ void rstd_rows8(const float* rssp, int row0, int fq, float (&rs)[8]) {
#pragma unroll
    for (int h = 0; h < 2; ++h) { f32x4 pa[4], pb[4];
#pragma unroll
        for (int q = 0; q < 4; ++q) { const f32x4* p = (const f32x4*)(rssp + (size_t)(row0 + h * 128 + q * 16) * 32) + 2 * fq; pa[q] = p[0]; pb[q] = p[1]; }
        asm volatile("" ::: "memory");
#pragma unroll
        for (int q = 0; q < 4; ++q) { float s = ((pa[q].x + pa[q].y) + (pa[q].z + pa[q].w)) + ((pb[q].x + pb[q].y) + (pb[q].z + pb[q].w)); s += __shfl_xor(s, 16); s += __shfl_xor(s, 32); rs[h * 4 + q] = rstd_of(s); } }
}
constexpr int ROWTILE_OFF = 131072 + 8192;
struct RowTile {
    static __device__ __forceinline__ void load(const float* part, int pm, int tid, LAS unsigned char* lds) {
        const int row = tid >> 1, half = tid & 1; const f32x4* p = (const f32x4*)(part + (size_t)(pm * 256 + row) * 32 + half * 16);
        const f32x4 a = p[0], b = p[1], c = p[2], d = p[3];
        float s = (((a.x + a.y) + (a.z + a.w)) + ((b.x + b.y) + (b.z + b.w))) + (((c.x + c.y) + (c.z + c.w)) + ((d.x + d.y) + (d.z + d.w)));
        s += __shfl_xor(s, 1);
        if (half == 0) ((LAS float*)(lds + ROWTILE_OFF))[row] = rstd_of(s);
        asm volatile("s_waitcnt lgkmcnt(0)" ::: "memory"); __builtin_amdgcn_s_barrier(); asm volatile("" ::: "memory");
    }
};
template <bool PART>
struct EpiBf16RsT {
    static constexpr bool PERM = true, AFTER_DRAIN = false;
    bf16* O; int ldc; const float* rss; LAS unsigned char* lds;
    __device__ __forceinline__ void load_rows(int pm, int tid, LAS unsigned char* l) const { RowTile::load(rss, pm, tid, l); }
    __device__ __forceinline__ void operator()(const pg8::f32x4 (&acc)[2][2][4][2], const pg8::Unit& u, int wr, int wc, int fr, int fq) const {
        const int row0 = u.pm * 256 + wr * 64 + fr;
        const size_t rbs = (size_t)(ldc >> 5) * 512, lane_blk = ((size_t)(u.pm * 16 + wr * 4) * (ldc >> 5) + u.pn * 8 + wc) * 512 + fr * 32 + 8 * fq;
        float rsv[8];
#pragma unroll
        for (int q = 0; q < 8; ++q) rsv[q] = PART ? ((const LAS float*)(lds + ROWTILE_OFF))[wr * 64 + fr + (q >> 2) * 128 + (q & 3) * 16] : rss[row0 + (q >> 2) * 128 + (q & 3) * 16];
        asm volatile("" ::: "memory");
#pragma unroll
        for (int ai = 0; ai < 2; ++ai)
#pragma unroll
            for (int m = 0; m < 4; ++m) { const float rs = rsv[ai * 4 + m]; bf16* rowp = O + lane_blk + (size_t)(ai * 8 + m) * rbs;
#pragma unroll
                for (int bj = 0; bj < 2; ++bj) { const pg8::f32x4 v0 = acc[ai][bj][m][0] * rs, v1 = acc[ai][bj][m][1] * rs;
                    pg8::u32x4 w; w.x = pg8::cvt_pk_bf16(v0[0], v0[1]); w.y = pg8::cvt_pk_bf16(v0[2], v0[3]); w.z = pg8::cvt_pk_bf16(v1[0], v1[1]); w.w = pg8::cvt_pk_bf16(v1[2], v1[3]);
                    NT_STORE((pg8::u32x4*)(rowp + bj * 2048), w); } }
    }
};
typedef EpiBf16RsT<false> EpiBf16Rs; typedef EpiBf16RsT<true> EpiBf16RsP;
namespace pg8 { template <> struct RowsLds<EpiBf16RsP> { static constexpr bool value = true; }; }
struct EpiBf16RsLocal {
    static constexpr bool PERM = true, AFTER_DRAIN = false;
    bf16* O; int ldc; const float* rss;
    __device__ __forceinline__ void operator()(const pg8::f32x4 (&acc)[2][2][4][2], const pg8::Unit& u, int wr, int wc, int fr, int fq) const {
        const int row0 = u.pm * 256 + wr * 64 + fr, col0 = wc * 32 + 8 * fq; bf16* Ow = O + (size_t)blockIdx.x * 65536;
#pragma unroll
        for (int ai = 0; ai < 2; ++ai)
#pragma unroll
            for (int m = 0; m < 4; ++m) { const int row = row0 + ai * 128 + m * 16; const float rs = rstd_row(rss, row, fq); bf16* rowp = Ow + (size_t)(row & 255) * 256 + col0;
#pragma unroll
                for (int bj = 0; bj < 2; ++bj) { const pg8::f32x4 v0 = acc[ai][bj][m][0] * rs, v1 = acc[ai][bj][m][1] * rs;
                    pg8::u32x4 w; w.x = pg8::cvt_pk_bf16(v0[0], v0[1]); w.y = pg8::cvt_pk_bf16(v0[2], v0[3]); w.z = pg8::cvt_pk_bf16(v1[0], v1[1]); w.w = pg8::cvt_pk_bf16(v1[2], v1[3]);
                    *(pg8::u32x4*)(rowp + bj * 128) = w; } }
    }
};
struct EpiStoreOnly {
    static constexpr bool PERM = true, AFTER_DRAIN = false;
    bf16* O; int ldc;
    __device__ __forceinline__ void operator()(const pg8::f32x4 (&acc)[2][2][4][2], const pg8::Unit& u, int wr, int wc, int fr, int fq) const {
        const int row0 = wr * 64 + fr, col0 = wc * 32 + 8 * fq; bf16* Ow = O + (size_t)blockIdx.x * 65536;
#pragma unroll
        for (int ai = 0; ai < 2; ++ai)
#pragma unroll
            for (int m = 0; m < 4; ++m) { bf16* rowp = Ow + (size_t)(row0 + ai * 128 + m * 16) * 256 + col0;
#pragma unroll
                for (int bj = 0; bj < 2; ++bj) { const pg8::f32x4 v0 = acc[ai][bj][m][0] * 1.0009765625f, v1 = acc[ai][bj][m][1] * 1.0009765625f;
                    pg8::u32x4 w; w.x = pg8::cvt_pk_bf16(v0[0], v0[1]); w.y = pg8::cvt_pk_bf16(v0[2], v0[3]); w.z = pg8::cvt_pk_bf16(v1[0], v1[1]); w.w = pg8::cvt_pk_bf16(v1[2], v1[3]);
                    *(pg8::u32x4*)(rowp + bj * 128) = w; } }
    }
};
struct EpiValuOnly {
    static constexpr bool PERM = true, AFTER_DRAIN = false;
    bf16* O; int ldc; const float* rss;
    __device__ __forceinline__ void operator()(const pg8::f32x4 (&acc)[2][2][4][2], const pg8::Unit& u, int wr, int wc, int fr, int fq) const {
        const int row0 = u.pm * 256 + wr * 64 + fr; float rsv[8];
#pragma unroll
        for (int q = 0; q < 8; ++q) rsv[q] = rss[row0 + (q >> 2) * 128 + (q & 3) * 16];
        pg8::u32x4 s = {0u, 0u, 0u, 0u};
#pragma unroll
        for (int ai = 0; ai < 2; ++ai)
#pragma unroll
            for (int m = 0; m < 4; ++m) { const float rs = rsv[ai * 4 + m];
#pragma unroll
                for (int bj = 0; bj < 2; ++bj) { const pg8::f32x4 v0 = acc[ai][bj][m][0] * rs, v1 = acc[ai][bj][m][1] * rs;
                    s.x ^= pg8::cvt_pk_bf16(v0[0], v0[1]); s.y ^= pg8::cvt_pk_bf16(v0[2], v0[3]); s.z ^= pg8::cvt_pk_bf16(v1[0], v1[1]); s.w ^= pg8::cvt_pk_bf16(v1[2], v1[3]); } }
        *(pg8::u32x4*)(O + (size_t)blockIdx.x * 65536 + threadIdx.x * 8) = s;
    }
};
struct SameOrder {
    int n;
    __device__ bool next(int i, pg8::Unit& u) const { if (i >= n) return false; u.pm = 0; u.pn = 0; return true; }
    __device__ __forceinline__ void a_ready(const pg8::Unit&) const {}
    __device__ __forceinline__ void done(const pg8::Unit&) const {}
};
struct EpiNone {
    static constexpr bool PERM = true, AFTER_DRAIN = false;
    float* O; int never;
    __device__ __forceinline__ void operator()(const pg8::f32x4 (&acc)[2][2][4][2], const pg8::Unit& u, int wr, int wc, int fr, int fq) const {
        pg8::f32x4 s = {0.f, 0.f, 0.f, 0.f};
#pragma unroll
        for (int ai = 0; ai < 2; ++ai)
#pragma unroll
            for (int m = 0; m < 4; ++m)
#pragma unroll
                for (int bj = 0; bj < 2; ++bj)
#pragma unroll
                    for (int n = 0; n < 2; ++n) s += acc[ai][bj][m][n];
        if (never < 0) *(pg8::f32x4*)(O + threadIdx.x * 4) = s;
    }
};
template <bool BASE_F32, bool OUT_F32>
struct EpiResNorm {
    static constexpr bool PERM = true, AFTER_DRAIN = false;
    const void* base; void* out; float* rssn; int ldc;
    __device__ __forceinline__ void operator()(const pg8::f32x4 (&acc)[2][2][4][2], const pg8::Unit& u, int wr, int wc, int fr, int fq) const {
        const int row0 = u.pm * 256 + wr * 64 + fr, col0 = u.pn * 256 + wc * 32 + 8 * fq;
        const size_t rbs = (size_t)(ldc >> 5) * 512, lane_blk = ((size_t)(u.pm * 16 + wr * 4) * (ldc >> 5) + u.pn * 8 + wc) * 512 + fr * 32 + 8 * fq;
        pg8::u32x4 bw[2][4][2];
        if (!BASE_F32) {
#pragma unroll
            for (int ai = 0; ai < 2; ++ai)
#pragma unroll
                for (int m = 0; m < 4; ++m)
#pragma unroll
                    for (int bj = 0; bj < 2; ++bj) bw[ai][m][bj] = *(const pg8::u32x4*)((const bf16*)base + lane_blk + (size_t)(ai * 8 + m) * rbs + bj * 2048);
            asm volatile("" ::: "memory");
        }
#pragma unroll
        for (int ai = 0; ai < 2; ++ai) {
            pg8::f32x4 bf[4][2][2];
            if (BASE_F32) {
#pragma unroll
                for (int m = 0; m < 4; ++m)
#pragma unroll
                    for (int bj = 0; bj < 2; ++bj) { const float* p = (const float*)base + (size_t)(row0 + ai * 128 + m * 16) * ldc + col0 + bj * 128; bf[m][bj][0] = *(const pg8::f32x4*)p; bf[m][bj][1] = *(const pg8::f32x4*)(p + 4); }
                asm volatile("" ::: "memory");
            }
#pragma unroll
            for (int m = 0; m < 4; ++m) { const int row = row0 + ai * 128 + m * 16; const size_t off = (size_t)row * ldc + col0; float ss = 0.f;
#pragma unroll
                for (int bj = 0; bj < 2; ++bj) { const size_t i = off + bj * 128; pg8::f32x4 x0, x1;
                    if (BASE_F32) { x0 = bf[m][bj][0]; x1 = bf[m][bj][1]; }
                    else { const pg8::u32x4 w = bw[ai][m][bj];
                        x0 = (pg8::f32x4){__uint_as_float(w.x << 16), __uint_as_float(w.x & 0xffff0000u), __uint_as_float(w.y << 16), __uint_as_float(w.y & 0xffff0000u)};
                        x1 = (pg8::f32x4){__uint_as_float(w.z << 16), __uint_as_float(w.z & 0xffff0000u), __uint_as_float(w.w << 16), __uint_as_float(w.w & 0xffff0000u)}; }
                    x0 += acc[ai][bj][m][0]; x1 += acc[ai][bj][m][1];
                    if (OUT_F32) { *(pg8::f32x4*)((float*)out + i) = x0; *(pg8::f32x4*)((float*)out + i + 4) = x1; }
                    else { pg8::u32x4 w; w.x = pg8::cvt_pk_bf16(x0[0], x0[1]); w.y = pg8::cvt_pk_bf16(x0[2], x0[3]); w.z = pg8::cvt_pk_bf16(x1[0], x1[1]); w.w = pg8::cvt_pk_bf16(x1[2], x1[3]); NT_STORE((pg8::u32x4*)((bf16*)out + lane_blk + (size_t)(ai * 8 + m) * rbs + bj * 2048), w); }
                    ss += ((x0[0] * x0[0] + x0[1] * x0[1]) + (x0[2] * x0[2] + x0[3] * x0[3])) + ((x1[0] * x1[0] + x1[1] * x1[1]) + (x1[2] * x1[2] + x1[3] * x1[3])); }
                ss += __shfl_xor(ss, 16); ss += __shfl_xor(ss, 32);
                if (fq == 0) rssn[(size_t)row * 32 + u.pn * 4 + wc] = ss; }
        }
    }
};
typedef EpiResNorm<true, false> EpiResFirst; typedef EpiResNorm<false, false> EpiResMid; typedef EpiResNorm<false, true> EpiResLast;
__device__ __forceinline__ float dpp_ror1(float v) { return __int_as_float(__builtin_amdgcn_update_dpp(0, __float_as_int(v), 0x121, 0xf, 0xf, false)); }
__device__ __forceinline__ float dpp_ror2(float v) { return __int_as_float(__builtin_amdgcn_update_dpp(0, __float_as_int(v), 0x122, 0xf, 0xf, false)); }
constexpr float LOG2E_ = 1.4426950408889634f;
struct EpiGuFused {
    static constexpr bool PERM = true, AFTER_DRAIN = false;
    bf16* ACT; const float* rss; const float* cw; const float* cb; float* sideG; float* sideU; LAS unsigned char* halo;
    __device__ __forceinline__ void load_rows(int pm, int tid, LAS unsigned char* l) const { RowTile::load(rss, pm, tid, l); }
    __device__ __forceinline__ void operator()(const pg8::f32x4 (&acc)[2][2][4][2], const pg8::Unit& u, int wr, int wc, int fr, int fq) const {
        const int ch0 = u.pn * 128 + wc * 32 + 8 * fq;
        const size_t act_blk = ((size_t)(u.pm * 16 + wr * 4) * (DFF >> 5) + u.pn * 4 + wc) * 512 + fr * 32 + 8 * fq;
        float rsv[8];
#pragma unroll
        for (int q = 0; q < 8; ++q) rsv[q] = ((const LAS float*)(halo - 131072 + ROWTILE_OFF))[wr * 64 + fr + (q >> 2) * 128 + (q & 3) * 16];
        float w0[8], w1[8], w2[8], bb[8];
#pragma unroll
        for (int k = 0; k < 8; ++k) { w0[k] = cw[ch0 + k] * LOG2E_; w1[k] = cw[DFF + ch0 + k] * LOG2E_; w2[k] = cw[2 * DFF + ch0 + k] * LOG2E_; bb[k] = cb[ch0 + k] * LOG2E_; }
        asm volatile("" ::: "memory");
#pragma unroll
        for (int ai = 0; ai < 2; ++ai) { if (fr >= 14) { LAS float* hs = (LAS float*)(halo + (((ai * 2 + wr) * 4 + wc) * 8 + (fr - 14) * 4 + fq) * 32); const float rs = rsv[ai * 4 + 3];
                *(LAS pg8::f32x4*)hs = acc[ai][0][3][0] * rs; *(LAS pg8::f32x4*)(hs + 4) = acc[ai][0][3][1] * rs; } }
        asm volatile("s_waitcnt lgkmcnt(0)" ::: "memory"); __builtin_amdgcn_s_barrier(); asm volatile("" ::: "memory");
#pragma unroll
        for (int ai = 0; ai < 2; ++ai) {
            float rot[5][2][8];
            { const bool has_above = (ai | wr) != 0; const int sa = wr ? ai : 0, sw = wr ? 0 : 1;
              const LAS float* h62 = (const LAS float*)(halo + (((sa * 2 + sw) * 4 + wc) * 8 + fq) * 32); const LAS float* h63 = h62 + 32;
              const pg8::f32x4 a0 = *(const LAS pg8::f32x4*)h62, a1 = *(const LAS pg8::f32x4*)(h62 + 4), b0 = *(const LAS pg8::f32x4*)h63, b1 = *(const LAS pg8::f32x4*)(h63 + 4);
#pragma unroll
              for (int k = 0; k < 8; ++k) { const float r62 = k < 4 ? a0[k & 3] : a1[k & 3], r63 = k < 4 ? b0[k & 3] : b1[k & 3];
                  rot[0][0][k] = has_above ? r63 : 0.f; rot[0][1][k] = has_above ? (fr == 0 ? r62 : r63) : 0.f; } }
#pragma unroll
            for (int m = 0; m < 4; ++m) { const int row = u.pm * 256 + ai * 128 + wr * 64 + m * 16 + fr; const float rs = rsv[ai * 4 + m];
                float g[8], uu[8], o[8];
#pragma unroll
                for (int k = 0; k < 8; ++k) { g[k] = acc[ai][0][m][k >> 2][k & 3] * rs; uu[k] = acc[ai][1][m][k >> 2][k & 3] * (rs * (1.0f / LOG2E_)); }
#pragma unroll
                for (int k = 0; k < 8; ++k) { rot[m + 1][0][k] = dpp_ror1(g[k]); rot[m + 1][1][k] = dpp_ror2(g[k]);
                    const float g1 = (fr == 0) ? rot[m][0][k] : rot[m + 1][0][k], g2 = (fr < 2) ? rot[m][1][k] : rot[m + 1][1][k];
                    const float v = __builtin_fmaf(w2[k], g[k], __builtin_fmaf(w1[k], g1, __builtin_fmaf(w0[k], g2, bb[k])));
                    o[k] = v * __builtin_amdgcn_rcpf(1.0f + __builtin_amdgcn_exp2f(-v)) * uu[k]; }
                pg8::u32x4 ow; ow.x = pg8::cvt_pk_bf16(o[0], o[1]); ow.y = pg8::cvt_pk_bf16(o[2], o[3]); ow.z = pg8::cvt_pk_bf16(o[4], o[5]); ow.w = pg8::cvt_pk_bf16(o[6], o[7]);
                NT_STORE((pg8::u32x4*)(ACT + act_blk + (size_t)(ai * 8 + m) * ((DFF >> 5) * 512)), ow);
                if (m == 0 && fr < 2 && ai == 0 && wr == 0) { float* sg = sideG + ((size_t)u.pm * 4 + fr) * DFF + ch0; float* su = sideU + ((size_t)u.pm * 2 + fr) * DFF + ch0;
                    *(pg8::f32x4*)sg = (pg8::f32x4){g[0], g[1], g[2], g[3]}; *(pg8::f32x4*)(sg + 4) = (pg8::f32x4){g[4], g[5], g[6], g[7]};
                    *(pg8::f32x4*)su = (pg8::f32x4){uu[0], uu[1], uu[2], uu[3]} * LOG2E_; *(pg8::f32x4*)(su + 4) = (pg8::f32x4){uu[4], uu[5], uu[6], uu[7]} * LOG2E_; }
                if (m == 3 && fr >= 14 && ai == 1 && wr == 1) { float* sg = sideG + ((size_t)u.pm * 4 + 2 + (fr - 14)) * DFF + ch0;
                    *(pg8::f32x4*)sg = (pg8::f32x4){g[0], g[1], g[2], g[3]}; *(pg8::f32x4*)(sg + 4) = (pg8::f32x4){g[4], g[5], g[6], g[7]}; }
            }
        }
    }
};
namespace pg8 { template <> struct RowsLds<EpiGuFused> { static constexpr bool value = true; }; }
struct Args { const float* in[21]; float* out; unsigned char* ws; int ph_lo, ph_hi; };
struct Frame {
    LAS unsigned char* lds;
    int tid, lane, wave, G, vcu;
    unsigned char* ws;
};

__device__ __forceinline__ void ph_ffn_fixup(Frame& F, bf16* ACT, const float* sideG, const float* sideU, const float* cw, const float* cb) {
    const int gt = F.vcu * NTHR + F.tid, NT = F.G * NTHR;
    for (int it = gt; it < 128 * 2 * 704; it += NT) {
        const int oct = it % 704, rr = (it / 704) & 1, pm = it / 1408, ch0 = oct * 8; const bool first = (pm & 7) == 0;
        const float* pm2 = rr == 0 ? sideG + ((size_t)(pm - 1) * 4 + 2) * DFF + ch0 : sideG + ((size_t)(pm - 1) * 4 + 3) * DFF + ch0;
        const float* pm1 = rr == 0 ? sideG + ((size_t)(pm - 1) * 4 + 3) * DFF + ch0 : sideG + ((size_t)pm * 4 + 0) * DFF + ch0;
        const float* p0 = sideG + ((size_t)pm * 4 + rr) * DFF + ch0; const float* pu = sideU + ((size_t)pm * 2 + rr) * DFF + ch0;
        float gm2[8], gm1[8], g0[8], uu[8], o[8];
#pragma unroll
        for (int k = 0; k < 8; ++k) { gm2[k] = first ? 0.f : pm2[k]; gm1[k] = (first && rr == 0) ? 0.f : pm1[k]; g0[k] = p0[k]; uu[k] = pu[k]; }
#pragma unroll
        for (int k = 0; k < 8; ++k) { const float v = cb[ch0 + k] + cw[ch0 + k] * gm2[k] + cw[DFF + ch0 + k] * gm1[k] + cw[2 * DFF + ch0 + k] * g0[k];
            o[k] = v * __builtin_amdgcn_rcpf(1.0f + __builtin_amdgcn_exp2f(-1.4426950408889634f * v)) * uu[k]; }
        v4u ow; ow.x = pk2(o[0], o[1]); ow.y = pk2(o[2], o[3]); ow.z = pk2(o[4], o[5]); ow.w = pk2(o[6], o[7]);
        *(v4u*)(ACT + blk_off(pm * 256 + rr, ch0, DFF)) = ow;
    }
}
__device__ __forceinline__ int dest_row(int kind, int n0) { if (kind == 0) return n0; const int c = n0 < DFF ? n0 : n0 - DFF; return (c >> 7) * 256 + (c & 127) + (n0 < DFF ? 0 : 128); }
__device__ __forceinline__ void p0_transpose_item(const float* W, int K, int N, bf16* WT, int kind, LAS unsigned char* scr, int item, int lane, const float* gain) {
    constexpr int TP = 264;
    const int nblk = (N + 127) / 128;
    const int kb = item / nblk, nb = item % nblk, k0 = 64 * kb, n0 = 128 * nb;
    const int nn = n0 + 4 * (lane & 31); const bool ok = nn < N;
    f32x4 v[32];
#pragma unroll
    for (int i = 0; i < 32; ++i) { const int kk = 2 * i + (lane >> 5); v[i] = ok ? *(const f32x4*)(W + (size_t)(k0 + kk) * N + nn) : (f32x4){0.f, 0.f, 0.f, 0.f}; }
#pragma unroll
    for (int i = 0; i < 32; ++i) { const int kk = 2 * i + (lane >> 5); f32x4 x = v[i]; if (gain) x = x * gain[k0 + kk];
        v2u w; w.x = pk2(x.x, x.y); w.y = pk2(x.z, x.w); *(LAS v2u*)(scr + kk * TP + 8 * (lane & 31)) = w; }
    asm volatile("s_waitcnt lgkmcnt(0)" ::: "memory");
    const int r0 = dest_row(kind, n0);
#pragma unroll 4
    for (int i = 0; i < 16; ++i) { const int p = lane + 64 * i, c = p & 7, n = p >> 3; const LAS unsigned char* s = scr + (8 * c) * TP + 2 * n;
        unsigned e[8];
#pragma unroll
        for (int q = 0; q < 8; ++q) e[q] = *(const LAS bf16*)(s + q * TP);
        v4u o; o.x = e[0] | (e[1] << 16); o.y = e[2] | (e[3] << 16); o.z = e[4] | (e[5] << 16); o.w = e[6] | (e[7] << 16);
        { const int cc = n & 31, rho = 16 * ((cc >> 2) & 1) + 4 * (cc >> 3) + (cc & 3);
          *(v4u*)(WT + blk_off(r0 + (n & ~31) + rho, k0 + 8 * c, K)) = o; } }
    asm volatile("s_waitcnt lgkmcnt(0)" ::: "memory");
}
__device__ __forceinline__ void p0_transpose(const float* W, int K, int N, bf16* WT, int kind, LAS unsigned char* scr, int gw, int NGW, int lane, const float* gain = nullptr) {
    const int nitems = (K / 64) * ((N + 127) / 128);
    for (int item = gw; item < nitems; item += NGW) p0_transpose_item(W, K, N, WT, kind, scr, item, lane, gain);
}
constexpr int L1_I0 = (DM / 64) * ((O_IN + 127) / 128), L1_I1 = (DM / 64) * (DM / 128), L1_I2 = (DM / 64) * (GUW / 128), L1_I3 = (DFF / 64) * (DM / 128), L1_ITEMS = L1_I0 + L1_I1 + L1_I2 + L1_I3;
__device__ __forceinline__ void conv_l1_item(Frame& F, const Args& A, int it, LAS unsigned char* scr) {
    unsigned char* ws = F.ws;
    if (it < L1_I0) { p0_transpose_item(A.in[13], DM, O_IN, (bf16*)(ws + WS_WIN1), 0, scr, it, F.lane, FOLD ? A.in[1] + DM : nullptr); return; } it -= L1_I0;
    if (it < L1_I1) { p0_transpose_item(A.in[14], DM, DM, (bf16*)(ws + WS_WOUT1), 0, scr, it, F.lane, nullptr); return; } it -= L1_I1;
    if (it < L1_I2) { p0_transpose_item(A.in[16] + (size_t)DM * GUW, DM, GUW, (bf16*)(ws + WS_WGU1), 1, scr, it, F.lane, FOLD ? A.in[2] + DM : nullptr); return; } it -= L1_I2;
    p0_transpose_item(A.in[19] + (size_t)DFF * DM, DFF, DM, (bf16*)(ws + WS_WDN1), 0, scr, it, F.lane, nullptr);
}
__device__ __forceinline__ int t5_bucket(int n) {
    if (n < 16) return n;
    int lg = 16 + (int)(logf((float)n / 16.0f) / logf(8.0f) * 16.0f);
    return lg < 31 ? lg : 31;
}
template <bool OUT_BF16>
__device__ __forceinline__ void rmsnorm_rows(Frame& F, const float* X, const float* g, void* out) {
    const int gw = F.vcu * NWAVES + F.wave, NGW = F.G * NWAVES;
    for (int row = gw; row < MTOK; row += NGW) {
        const f32x4* xr = (const f32x4*)(X + (size_t)row * DM) + F.lane;
        f32x4 v[8]; float s = 0.f;
#pragma unroll
        for (int j = 0; j < 8; ++j) { v[j] = xr[64 * j]; s += (v[j].x * v[j].x + v[j].y * v[j].y) + (v[j].z * v[j].z + v[j].w * v[j].w); }
        const float rstd = 1.0f / sqrtf(wave_sum(s) * (1.0f / DM) + EPS);
#pragma unroll
        for (int j = 0; j < 8; ++j) { const f32x4 gg = ((const f32x4*)g)[F.lane + 64 * j]; const f32x4 o = v[j] * rstd * gg;
            if (OUT_BF16) { v2u w; w.x = pk2(o.x, o.y); w.y = pk2(o.z, o.w); *((v2u*)((bf16*)out + (size_t)row * DM) + F.lane + 64 * j) = w; }
            else *((f32x4*)((float*)out + (size_t)row * DM) + F.lane + 64 * j) = o; }
    }
}
__device__ __forceinline__ void p0_prologue(Frame& F, const Args& A) {
    LAS unsigned char* scr = F.lds + F.wave * 17408;
    const int gw = F.vcu * NWAVES + F.wave, NGW = F.G * NWAVES;
    unsigned char* ws = F.ws;
#if DEFER_L1
    { constexpr int I0 = (DM / 64) * (E_IN / 128), I1 = (DM / 64) * (DM / 128), I2 = (DM / 64) * (GUW / 128), I3 = (DFF / 64) * (DM / 128);
      for (int it0 = gw; it0 < I0 + I1 + I2 + I3 + L1_I0 + L1_I1; it0 += NGW) { int it = it0;
          if (it < I0) { p0_transpose_item(A.in[3], DM, E_IN, (bf16*)(ws + WS_WIN0), 0, scr, it, F.lane, FOLD ? A.in[1] : nullptr); continue; } it -= I0;
          if (it < I1) { p0_transpose_item(A.in[12], DM, DM, (bf16*)(ws + WS_WOUT0), 0, scr, it, F.lane, nullptr); continue; } it -= I1;
          if (it < I2) { p0_transpose_item(A.in[16], DM, GUW, (bf16*)(ws + WS_WGU0), 1, scr, it, F.lane, FOLD ? A.in[2] : nullptr); continue; } it -= I2;
          if (it < I3) { p0_transpose_item(A.in[19], DFF, DM, (bf16*)(ws + WS_WDN0), 0, scr, it, F.lane, nullptr); continue; } it -= I3;
          if (it < L1_I0) { p0_transpose_item(A.in[13], DM, O_IN, (bf16*)(ws + WS_WIN1), 0, scr, it, F.lane, FOLD ? A.in[1] + DM : nullptr); continue; } it -= L1_I0;
          p0_transpose_item(A.in[14], DM, DM, (bf16*)(ws + WS_WOUT1), 0, scr, it, F.lane, nullptr); } }
#else
    p0_transpose(A.in[3], DM, E_IN, (bf16*)(ws + WS_WIN0), 0, scr, gw, NGW, F.lane, FOLD ? A.in[1] : nullptr);
    p0_transpose(A.in[12], DM, DM, (bf16*)(ws + WS_WOUT0), 0, scr, gw, NGW, F.lane);
#if !DEFER_L1
    p0_transpose(A.in[13], DM, O_IN, (bf16*)(ws + WS_WIN1), 0, scr, gw, NGW, F.lane, FOLD ? A.in[1] + DM : nullptr);
#endif
#if !DEFER_L1
    p0_transpose(A.in[14], DM, DM, (bf16*)(ws + WS_WOUT1), 0, scr, gw, NGW, F.lane);
#endif
    p0_transpose(A.in[16], DM, GUW, (bf16*)(ws + WS_WGU0), 1, scr, gw, NGW, F.lane, FOLD ? A.in[2] : nullptr);
#if !DEFER_L1
    p0_transpose(A.in[16] + (size_t)DM * GUW, DM, GUW, (bf16*)(ws + WS_WGU1), 1, scr, gw, NGW, F.lane, FOLD ? A.in[2] + DM : nullptr);
#endif
    p0_transpose(A.in[19], DFF, DM, (bf16*)(ws + WS_WDN0), 0, scr, gw, NGW, F.lane);
#if !DEFER_L1
    p0_transpose(A.in[19] + (size_t)DFF * DM, DFF, DM, (bf16*)(ws + WS_WDN1), 0, scr, gw, NGW, F.lane);
#endif
#endif
    const int gt = F.vcu * NTHR + F.tid, NT = F.G * NTHR;
    { v4u* z = (v4u*)((bf16*)(ws + WS_WIN1) + (size_t)4224 * DM); const int n16 = (O_INP - 4224) * DM / 8; for (int i = gt; i < n16; i += NT) z[i] = (v4u){0u, 0u, 0u, 0u}; }
    { f32x2* rot = (f32x2*)(ws + WS_ROT);
      for (int i = gt; i < SEQ * 64; i += NT) { const int t = i >> 6, j = i & 63; const float freq = exp2f(-(float)j * (13.287712379549449f / 64.0f)); const float ang = (float)t * freq;
          const float rev = ang * 0.15915494309189535f; const float fr = rev - floorf(rev); rot[i] = (f32x2){__builtin_amdgcn_cosf(fr), __builtin_amdgcn_sinf(fr)}; } }
    { bf16* waT = (bf16*)(ws + WS_GT); bf16* wxT = waT + 8 * 128 * 128;
      for (int i = gt; i < 8 * 128 * 128; i += NT) { const int n = i >> 14, e = (i >> 7) & 127, d = i & 127; waT[i] = (bf16)f2bf(A.in[7][(n * 128 + d) * 128 + e]); wxT[i] = (bf16)f2bf(A.in[9][(n * 128 + d) * 128 + e]); } }
    { float* tb = (float*)(ws + WS_TB); for (int i = gt; i < 128 * 16; i += NT) { const int n = i >> 4, h = i & 15; tb[i] = A.in[15][t5_bucket(n) * 16 + h]; }
      float* sp = (float*)(ws + WS_SP); for (int i = gt; i < 1024; i += NT) { const float x = -A.in[11][i]; sp[i] = fmaxf(x, 0.f) + log1pf(__expf(-fabsf(x))); } }
#if FOLD == 0
    rmsnorm_rows<true>(F, A.in[0], A.in[1], ws + WS_H);
#else
    { bf16* XB = (bf16*)(ws + WS_XB); float* rstd0 = (float*)(ws + WS_RSTD);
      for (int rb = gw; rb < MTOK / 16; rb += NGW) { const int row = rb * 16 + (F.lane >> 2); const float* xr = A.in[0] + (size_t)row * DM + (F.lane & 3) * 8; bf16* ob = XB + (size_t)rb * (DM / 32) * 512 + F.lane * 8; float s = 0.f;
#pragma unroll 8
          for (int cb = 0; cb < DM / 32; ++cb) { const f32x4 v0 = *(const f32x4*)(xr + cb * 32), v1 = *(const f32x4*)(xr + cb * 32 + 4);
              s += ((v0.x * v0.x + v0.y * v0.y) + (v0.z * v0.z + v0.w * v0.w)) + ((v1.x * v1.x + v1.y * v1.y) + (v1.z * v1.z + v1.w * v1.w));
              v4u w; w.x = pk2(v0.x, v0.y); w.y = pk2(v0.z, v0.w); w.z = pk2(v1.x, v1.y); w.w = pk2(v1.z, v1.w); *(v4u*)(ob + cb * 512) = w; }
          s += __shfl_xor(s, 1); s += __shfl_xor(s, 2);
          if ((F.lane & 3) == 0) rstd0[row] = rstd_of(s); } }
#endif
}

__device__ __forceinline__ void ret_naive_unit(Frame& F, const Args& A, int b, int h) {
    LAS float* ql = (LAS float*)(F.lds); LAS float* kl = ql + 16 * 128; LAS float* vl = kl + 16 * 128; LAS float* yp = vl + 16 * 128;
    const bf16* PROJ = (const bf16*)(F.ws + WS_PROJ); bf16* MIX = (bf16*)(F.ws + WS_H); const f32x2* rot = (const f32x2*)(F.ws + WS_ROT);
    const float* gn = A.in[4];
    const int tid = F.tid, e = tid & 127, dg = tid >> 7;
    const float gamma = 1.0f - exp2f(-5.0f - (float)h);
    float S[32];
#pragma unroll
    for (int i = 0; i < 32; ++i) S[i] = 0.f;
    for (int t0 = 0; t0 < SEQ; t0 += 16) {
        { const int row = tid >> 5, t = t0 + row; const bf16* prow = PROJ + (size_t)(b * SEQ + t) * E_IN;
#pragma unroll
          for (int rep = 0; rep < 2; ++rep) { const int i = (tid & 31) + 32 * rep; const f32x2 cs = rot[t * 64 + i];
              const float q1 = bf2f(prow[C0_Q + h * 128 + i]), q2 = bf2f(prow[C0_Q + h * 128 + i + 64]);
              const float k1 = bf2f(prow[C0_K + h * 128 + i]), k2 = bf2f(prow[C0_K + h * 128 + i + 64]);
              ql[row * 128 + i] = q1 * cs.x - q2 * cs.y; ql[row * 128 + i + 64] = q2 * cs.x + q1 * cs.y;
              kl[row * 128 + i] = (k1 * cs.x - k2 * cs.y) * 0.08838834764831845f; kl[row * 128 + i + 64] = (k2 * cs.x + k1 * cs.y) * 0.08838834764831845f;
              vl[row * 128 + i] = bf2f(prow[C0_V + h * 128 + i]); vl[row * 128 + i + 64] = bf2f(prow[C0_V + h * 128 + i + 64]); } }
        __syncthreads();
        for (int r = 0; r < 16; ++r) {
            const float vv = vl[r * 128 + e]; float yacc = 0.f;
#pragma unroll
            for (int q4 = 0; q4 < 8; ++q4) { const f32x4 k4 = *(const LAS f32x4*)(kl + r * 128 + dg * 32 + 4 * q4); const f32x4 qq = *(const LAS f32x4*)(ql + r * 128 + dg * 32 + 4 * q4);
#pragma unroll
                for (int j = 0; j < 4; ++j) { S[4 * q4 + j] = gamma * S[4 * q4 + j] + k4[j] * vv; yacc += qq[j] * S[4 * q4 + j]; } }
            yp[(r * 4 + dg) * 128 + e] = yacc;
        }
        __syncthreads();
#pragma unroll
        for (int rr = 0; rr < 2; ++rr) { const int r = 2 * F.wave + rr; const int l = F.lane;
            const float y0 = (yp[(r * 4 + 0) * 128 + l] + yp[(r * 4 + 1) * 128 + l]) + (yp[(r * 4 + 2) * 128 + l] + yp[(r * 4 + 3) * 128 + l]);
            const float y1 = (yp[(r * 4 + 0) * 128 + l + 64] + yp[(r * 4 + 1) * 128 + l + 64]) + (yp[(r * 4 + 2) * 128 + l + 64] + yp[(r * 4 + 3) * 128 + l + 64]);
            const float rstd = 1.0f / sqrtf(wave_sum(y0 * y0 + y1 * y1) * (1.0f / 128.0f) + EPS);
            const size_t tok = (size_t)(b * SEQ + t0 + r);
            const float g0 = bf2f(PROJ[tok * E_IN + C0_G + h * 128 + l]), g1 = bf2f(PROJ[tok * E_IN + C0_G + h * 128 + l + 64]);
            MIX[tok * DM + h * 128 + l] = (bf16)f2bf(y0 * rstd * gn[h * 128 + l] * siluf_(g0));
            MIX[tok * DM + h * 128 + l + 64] = (bf16)f2bf(y1 * rstd * gn[h * 128 + l + 64] * siluf_(g1)); }
        __syncthreads();
    }
}
__device__ __forceinline__ void lru_naive_unit(Frame& F, const Args& A, int b, int n) {
    LAS float* xc = (LAS float*)(F.lds); LAS float* pr = xc + 8 * 128; LAS float* pi = pr + 8 * 4 * 128;
    const bf16* PROJ = (const bf16*)(F.ws + WS_PROJ); bf16* MIX = (bf16*)(F.ws + WS_H);
    const float* cw = A.in[5]; const float* cb = A.in[6]; const float* wa = A.in[7]; const float* ba = A.in[8]; const float* wx = A.in[9]; const float* bx = A.in[10];
    const float* sp = (const float*)(F.ws + WS_SP);
    const int tid = F.tid, e = tid & 127, part = tid >> 7;
    float war[32], wxr[32];
#pragma unroll
    for (int dd = 0; dd < 32; ++dd) { war[dd] = wa[(size_t)(n * 128 + part * 32 + dd) * 128 + e]; wxr[dd] = wx[(size_t)(n * 128 + part * 32 + dd) * 128 + e]; }
    const int ce = n * 128 + e;
    const float bae = ba[ce], bxe = bx[ce], spe = sp[ce];
    float cwr[2][4], cbr[2];
#pragma unroll
    for (int rep = 0; rep < 2; ++rep) { const int c = n * 128 + (tid & 63) + 64 * rep; cbr[rep] = cb[c];
#pragma unroll
        for (int j = 0; j < 4; ++j) cwr[rep][j] = cw[j * 1024 + c]; }
    float hst = 0.f;
    for (int t0 = 0; t0 < SEQ; t0 += 8) {
        { const int row = tid >> 6, t = t0 + row;
#pragma unroll
          for (int rep = 0; rep < 2; ++rep) { const int c = (tid & 63) + 64 * rep; float a = cbr[rep];
#pragma unroll
              for (int j = 0; j < 4; ++j) { const int tt = t - 3 + j; if (tt >= 0) a += cwr[rep][j] * bf2f(PROJ[(size_t)(b * SEQ + tt) * E_IN + C0_XR + n * 128 + c]); }
              xc[row * 128 + c] = a; } }
        __syncthreads();
        for (int r = 0; r < 8; ++r) { float pa = 0.f, px = 0.f;
#pragma unroll
            for (int q4 = 0; q4 < 8; ++q4) { const f32x4 x4 = *(const LAS f32x4*)(xc + r * 128 + part * 32 + 4 * q4);
#pragma unroll
                for (int j = 0; j < 4; ++j) { pa += x4[j] * war[4 * q4 + j]; px += x4[j] * wxr[4 * q4 + j]; } }
            pr[(r * 4 + part) * 128 + e] = pa; pi[(r * 4 + part) * 128 + e] = px; }
        __syncthreads();
        if (tid < 128) {
            for (int r = 0; r < 8; ++r) {
                const float ra = (pr[(r * 4 + 0) * 128 + e] + pr[(r * 4 + 1) * 128 + e]) + (pr[(r * 4 + 2) * 128 + e] + pr[(r * 4 + 3) * 128 + e]) + bae;
                const float ia = (pi[(r * 4 + 0) * 128 + e] + pi[(r * 4 + 1) * 128 + e]) + (pi[(r * 4 + 2) * 128 + e] + pi[(r * 4 + 3) * 128 + e]) + bxe;
                const float rg = sigmoidf_(ra), ig = sigmoidf_(ia);
                const float log_a = -8.0f * rg * spe; const float a = __expf(log_a);
                const float em = -expm1f(2.0f * log_a); const float mult = sqrtf(fmaxf(em, 0.f));
                const float bb = mult * (ig * xc[r * 128 + e]);
                hst = a * hst + bb;
                const size_t tok = (size_t)(b * SEQ + t0 + r);
                const float y = bf2f(PROJ[tok * E_IN + C0_YR + n * 128 + e]);
                MIX[tok * DM + 1024 + n * 128 + e] = (bf16)f2bf(hst * gelu_tanh(y));
            }
        }
        __syncthreads();
    }
}
__device__ __forceinline__ void ph_mixer0_naive(Frame& F, const Args& A) {
    for (int u = F.vcu; u < 256; u += F.G) {
        if (u < 128) ret_naive_unit(F, A, u >> 3, u & 7); else lru_naive_unit(F, A, (u - 128) >> 3, (u - 128) & 7);
        __syncthreads();
    }
}
namespace mx {
typedef float f32x16 __attribute__((ext_vector_type(16)));
typedef short s16x8 __attribute__((ext_vector_type(8)));
constexpr int PB = 272;
constexpr int OFF_KH = 0, OFF_KT = 34816, OFF_VT = 69632, OFF_ST = 104448, OFF_SSQ = 139264;
__device__ __forceinline__ int crow(int r, int hi) { return (r & 3) + 8 * (r >> 2) + 4 * hi; }
__device__ __forceinline__ unsigned cvtpk(float lo, float hi) { unsigned r; asm volatile("v_cvt_pk_bf16_f32 %0, %1, %2" : "=v"(r) : "v"(lo), "v"(hi)); return r; }
__device__ __forceinline__ float blo(unsigned w) { return __uint_as_float(w << 16); }
__device__ __forceinline__ float bhi(unsigned w) { return __uint_as_float(w & 0xffff0000u); }
#define MFMA32(a, b, c) __builtin_amdgcn_mfma_f32_32x32x16_bf16((a), (b), (c), 0, 0, 0)
typedef short s16x4 __attribute__((ext_vector_type(4)));
__device__ __forceinline__ s16x4 trr(int addr) { s16x4 r; asm volatile("ds_read_b64_tr_b16 %0, %1" : "=&v"(r) : "v"(addr) : "memory"); return r; }
#define TRWAIT() do { asm volatile("s_waitcnt lgkmcnt(0)" ::: "memory"); __builtin_amdgcn_sched_barrier(0); } while (0)
__device__ __forceinline__ void rot_cs(int t, float freq, float& c, float& s) {
    const float rev = ((float)t * freq) * 0.15915494309189535f, fr = rev - floorf(rev); c = __builtin_amdgcn_cosf(fr); s = __builtin_amdgcn_sinf(fr);
}
__device__ __forceinline__ void ret_unit(Frame& F, const Args& A, int b, int h) {
    LAS unsigned char* KH = F.lds + OFF_KH; LAS unsigned char* GT = F.lds + OFF_KT;     LAS unsigned char* VT = F.lds + OFF_VT; LAS unsigned char* STB = F.lds + OFF_ST;
    LAS float* SSQ = (LAS float*)(F.lds + OFF_SSQ); LAS float* FRQ = SSQ + 256;
    const bf16* PROJ = (const bf16*)(F.ws + WS_PROJ); bf16* MIX = (bf16*)(F.ws + WS_H);
    const float* gn = A.in[4];
    const int tid = F.tid, lane = F.lane, wave = F.wave, c = lane & 31, hi = lane >> 5, I = wave >> 1, E = wave & 1;
    const float lg = log2f(1.0f - exp2f(-5.0f - (float)h));
    const float g128 = exp2f(128.0f * lg);
    f32x16 st0 = {}, st1 = {};
    const int trl = ((lane & 15) >> 2) * PB + (16 * ((lane >> 4) & 1) + 4 * (lane & 3)) * 2;
    const int vtr = (int)(unsigned)(size_t)VT + trl, ktr = (int)(unsigned)(size_t)KH + trl;
    for (int i = tid; i < 34816 / 16; i += NTHR) ((LAS v4u*)STB)[i] = (v4u){0u, 0u, 0u, 0u};
    if (tid < 64) FRQ[tid] = exp2f(-(float)tid * (13.287712379549449f / 64.0f));
    v4u kraw[2][2], vraw[4], qraw[4][2], graw[4];
    const int il = 32 * I + c;
    const int tcK = (int)blk_off(tid >> 3, C0_K + h * 128 + (tid & 7) * 8, E_IN), tcV = (int)blk_off(tid >> 4, C0_V + h * 128 + (tid & 15) * 8, E_IN), tcQ = (int)blk_off(il, C0_Q + h * 128 + 8 * hi, E_IN);
#define RET_LOAD(n_) do { const bf16* cb_ = PROJ + ((size_t)b * SEQ + (n_) * 128) * E_IN; \
        _Pragma("unroll") for (int rep = 0; rep < 2; ++rep) { kraw[rep][0] = *(const v4u*)(cb_ + (size_t)(64 * rep) * E_IN + tcK); kraw[rep][1] = *(const v4u*)(cb_ + (size_t)(64 * rep) * E_IN + tcK + 1024); } } while (0)
#define RET_LOADVG(n_) do { const bf16* cb_ = PROJ + ((size_t)b * SEQ + (n_) * 128) * E_IN; \
        _Pragma("unroll") for (int rep = 0; rep < 4; ++rep) { vraw[rep] = *(const v4u*)(cb_ + (size_t)(32 * rep) * E_IN + tcV); graw[rep] = *(const v4u*)(cb_ + (size_t)(32 * rep) * E_IN + tcV + 32 * 512); } } while (0)
#define RET_LOADQ(n_) do { const bf16* cb_ = PROJ + ((size_t)b * SEQ + (n_) * 128) * E_IN + tcQ; \
        _Pragma("unroll") for (int ks = 0; ks < 4; ++ks) { qraw[ks][0] = *(const v4u*)(cb_ + (ks >> 1) * 512 + 16 * (ks & 1)); qraw[ks][1] = *(const v4u*)(cb_ + (ks >> 1) * 512 + 16 * (ks & 1) + 1024); } } while (0)
    __syncthreads();
    for (int n = 0; n < SEQ / 128; ++n) {
        const size_t tok0 = (size_t)b * SEQ + n * 128;
        RET_LOAD(n);
#pragma unroll
        for (int rep = 0; rep < 2; ++rep) { const int idx = tid + 512 * rep, j = idx >> 3, d0 = (idx & 7) * 8;
            const v4u xlo = kraw[rep][0], xhi = kraw[rep][1];
            const float ks = 0.08838834764831845f * __builtin_amdgcn_exp2f(-(float)j * lg);
            const f32x4 f0 = *(const LAS f32x4*)(FRQ + d0), f1 = *(const LAS f32x4*)(FRQ + d0 + 4); const float fq_[8] = {f0.x, f0.y, f0.z, f0.w, f1.x, f1.y, f1.z, f1.w};
            float o1[8], o2[8];
#pragma unroll
            for (int q = 0; q < 4; ++q) { float c0, s0, c1, s1; rot_cs(n * 128 + j, fq_[2 * q], c0, s0); rot_cs(n * 128 + j, fq_[2 * q + 1], c1, s1);
                const float a1 = blo(xlo[q]), a2 = blo(xhi[q]), b1 = bhi(xlo[q]), b2 = bhi(xhi[q]);
                o1[2 * q] = (a1 * c0 - a2 * s0) * ks; o2[2 * q] = (a2 * c0 + a1 * s0) * ks;
                o1[2 * q + 1] = (b1 * c1 - b2 * s1) * ks; o2[2 * q + 1] = (b2 * c1 + b1 * s1) * ks; }
            v4u w1, w2;
#pragma unroll
            for (int q = 0; q < 4; ++q) { w1[q] = cvtpk(o1[2 * q], o1[2 * q + 1]); w2[q] = cvtpk(o2[2 * q], o2[2 * q + 1]); }
            *(LAS v4u*)(KH + j * PB + d0 * 2) = w1; *(LAS v4u*)(KH + j * PB + (d0 + 64) * 2) = w2; }
        RET_LOADQ(n); RET_LOADVG(n);
        s16x8 qf[8];
        { const float qs = __builtin_amdgcn_exp2f((float)il * lg);
#pragma unroll
          for (int ks = 0; ks < 4; ++ks) { const int d0 = 16 * ks + 8 * hi; const v4u xlo = qraw[ks][0], xhi = qraw[ks][1];
              const f32x4 f0 = *(const LAS f32x4*)(FRQ + d0), f1 = *(const LAS f32x4*)(FRQ + d0 + 4); const float fq_[8] = {f0.x, f0.y, f0.z, f0.w, f1.x, f1.y, f1.z, f1.w}; v4u w1, w2;
#pragma unroll
              for (int q = 0; q < 4; ++q) { float c0, s0, c1, s1; rot_cs(n * 128 + il, fq_[2 * q], c0, s0); rot_cs(n * 128 + il, fq_[2 * q + 1], c1, s1);
                  const float a1 = blo(xlo[q]), a2 = blo(xhi[q]), b1 = bhi(xlo[q]), b2 = bhi(xhi[q]);
                  w1[q] = cvtpk((a1 * c0 - a2 * s0) * qs, (b1 * c1 - b2 * s1) * qs); w2[q] = cvtpk((a2 * c0 + a1 * s0) * qs, (b2 * c1 + b1 * s1) * qs); }
              qf[ks] = *reinterpret_cast<s16x8*>(&w1); qf[ks + 4] = *reinterpret_cast<s16x8*>(&w2); } }
#pragma unroll
        for (int rep = 0; rep < 4; ++rep) { const int idx = tid + 512 * rep, j = idx >> 4, e0 = (idx & 15) * 8; *(LAS v4u*)(VT + j * PB + e0 * 2) = vraw[rep]; *(LAS v4u*)(GT + j * PB + e0 * 2) = graw[rep]; }
        __syncthreads();
        f32x16 y0 = {}, y1 = {};
#pragma unroll
        for (int ks = 0; ks < 8; ++ks) { const s16x8 a0 = *(const LAS s16x8*)(STB + (64 * E + c) * PB + (16 * ks + 8 * hi) * 2), a1 = *(const LAS s16x8*)(STB + (64 * E + 32 + c) * PB + (16 * ks + 8 * hi) * 2);
            y0 = MFMA32(a0, qf[ks], y0); y1 = MFMA32(a1, qf[ks], y1); __builtin_amdgcn_sched_barrier(0); }
        for (int J = 0; J <= I; ++J) {
            f32x16 s = {};
#pragma unroll
            for (int ks = 0; ks < 8; ++ks) { const s16x8 ak = *(const LAS s16x8*)(KH + (32 * J + c) * PB + (16 * ks + 8 * hi) * 2); s = MFMA32(ak, qf[ks], s); if (ks & 1) __builtin_amdgcn_sched_barrier(0); }
            { const int lim = c + 32 * (I - J);
#pragma unroll
              for (int r = 0; r < 16; ++r) s[r] = (crow(r, hi) <= lim) ? s[r] : 0.f; }
#pragma unroll
            for (int s2 = 0; s2 < 2; ++s2) { v4u pw;
#pragma unroll
                for (int q = 0; q < 4; ++q) pw[q] = cvtpk(s[8 * s2 + 2 * q], s[8 * s2 + 2 * q + 1]);
                const s16x8 pb = *reinterpret_cast<s16x8*>(&pw);
                const int jb = 32 * J + 16 * s2 + 4 * hi;
                { const s16x4 l4 = trr(vtr + jb * PB + (64 * E) * 2), h4 = trr(vtr + (jb + 8) * PB + (64 * E) * 2);
                  const s16x4 l5 = trr(vtr + jb * PB + (64 * E + 32) * 2), h5 = trr(vtr + (jb + 8) * PB + (64 * E + 32) * 2);
                  TRWAIT();
                  y0 = MFMA32(((s16x8){l4[0], l4[1], l4[2], l4[3], h4[0], h4[1], h4[2], h4[3]}), pb, y0);
                  y1 = MFMA32(((s16x8){l5[0], l5[1], l5[2], l5[3], h5[0], h5[1], h5[2], h5[3]}), pb, y1); } }
        }
        { const int et = wave >> 1, dt0 = 2 * (wave & 1);
#pragma unroll
          for (int ks = 0; ks < 8; ++ks) { const int jr = 16 * ks + 8 * hi;
              const s16x4 al = trr(vtr + jr * PB + (32 * et) * 2), ah = trr(vtr + (jr + 4) * PB + (32 * et) * 2);
              const s16x4 bl0 = trr(ktr + jr * PB + (32 * dt0) * 2), bh0 = trr(ktr + (jr + 4) * PB + (32 * dt0) * 2), bl1 = trr(ktr + jr * PB + (32 * dt0 + 32) * 2), bh1 = trr(ktr + (jr + 4) * PB + (32 * dt0 + 32) * 2);
              TRWAIT();
              const s16x8 av = {al[0], al[1], al[2], al[3], ah[0], ah[1], ah[2], ah[3]};
              st0 = MFMA32(av, ((s16x8){bl0[0], bl0[1], bl0[2], bl0[3], bh0[0], bh0[1], bh0[2], bh0[3]}), st0);
              st1 = MFMA32(av, ((s16x8){bl1[0], bl1[1], bl1[2], bl1[3], bh1[0], bh1[1], bh1[2], bh1[3]}), st1); }
#pragma unroll
          for (int r = 0; r < 16; ++r) { st0[r] *= g128; st1[r] *= g128; } }
        { float ss = 0.f;
#pragma unroll
          for (int r = 0; r < 16; ++r) ss += y0[r] * y0[r] + y1[r] * y1[r];
          ss += __shfl_xor(ss, 32);
          if (hi == 0) SSQ[(I * 2 + E) * 32 + c] = ss; }
        __syncthreads();
        { const int et = wave >> 1, dt0 = 2 * (wave & 1);
#pragma unroll
          for (int r = 0; r < 16; ++r) { const int e = 32 * et + crow(r, hi);
              *(LAS bf16*)(STB + e * PB + (32 * dt0 + c) * 2) = (bf16)f2bf(st0[r]); *(LAS bf16*)(STB + e * PB + (32 * dt0 + 32 + c) * 2) = (bf16)f2bf(st1[r]); } }
        { const float tot = SSQ[(I * 2) * 32 + c] + SSQ[(I * 2 + 1) * 32 + c]; const float rstd = __builtin_amdgcn_rsqf(tot * (1.0f / 128.0f) + EPS);
#pragma unroll
          for (int et2 = 0; et2 < 2; ++et2)
#pragma unroll
              for (int rg = 0; rg < 4; ++rg) { const int e0 = 64 * E + 32 * et2 + 8 * rg + 4 * hi;
                  LAS v2u* slot = (LAS v2u*)(GT + il * PB + e0 * 2);
                  const v2u gw = *slot; const f32x4 gv = *(const f32x4*)(gn + h * 128 + e0);
                  const f32x16& yy = et2 ? y1 : y0;
                  const float o0 = yy[4 * rg] * rstd * gv.x * siluf_(blo(gw.x)), o1 = yy[4 * rg + 1] * rstd * gv.y * siluf_(bhi(gw.x));
                  const float o2 = yy[4 * rg + 2] * rstd * gv.z * siluf_(blo(gw.y)), o3 = yy[4 * rg + 3] * rstd * gv.w * siluf_(bhi(gw.y));
                  v2u ow; ow.x = cvtpk(o0, o1); ow.y = cvtpk(o2, o3);
                  *slot = ow; } }
        __syncthreads();
#pragma unroll
        for (int rep = 0; rep < 4; ++rep) { const int idx = tid + 512 * rep, j = idx >> 4, e0 = (idx & 15) * 8;
            *(v4u*)(MIX + blk_off((int)(tok0 + j), h * 128 + e0, DM)) = *(const LAS v4u*)(GT + j * PB + e0 * 2); }
        __syncthreads();
    }
}
constexpr int L_RAW = 0;
constexpr int L_XC = 32768;
constexpr int L_AL = L_XC + 17408;
constexpr int L_BL = L_AL + 32768;
constexpr int L_SEG = L_BL + 32768;
constexpr int L_CAR = L_SEG + 4096;
constexpr int L_CW = L_CAR + 1024;
__device__ __forceinline__ float fsig(float x) { return __builtin_amdgcn_rcpf(1.0f + __builtin_amdgcn_exp2f(-1.4426950408889634f * x)); }
__device__ __forceinline__ void lru_unit(Frame& F, const Args& A, int b, int n) {
    LAS unsigned char* RAW = F.lds + L_RAW; LAS unsigned char* XC = F.lds + L_XC; LAS float* AL = (LAS float*)(F.lds + L_AL); LAS float* BL = (LAS float*)(F.lds + L_BL);
    LAS float* SEGA = (LAS float*)(F.lds + L_SEG); LAS float* SEGB = SEGA + 512; LAS float* CAR = (LAS float*)(F.lds + L_CAR);
    const bf16* PROJ = (const bf16*)(F.ws + WS_PROJ); bf16* MIX = (bf16*)(F.ws + WS_H);
    const bf16* waT = (const bf16*)(F.ws + WS_GT); const bf16* wxT = waT + 8 * 128 * 128;
    const int tid = F.tid, lane = F.lane, wave = F.wave, c = lane & 31, hi = lane >> 5, et = wave & 3, tt = wave >> 2;
    const int e = 32 * et + c, ce = n * 128 + e;
    s16x8 wfa[8], wfx[8];
#pragma unroll
    for (int ks = 0; ks < 8; ++ks) { wfa[ks] = *(const s16x8*)(waT + (size_t)ce * 128 + 16 * ks + 8 * hi); wfx[ks] = *(const s16x8*)(wxT + (size_t)ce * 128 + 16 * ks + 8 * hi); }
    const float bae = A.in[8][ce], bxe = A.in[10][ce], spe = ((const float*)(F.ws + WS_SP))[ce];
    const int c0 = 8 * (tid & 15);
    LAS float* CW = (LAS float*)(F.lds + L_CW);
    if (tid < 128) { CW[512 + tid] = A.in[6][n * 128 + tid];
#pragma unroll
        for (int j = 0; j < 4; ++j) CW[j * 128 + tid] = A.in[5][j * 1024 + n * 128 + tid]; }
    const bf16* xrb = PROJ + (size_t)b * SEQ * E_IN + C0_XR + n * 128;
    const bf16* yrb = PROJ + (size_t)b * SEQ * E_IN + C0_YR + n * 128;
    bf16* outb = MIX + (size_t)b * SEQ * DM + 1024 + n * 128;
    const int ch = tid & 127, seg = tid >> 7;
    if (tid < 128) CAR[tid] = 0.f;
    if (tid < 48) *(LAS v4u*)(RAW + (125 + tid / 16) * 256 + (tid & 15) * 16) = (v4u){0u, 0u, 0u, 0u};
#pragma unroll
    for (int rep = 0; rep < 2; ++rep) { const int idx = tid + 512 * rep, r = idx >> 4, o = idx & 15; *(LAS v4u*)(RAW + r * 256 + o * 16) = *(const v4u*)(PROJ + blk_off(b * SEQ + r, C0_XR + n * 128 + o * 8, E_IN)); }
    __syncthreads();
    for (int k = 0; k < SEQ / 64; ++k) {
        const int t0 = 64 * k;
        v4u pre[2];
        if (k + 1 < SEQ / 64) {
#pragma unroll
            for (int rep = 0; rep < 2; ++rep) { const int idx = tid + 512 * rep, r = idx >> 4, o = idx & 15; pre[rep] = *(const v4u*)(PROJ + blk_off(b * SEQ + t0 + 64 + r, C0_XR + n * 128 + o * 8, E_IN)); } }
        else { pre[0] = (v4u){0u, 0u, 0u, 0u}; pre[1] = pre[0]; }
        unsigned yv[8];
#pragma unroll
        for (int r = 0; r < 8; ++r) yv[r] = (unsigned)PROJ[blk_off(b * SEQ + t0 + 16 * seg + 2 * r, C0_YR + n * 128 + ch, E_IN)] | ((unsigned)PROJ[blk_off(b * SEQ + t0 + 16 * seg + 2 * r + 1, C0_YR + n * 128 + ch, E_IN)] << 16);
#pragma unroll
        for (int rep = 0; rep < 2; ++rep) { const int tl = (tid >> 4) + 32 * rep, t = t0 + tl; float acc[8];
            { const f32x4 b0 = *(const LAS f32x4*)(CW + 512 + c0), b1 = *(const LAS f32x4*)(CW + 512 + c0 + 4);
              acc[0] = b0.x; acc[1] = b0.y; acc[2] = b0.z; acc[3] = b0.w; acc[4] = b1.x; acc[5] = b1.y; acc[6] = b1.z; acc[7] = b1.w; }
#pragma unroll
            for (int j = 0; j < 4; ++j) { const v4u xv = *(const LAS v4u*)(RAW + ((t - 3 + j) & 127) * 256 + c0 * 2);
                const f32x4 w0 = *(const LAS f32x4*)(CW + j * 128 + c0), w1 = *(const LAS f32x4*)(CW + j * 128 + c0 + 4);
                acc[0] += w0.x * blo(xv[0]); acc[1] += w0.y * bhi(xv[0]); acc[2] += w0.z * blo(xv[1]); acc[3] += w0.w * bhi(xv[1]);
                acc[4] += w1.x * blo(xv[2]); acc[5] += w1.y * bhi(xv[2]); acc[6] += w1.z * blo(xv[3]); acc[7] += w1.w * bhi(xv[3]); }
            v4u w;
#pragma unroll
            for (int q = 0; q < 4; ++q) w[q] = cvtpk(acc[2 * q], acc[2 * q + 1]);
            *(LAS v4u*)(XC + tl * PB + c0 * 2) = w; }
        __syncthreads();
        { f32x16 ra = {}, ia = {};
#pragma unroll
          for (int ks = 0; ks < 8; ++ks) { const s16x8 a = *(const LAS s16x8*)(XC + (32 * tt + c) * PB + (16 * ks + 8 * hi) * 2); ra = MFMA32(a, wfa[ks], ra); ia = MFMA32(a, wfx[ks], ia); }
#pragma unroll
          for (int r = 0; r < 16; ++r) { const int tl = 32 * tt + crow(r, hi);
              const float rg = fsig(ra[r] + bae), ig = fsig(ia[r] + bxe);
              const float la2 = -16.0f * rg * spe;
              const float a = __builtin_amdgcn_exp2f(0.7213475204444817f * la2);
              const float em = (la2 > -0.05f) ? -la2 * (1.0f + la2 * (0.5f + la2 * (0.16666667f + la2 * 0.041666668f))) : 1.0f - a * a;
              const float x = bf2f(*(const LAS bf16*)(XC + tl * PB + e * 2));
              AL[tl * 128 + e] = a; BL[tl * 128 + e] = __builtin_amdgcn_sqrtf(fmaxf(em, 0.f)) * (ig * x); } }
        __syncthreads();
        { float As = 1.f, Bs = 0.f;
#pragma unroll
          for (int r = 0; r < 16; ++r) { const float a = AL[(16 * seg + r) * 128 + ch], bb = BL[(16 * seg + r) * 128 + ch]; Bs = a * Bs + bb; As *= a; }
          SEGA[seg * 128 + ch] = As; SEGB[seg * 128 + ch] = Bs; }
#pragma unroll
        for (int rep = 0; rep < 2; ++rep) { const int idx = tid + 512 * rep, r = idx >> 4, o = idx & 15; *(LAS v4u*)(RAW + (((t0 + 64 + r) & 127)) * 256 + o * 16) = pre[rep]; }
        __syncthreads();
        { float hs = CAR[(k & 1) * 128 + ch];
#pragma unroll
          for (int s = 0; s < 3; ++s) if (s < seg) hs = SEGA[s * 128 + ch] * hs + SEGB[s * 128 + ch];
#pragma unroll
          for (int r = 0; r < 16; ++r) { const float a = AL[(16 * seg + r) * 128 + ch], bb = BL[(16 * seg + r) * 128 + ch]; hs = a * hs + bb;
              const float y = (r & 1) ? bhi(yv[r >> 1]) : blo(yv[r >> 1]); const float u = 0.7978845608028654f * (y + 0.044715f * y * y * y);
              const float th = 1.0f - 2.0f * __builtin_amdgcn_rcpf(1.0f + __builtin_amdgcn_exp2f(2.885390081777927f * u));
              MIX[blk_off(b * SEQ + t0 + 16 * seg + r, 1024 + n * 128 + ch, DM)] = (bf16)f2bf(hs * 0.5f * y * (1.0f + th)); }
          if (seg == 3) CAR[((k + 1) & 1) * 128 + ch] = hs; }
    }
}
#undef MFMA32
}
__device__ __forceinline__ void drain_conv_queue(Frame& F, const Args& A, int ctr_word, int lo, int hi) {
    unsigned* ctr = (unsigned*)(F.ws + WS_CTL) + ctr_word; LAS unsigned* slot = (LAS unsigned*)(F.lds + 8 * 17408); LAS unsigned char* scr = F.lds + F.wave * 17408;
    for (;;) { __syncthreads();
        if (F.tid == 0) *slot = __hip_atomic_fetch_add(ctr, 8u, __ATOMIC_RELAXED, __HIP_MEMORY_SCOPE_AGENT);
        __syncthreads();
        const int base = lo + (int)*slot; if (base >= hi) break;
        const int it = base + F.wave; if (it < hi) conv_l1_item(F, A, it, scr); }
}
__device__ __forceinline__ void ph_mixer0(Frame& F, const Args& A) {
#if MIXER0 == 3
    for (int u = F.vcu; u < 128; u += F.G) { __syncthreads(); ret_naive_unit(F, A, u >> 3, u & 7); }
#else
#if PROBE_DUP == 21
    for (int rep_ = 0; rep_ < 2; ++rep_)
#endif
    for (int u = F.vcu; u < 128; u += F.G) { __syncthreads(); mx::ret_unit(F, A, u >> 3, u & 7); }
#endif
#if MIXER0 == 2
    for (int u = F.vcu; u < 256; u += F.G) { if (u < 128) continue; __syncthreads(); lru_naive_unit(F, A, (u - 128) >> 3, (u - 128) & 7); }
#else
#if PROBE_DUP == 22
    for (int rep_ = 0; rep_ < 2; ++rep_)
#endif
    for (int u = F.vcu; u < 256; u += F.G) { if (u < 128) continue; __syncthreads(); mx::lru_unit(F, A, (u - 128) >> 3, (u - 128) & 7); }
#endif
#if DEFER_L1
    drain_conv_queue(F, A, 2048, L1_I0 + L1_I1, L1_I0 + L1_I1);
#endif
}
__device__ __forceinline__ void ph_act_naive(Frame& F, const bf16* GUB, bf16* ACT, const float* cw, const float* cb, int Mh) {
    const int gt = F.vcu * NTHR + F.tid, NT = F.G * NTHR; const int nrb = Mh / 32;
    for (int it = gt; it < nrb * 704; it += NT) {
        const int oct = it % 704, rb = it / 704, c0 = oct * 8, gcol = (c0 >> 7) * 256 + (c0 & 127);
        float w0[8], w1[8], w2[8], bb[8];
#pragma unroll
        for (int k = 0; k < 8; ++k) { w0[k] = cw[c0 + k]; w1[k] = cw[DFF + c0 + k]; w2[k] = cw[2 * DFF + c0 + k]; bb[k] = cb[c0 + k]; }
        const int r0 = rb * 32; const bool first = (r0 % SEQ) == 0;
        float g1[8], g2[8];
        { v4u a = (v4u){0u, 0u, 0u, 0u}, c = a; if (!first) { a = *(const v4u*)(GUB + (size_t)(r0 - 2) * GUW + gcol); c = *(const v4u*)(GUB + (size_t)(r0 - 1) * GUW + gcol); }
#pragma unroll
          for (int k = 0; k < 4; ++k) { g2[2 * k] = __uint_as_float(a[k] << 16); g2[2 * k + 1] = __uint_as_float(a[k] & 0xffff0000u); g1[2 * k] = __uint_as_float(c[k] << 16); g1[2 * k + 1] = __uint_as_float(c[k] & 0xffff0000u); } }
        for (int r = r0; r < r0 + 32; ++r) {
            const v4u gv = *(const v4u*)(GUB + (size_t)r * GUW + gcol), uv = *(const v4u*)(GUB + (size_t)r * GUW + gcol + 128);
            float g[8], u[8], o[8];
#pragma unroll
            for (int k = 0; k < 4; ++k) { g[2 * k] = __uint_as_float(gv[k] << 16); g[2 * k + 1] = __uint_as_float(gv[k] & 0xffff0000u); u[2 * k] = __uint_as_float(uv[k] << 16); u[2 * k + 1] = __uint_as_float(uv[k] & 0xffff0000u); }
#pragma unroll
            for (int k = 0; k < 8; ++k) { const float v = bb[k] + w0[k] * g2[k] + w1[k] * g1[k] + w2[k] * g[k]; o[k] = siluf_(v) * u[k]; g2[k] = g1[k]; g1[k] = g[k]; }
            v4u ov; ov.x = pk2(o[0], o[1]); ov.y = pk2(o[2], o[3]); ov.z = pk2(o[4], o[5]); ov.w = pk2(o[6], o[7]);
            *(v4u*)(ACT + (size_t)r * DFF + c0) = ov;
        }
    }
}
__device__ __forceinline__ unsigned ord_key(float f) { const unsigned u = __float_as_uint(f); return (u & 0x80000000u) ? ~u : (u | 0x80000000u); }
__device__ __forceinline__ void ph_dsa_naive(Frame& F) {
    LAS float* qil = (LAS float*)(F.lds);
    LAS float* wl = (LAS float*)(F.lds + 4096);
    LAS float* ql = (LAS float*)(F.lds + 8192);
    LAS unsigned* sc = (LAS unsigned*)(F.lds + 16384);
    LAS int* idxl = (LAS int*)(F.lds + 24576);
    LAS float* pl = (LAS float*)(F.lds + 25600);
    LAS float* red = (LAS float*)(F.lds + 26624);
    LAS int* cntl = (LAS int*)(F.lds + 26752);
    LAS int* wtot = (LAS int*)(F.lds + 26880);
    LAS float* op = (LAS float*)(F.lds + 28672);
    const bf16* P1 = (const bf16*)(F.ws + WS_PROJ); bf16* ATT = (bf16*)(F.ws + WS_H); const float* tb = (const float*)(F.ws + WS_TB);
    const int tid = F.tid, lane = F.lane, wave = F.wave;
    for (int unit = F.vcu; unit < MTOK; unit += F.G) {
        const int b = unit >> 11, t = unit & 2047; const bf16* P = P1 + (size_t)unit * O_INP;
        for (int i = tid; i < 1024; i += NTHR) qil[i] = bf2f(P[C1_QI + i]);
        if (tid < 16) wl[tid] = bf2f(P[C1_WI + tid]) * 0.03125f;
        for (int i = tid; i < 2048; i += NTHR) ql[i] = bf2f(P[C1_Q + i]);
        __syncthreads();
        bool sel[4];
        if (t >= 256) {
#pragma unroll 1
            for (int j = 0; j < 4; ++j) { const int s = tid + 512 * j; unsigned key = 0u;
                if (s <= t) { const v4u* kp = (const v4u*)(P1 + (size_t)(b * SEQ + s) * O_INP + C1_KI); float kv[64];
#pragma unroll
                    for (int q = 0; q < 8; ++q) { const v4u w = kp[q];
#pragma unroll
                        for (int k = 0; k < 4; ++k) { kv[8 * q + 2 * k] = __uint_as_float(w[k] << 16); kv[8 * q + 2 * k + 1] = __uint_as_float(w[k] & 0xffff0000u); } }
                    float score = 0.f;
#pragma unroll 1
                    for (int h = 0; h < 16; ++h) { float d = 0.f;
#pragma unroll
                        for (int q = 0; q < 16; ++q) { const f32x4 a = *(const LAS f32x4*)(qil + h * 64 + 4 * q); d += a.x * kv[4 * q] + a.y * kv[4 * q + 1] + a.z * kv[4 * q + 2] + a.w * kv[4 * q + 3]; }
                        score += wl[h] * fmaxf(d, 0.f); }
                    key = ord_key(score); }
                sc[s] = key; }
            __syncthreads();
            const unsigned k0 = sc[tid], k1 = sc[tid + 512], k2 = sc[tid + 1024], k3 = sc[tid + 1536];
            unsigned T = 0u;
#pragma unroll 1
            for (int bit = 31; bit >= 0; --bit) { const unsigned cand = T | (1u << bit);
                int c = (k0 >= cand) + (k1 >= cand) + (k2 >= cand) + (k3 >= cand); c = wave_sum_i(c);
                if (lane == 0) cntl[(bit & 1) * 8 + wave] = c;
                __syncthreads();
                int tot = 0;
#pragma unroll
                for (int w = 0; w < 8; ++w) tot += cntl[(bit & 1) * 8 + w];
                if (tot >= 256) T = cand; }
            int cg = (k0 > T) + (k1 > T) + (k2 > T) + (k3 > T), ce = (k0 == T) + (k1 == T) + (k2 == T) + (k3 == T);
            cg = wave_sum_i(cg); ce = wave_sum_i(ce);
            __syncthreads();
            if (lane == 0) { cntl[wave] = cg; cntl[8 + wave] = ce; }
            __syncthreads();
            int ngt = 0, neq = 0;
#pragma unroll
            for (int w = 0; w < 8; ++w) { ngt += cntl[w]; neq += cntl[8 + w]; }
            const int need = 256 - ngt;
            if (neq > need) {
                if (tid == 0) { int taken = 0; for (int s = 0; s <= t; ++s) if (sc[s] == T) { if (taken < need) ++taken; else sc[s] = 0u; } }
                __syncthreads();
            }
#pragma unroll
            for (int j = 0; j < 4; ++j) { const int s = tid + 512 * j; sel[j] = (s <= t) && (sc[s] >= T); }
        } else {
#pragma unroll
            for (int j = 0; j < 4; ++j) sel[j] = (tid + 512 * j) <= t;
        }
        int pre[4];
#pragma unroll
        for (int j = 0; j < 4; ++j) { const unsigned long long bal = __ballot(sel[j]); pre[j] = __popcll(bal & ((1ull << lane) - 1ull)); if (lane == 0) wtot[j * 8 + wave] = __popcll(bal); }
        __syncthreads();
        int nsel = 0;
        { int run = 0; int base[4];
#pragma unroll
          for (int j = 0; j < 4; ++j) {
#pragma unroll
              for (int w = 0; w < 8; ++w) { if (w == wave) base[j] = run; run += wtot[j * 8 + w]; } }
          nsel = run;
#pragma unroll
          for (int j = 0; j < 4; ++j) if (sel[j]) idxl[base[j] + pre[j]] = tid + 512 * j; }
        __syncthreads();
        for (int hq = 0; hq < 16; ++hq) { const int kvh = hq >> 2;
            float logit = -INFINITY;
            if (tid < nsel) { const int s = idxl[tid]; const v4u* kp = (const v4u*)(P1 + (size_t)(b * SEQ + s) * O_INP + C1_K + kvh * 128); float d = 0.f;
#pragma unroll
                for (int q = 0; q < 16; ++q) { const v4u w = kp[q]; const f32x4 a0 = *(const LAS f32x4*)(ql + hq * 128 + 8 * q), a1 = *(const LAS f32x4*)(ql + hq * 128 + 8 * q + 4);
                    d += a0.x * __uint_as_float(w.x << 16) + a0.y * __uint_as_float(w.x & 0xffff0000u) + a0.z * __uint_as_float(w.y << 16) + a0.w * __uint_as_float(w.y & 0xffff0000u)
                       + a1.x * __uint_as_float(w.z << 16) + a1.y * __uint_as_float(w.z & 0xffff0000u) + a1.z * __uint_as_float(w.w << 16) + a1.w * __uint_as_float(w.w & 0xffff0000u); }
                const int dist = t - s; logit = d * 0.08838834764831845f + tb[(dist < 127 ? dist : 127) * 16 + hq]; }
            float mx = wave_max(logit); if (lane == 0) red[wave] = mx;
            __syncthreads();
            mx = fmaxf(fmaxf(fmaxf(red[0], red[1]), fmaxf(red[2], red[3])), fmaxf(fmaxf(red[4], red[5]), fmaxf(red[6], red[7])));
            const float p = (tid < nsel) ? __expf(logit - mx) : 0.f;
            if (tid < 256) pl[tid] = p;
            float sm = wave_sum(p); if (lane == 0) red[8 + wave] = sm;
            __syncthreads();
            sm = ((red[8] + red[9]) + (red[10] + red[11])) + ((red[12] + red[13]) + (red[14] + red[15]));
            { const int d = tid & 127, part = tid >> 7; float a = 0.f; const int j1 = (part * 64 + 64) < nsel ? (part * 64 + 64) : nsel;
              for (int j = part * 64; j < j1; ++j) a += pl[j] * bf2f(P1[(size_t)(b * SEQ + idxl[j]) * O_INP + C1_V + kvh * 128 + d]);
              op[part * 128 + d] = a; }
            __syncthreads();
            if (tid < 128) ATT[(size_t)unit * DM + hq * 128 + tid] = (bf16)f2bf(((op[tid] + op[128 + tid]) + (op[256 + tid] + op[384 + tid])) / sm);
            __syncthreads();
        }
    }
}

typedef float f32x16 __attribute__((ext_vector_type(16)));
typedef short s16x8 __attribute__((ext_vector_type(8)));
typedef short s16x4 __attribute__((ext_vector_type(4)));
constexpr int IDX_ROWB = 144;
constexpr int IDX_CHUNK = 256 * IDX_ROWB;
__device__ __forceinline__ int half_sum_i(int v) {
#pragma unroll
    for (int o = 1; o < 32; o <<= 1) v += __shfl_xor(v, o);
    return v;
}
__device__ __forceinline__ void half_sums(int v, int& s0, int& s1) {
    v += __builtin_amdgcn_update_dpp(0, v, 0x111, 0xf, 0xf, true);
    v += __builtin_amdgcn_update_dpp(0, v, 0x112, 0xf, 0xf, true);
    v += __builtin_amdgcn_update_dpp(0, v, 0x114, 0xf, 0xf, true);
    v += __builtin_amdgcn_update_dpp(0, v, 0x118, 0xf, 0xf, true);
    s0 = __builtin_amdgcn_readlane(v, 15) + __builtin_amdgcn_readlane(v, 31); s1 = __builtin_amdgcn_readlane(v, 47) + __builtin_amdgcn_readlane(v, 63);
}
typedef unsigned short us2 __attribute__((ext_vector_type(2)));
__device__ __forceinline__ void ph_indexer(Frame& F) {
    const bf16* P1 = (const bf16*)(F.ws + WS_PROJ); unsigned* SEL = (unsigned*)(F.ws + WS_SEL);
    const int wave = F.wave;
    LAS unsigned char* kl = F.lds;
    bool pref = false;
    for (int u = F.vcu; u < 2048; u += F.G) {
        const int it = u >> 8, cc = u & 255, tg0 = cc & 127, tg = (it & 1) ? 127 - tg0 : tg0, b = (cc >> 7) + 2 * it;
        int tid = F.tid; asm volatile("" : "+v"(tid));
        const int lane = tid & 63, c = lane & 31, hh = lane >> 5;
        const int t0 = tg * 16, tq = t0 + 2 * wave + hh;
        unsigned* selb = SEL + (size_t)b * 32 * SEQ * 2; const int tw0 = t0 + 2 * wave;
        if (t0 < 256) {
#pragma unroll
            for (int q = 0; q < 2; ++q) { const int t = tw0 + q, lo = 32 * lane;
                selb[((size_t)(lane >> 1) * SEQ + t) * 2 + (lane & 1)] = (t >= lo + 31) ? 0xffffffffu : (t < lo ? 0u : ((2u << (t - lo)) - 1u)); }
            pref = false; continue;
        }
        LAS unsigned char* pf = kl + 2 * IDX_CHUNK + 4096 + 8192 + wave * 6144;
#define PF_DMA(bb, tt0) do { const int qrw_ = (bb) * SEQ + (tt0) + 2 * wave + ((c >> 2) & 1), qcl_ = C1_QI + ((c & 3) + 4 * (c >> 3)) * 64 + 8 * hh; \
            _Pragma("unroll") for (int ks = 0; ks < 4; ++ks) __builtin_amdgcn_global_load_lds((const unsigned*)(P1 + blk_off(qrw_, qcl_ + 16 * ks, O_INP)), (LAS unsigned*)(pf + ks * 1024), 16, 0, 0); \
            const bf16* wp_ = P1 + blk_off((bb) * SEQ + (tt0) + 2 * wave + hh, C1_WI, O_INP); \
            __builtin_amdgcn_global_load_lds((const unsigned*)wp_, (LAS unsigned*)(pf + 4096), 16, 0, 0); __builtin_amdgcn_global_load_lds((const unsigned*)(wp_ + 8), (LAS unsigned*)(pf + 5120), 16, 0, 0); } while (0)
        const int nch = (t0 + 15) / 256 + 1;
        const bf16* kib = P1 + (size_t)(b * SEQ) * O_INP + C1_KI;
        if (!pref) __syncthreads();
#define IDX_DMA_B(b, chunk, buf) do { _Pragma("unroll") for (int n_ = 0; n_ < 5; ++n_) { const int n = wave + 8 * n_; if (n < 36) { const int q = 64 * n + lane, row = q / 9, sg0 = q - 9 * row, sg = sg0 < 8 ? sg0 : 7; \
            __builtin_amdgcn_global_load_lds((const unsigned*)(P1 + blk_off(b * SEQ + (chunk) * 256 + row, C1_KI + sg * 8, O_INP)), (LAS unsigned*)(kl + (buf) * IDX_CHUNK + n * 1024), 16, 0, 0); } } } while (0)
#define IDX_DMA(chunk, buf) IDX_DMA_B(b, chunk, buf)
        if (!pref) { IDX_DMA(0, 0); PF_DMA(b, t0); }
        __syncthreads();
        s16x8 Afr[4];
#pragma unroll
        for (int ks = 0; ks < 4; ++ks) Afr[ks] = *(const LAS s16x8*)(pf + ks * 1024 + lane * 16);
        const v4u w0 = *(const LAS v4u*)(pf + 4096 + lane * 16), w1 = *(const LAS v4u*)(pf + 5120 + lane * 16);
        float wv[16];
        {
#pragma unroll
          for (int k = 0; k < 4; ++k) { wv[2 * k] = __uint_as_float(w0[k] << 16) * 0.03125f; wv[2 * k + 1] = __uint_as_float(w0[k] & 0xffff0000u) * 0.03125f;
              wv[8 + 2 * k] = __uint_as_float(w1[k] << 16) * 0.03125f; wv[8 + 2 * k + 1] = __uint_as_float(w1[k] & 0xffff0000u) * 0.03125f; } }
        unsigned key[64];
#pragma unroll
        for (int ch = 0; ch < 8; ++ch) {
            if (ch < nch) {
                if (ch < 7) IDX_DMA(ch + 1, (ch + 1) & 1);
                const LAS unsigned char* kb = kl + (ch & 1) * IDX_CHUNK;
#pragma unroll
                for (int tp = 0; tp < 4; ++tp) { const int tl = 2 * tp, T = ch * 8 + tl;
                    if (32 * (T + 1) <= t0 + 15) {
                        f32x16 acc = {0.f, 0.f, 0.f, 0.f, 0.f, 0.f, 0.f, 0.f, 0.f, 0.f, 0.f, 0.f, 0.f, 0.f, 0.f, 0.f}, acd = acc;
#pragma unroll
                        for (int ks = 0; ks < 4; ++ks) { const s16x8 Bfr = *(const LAS s16x8*)(kb + (tl * 32 + c) * IDX_ROWB + ks * 32 + hh * 16), Bfs = *(const LAS s16x8*)(kb + (tl * 32 + 32 + c) * IDX_ROWB + ks * 32 + hh * 16);
                            acc = __builtin_amdgcn_mfma_f32_32x32x16_bf16(Afr[ks], Bfr, acc, 0, 0, 0); acd = __builtin_amdgcn_mfma_f32_32x32x16_bf16(Afr[ks], Bfs, acd, 0, 0, 0); }
                        float sc = 0.f, sd = 0.f;
#pragma unroll
                        for (int i = 0; i < 16; ++i) { const int rb = (int)__float_as_uint(acc[i]), rd = (int)__float_as_uint(acd[i]);
                            sc = fmaf(wv[i], __uint_as_float((unsigned)(rb > 0 ? rb : 0)), sc); sd = fmaf(wv[i], __uint_as_float((unsigned)(rd > 0 ? rd : 0)), sd); }
                        key[T] = (32 * T + c <= tq) ? ord_key(sc) : 0u; key[T + 1] = (32 * T + 32 + c <= tq) ? ord_key(sd) : 0u;
                        __builtin_amdgcn_sched_barrier(0);
                    } else if (32 * T <= t0 + 15) {
                        f32x16 acc = {0.f, 0.f, 0.f, 0.f, 0.f, 0.f, 0.f, 0.f, 0.f, 0.f, 0.f, 0.f, 0.f, 0.f, 0.f, 0.f};
#pragma unroll
                        for (int ks = 0; ks < 4; ++ks) { const s16x8 Bfr = *(const LAS s16x8*)(kb + (tl * 32 + c) * IDX_ROWB + ks * 32 + hh * 16);
                            acc = __builtin_amdgcn_mfma_f32_32x32x16_bf16(Afr[ks], Bfr, acc, 0, 0, 0); }
                        float sc = 0.f;
#pragma unroll
                        for (int i = 0; i < 16; ++i) { const int rb = (int)__float_as_uint(acc[i]); sc = fmaf(wv[i], __uint_as_float((unsigned)(rb > 0 ? rb : 0)), sc); }
                        key[T] = (32 * T + c <= tq) ? ord_key(sc) : 0u; key[T + 1] = 0u;
                        __builtin_amdgcn_sched_barrier(0);
                    } else { key[T] = 0u; key[T + 1] = 0u; }
                }
                __syncthreads();
            } else {
#pragma unroll
                for (int tl = 0; tl < 8; ++tl) key[ch * 8 + tl] = 0u;
            }
        }
        { const int un = u + F.G; pref = false;
          if (un < 2048) { const int itn = un >> 8, ccn = un & 255, tg0n = ccn & 127, tgn = (itn & 1) ? 127 - tg0n : tg0n, bn = (ccn >> 7) + 2 * itn;
              if (tgn * 16 >= 256) { IDX_DMA_B(bn, 0, 0); PF_DMA(bn, tgn * 16); pref = true; } } }
#undef PF_DMA
#undef IDX_DMA
#undef IDX_DMA_B
        unsigned T0 = 0u, T1 = 0u; int A0 = 1 << 20, A1 = 1 << 20;
        bool compact = false; int G0 = 0, G1 = 0; unsigned cs0 = 0u, cs1 = 0u, cs2 = 0u, cs3 = 0u;
        unsigned hp[32];
#pragma unroll
        for (int j = 0; j < 32; ++j) hp[j] = __builtin_amdgcn_perm(key[2 * j + 1], key[2 * j], 0x07060302u);
#pragma unroll 1
        for (int bit = 31; bit >= 0; --bit) {
            if (bit == 15) { const unsigned Th = (hh ? T1 : T0) >> 16; LAS unsigned* cs = (LAS unsigned*)(kl + 2 * IDX_CHUNK + 4096 + wave * 1024) + lane; int n = 0;
#pragma unroll
                for (int g8 = 0; g8 < 8; ++g8) if (g8 < nch) {
#pragma unroll
                    for (int i = 0; i < 8; ++i) { const unsigned kv = key[g8 * 8 + i]; if ((kv >> 16) == Th) { if (n < 4) cs[n * 64] = (kv & 0xffffu) + 1u; ++n; } } }
                int q0, q1; half_sums(n, q0, q1);
                if (!__any(n > 4)) { compact = true; G0 = A0 - q0; G1 = A1 - q1;
                    asm volatile("s_waitcnt lgkmcnt(0)" ::: "memory");
                    const unsigned r0 = cs[0], r1 = cs[64], r2 = cs[128], r3 = cs[192]; cs0 = n > 0 ? r0 : 0u; cs1 = n > 1 ? r1 : 0u; cs2 = n > 2 ? r2 : 0u; cs3 = n > 3 ? r3 : 0u; } }
            const unsigned c0 = T0 | (1u << bit), c1 = T1 | (1u << bit), cand = hh ? c1 : c0; int cnt = 0;
            if (bit >= 16) {
                const unsigned cm = (cand >> 16) - 1u, pr = cm | (cm << 16), one2 = 0x00010001u; unsigned accp = 0u;
#pragma unroll
                for (int g8 = 0; g8 < 8; ++g8) if (g8 < nch) {
#pragma unroll
                    for (int i = 0; i < 4; ++i) { unsigned d_, f_; asm("v_pk_sub_u16 %0, %1, %2 clamp" : "=v"(d_) : "v"(hp[g8 * 4 + i]), "v"(pr)); asm("v_pk_min_u16 %0, %1, %2" : "=v"(f_) : "v"(d_), "v"(one2));
                        asm("v_pk_add_u16 %0, %1, %2" : "=v"(accp) : "v"(accp), "v"(f_)); } }
                cnt = (int)((accp & 0xffffu) + (accp >> 16));
            } else if (compact) { const unsigned cl = (cand & 0xffffu) + 1u;
                cnt = (cs0 >= cl ? 1 : 0) + (cs1 >= cl ? 1 : 0) + (cs2 >= cl ? 1 : 0) + (cs3 >= cl ? 1 : 0);
            } else {
#pragma unroll
            for (int g8 = 0; g8 < 8; ++g8) if (g8 < nch) {
#pragma unroll
                for (int i = 0; i < 8; ++i) cnt += (key[g8 * 8 + i] >= cand) ? 1 : 0; }
            }
            int n0, n1; half_sums(cnt, n0, n1); if (compact) { n0 += G0; n1 += G1; }
            if (n0 >= 256) { T0 = c0; A0 = n0; } if (n1 >= 256) { T1 = c1; A1 = n1; }
            if (n0 == 256 && n1 == 256) break; }
        const unsigned Tm = hh ? T1 : T0;
        LAS unsigned long long* selw = (LAS unsigned long long*)(kl + 2 * IDX_CHUNK + wave * 512);
        if (A0 == 256 && A1 == 256) {
#pragma unroll
            for (int i = 0; i < 64; ++i) { const unsigned long long bs = ((i >> 3) < nch) ? __ballot(key[i] >= Tm) : 0ull; if (lane == 0) selw[i] = bs; }
        } else {
        int cg = 0;
#pragma unroll
        for (int g8 = 0; g8 < 8; ++g8) if (g8 < nch) {
#pragma unroll
            for (int i = 0; i < 8; ++i) cg += (key[g8 * 8 + i] > Tm) ? 1 : 0; }
        int g0, g1; half_sums(cg, g0, g1);
        const int need = 256 - (hh ? g1 : g0);
        int run = 0;
#pragma unroll
        for (int i = 0; i < 64; ++i) { if ((i >> 3) >= nch) { if (lane == 0) selw[i] = 0ull; continue; }
            const bool gt = key[i] > Tm, eq = key[i] == Tm;
            const unsigned long long beq = __ballot(eq); const unsigned meq = hh ? (unsigned)(beq >> 32) : (unsigned)beq;
            const int rank = __popc(meq & ((1u << c) - 1u));
            const bool sl = gt || (eq && (run + rank < need));
            run += __popc(meq);
            const unsigned long long bs = __ballot(sl);
            if (lane == 0) selw[i] = bs; }
        }
        asm volatile("s_waitcnt lgkmcnt(0)" ::: "memory");
        unsigned wlo, whi;
        { const unsigned long long mine = selw[lane]; wlo = (unsigned)mine; whi = (unsigned)(mine >> 32); }
        selb[((size_t)(lane >> 1) * SEQ + tw0) * 2 + (lane & 1)] = wlo; selb[((size_t)(lane >> 1) * SEQ + tw0 + 1) * 2 + (lane & 1)] = whi;
    }
}

namespace att {
constexpr int D = 128, NW = 8, QBLK = 32, KVBLK = 64, LD = O_INP;
constexpr float SCALE = 0.088388347648318440f, THR = 8.f;
constexpr int SHM_V = KVBLK * D * 2, SHM_K = KVBLK * D * 2;
constexpr int OFF_Q = 2 * SHM_V + 2 * SHM_K, OFF_WS = OFF_Q + 65536, OFF_TB = OFF_WS + NW * 64 * 4;
#define KSWZ(row, colB) ((row) * 256 + ((colB) ^ (((row) & 7) << 4)))
#define SBAR() __builtin_amdgcn_sched_barrier(0)
__device__ __forceinline__ int crow(int r, int hi) { return (r & 3) + 8 * (r >> 2) + 4 * hi; }
__device__ __forceinline__ unsigned cvtpk(float lo, float hi) { unsigned r; asm volatile("v_cvt_pk_bf16_f32 %0, %1, %2" : "=v"(r) : "v"(lo), "v"(hi)); return r; }
__device__ __forceinline__ void partialSM(f32x16& p0, f32x16& p1, float& m_reg, float& mn, float& alpha, bool far, float bfar, const LAS float* tbq, int dbase) {
    constexpr float C = SCALE * 1.4426950408889634f;
    float boff = bfar;
    if (!far) { boff = 0.f;
#pragma unroll
        for (int r = 0; r < 16; ++r) { const int cbr = (r & 3) + 8 * (r >> 2);
            p0[r] += tbq[59 - cbr]; p1[r] += tbq[27 - cbr]; }
    }
    float pmax = p0[0];
#pragma unroll
    for (int r = 1; r < 16; ++r) pmax = fmaxf(pmax, p0[r]);
#pragma unroll
    for (int r = 0; r < 16; ++r) pmax = fmaxf(pmax, p1[r]);
    { auto rr = __builtin_amdgcn_permlane32_swap(__float_as_uint(pmax), __float_as_uint(pmax), false, false);
      pmax = fmaxf(__uint_as_float(rr[0]), __uint_as_float(rr[1])) + boff; }
    if (__builtin_expect(__all(pmax - m_reg <= THR / SCALE), 1)) { mn = m_reg; alpha = 1.f; }
    else { mn = fmaxf(m_reg, pmax); alpha = __builtin_amdgcn_exp2f((m_reg - mn) * C); m_reg = mn; }
    const float mnC = (boff - mn) * C;
#pragma unroll
    for (int r = 0; r < 16; ++r) p0[r] = fmaf(p0[r], C, mnC);
#pragma unroll
    for (int r = 0; r < 16; ++r) p1[r] = fmaf(p1[r], C, mnC);
#pragma unroll
    for (int r = 0; r < 16; ++r) p0[r] = __builtin_amdgcn_exp2f(p0[r]);
}
template <int R> __device__ __forceinline__ void mask1(f32x16& p0, f32x16& p1, unsigned m0, unsigned m1) {
    constexpr int cb = (R & 3) + 8 * (R >> 2); int t0, t1;
    asm("v_bfe_i32 %0, %1, %2, 1" : "=v"(t0) : "v"(m0), "n"(cb));
    asm("v_bfe_i32 %0, %1, %2, 1" : "=v"(t1) : "v"(m1), "n"(cb));
    p0[R] = __uint_as_float(__float_as_uint(p0[R]) & (unsigned)t0); p1[R] = __uint_as_float(__float_as_uint(p1[R]) & (unsigned)t1);
}
__device__ __forceinline__ void mask16(f32x16& p0, f32x16& p1, unsigned m0, unsigned m1) {
    mask1<0>(p0, p1, m0, m1); mask1<1>(p0, p1, m0, m1); mask1<2>(p0, p1, m0, m1); mask1<3>(p0, p1, m0, m1); mask1<4>(p0, p1, m0, m1); mask1<5>(p0, p1, m0, m1); mask1<6>(p0, p1, m0, m1); mask1<7>(p0, p1, m0, m1);
    mask1<8>(p0, p1, m0, m1); mask1<9>(p0, p1, m0, m1); mask1<10>(p0, p1, m0, m1); mask1<11>(p0, p1, m0, m1); mask1<12>(p0, p1, m0, m1); mask1<13>(p0, p1, m0, m1); mask1<14>(p0, p1, m0, m1); mask1<15>(p0, p1, m0, m1);
}
__device__ __forceinline__ void finishSM(f32x16& p0, f32x16& p1, float alpha, float& l_reg, unsigned m0, unsigned m1, s16x8& pa0, s16x8& pa1, s16x8& pa2, s16x8& pa3) {
#pragma unroll
    for (int r = 0; r < 16; ++r) p1[r] = __builtin_amdgcn_exp2f(p1[r]);
    mask16(p0, p1, m0, m1);
    float ps = 0.f;
#pragma unroll
    for (int r = 0; r < 16; ++r) ps += p0[r];
#pragma unroll
    for (int r = 0; r < 16; ++r) ps += p1[r];
    { auto rr = __builtin_amdgcn_permlane32_swap(__float_as_uint(ps), __float_as_uint(ps), false, false);
      ps = __uint_as_float(rr[0]) + __uint_as_float(rr[1]); }
    l_reg = l_reg * alpha + ps;
#define PK4(P, BASE, OUT) do { unsigned a0 = cvtpk(P[BASE + 0], P[BASE + 1]), a1 = cvtpk(P[BASE + 2], P[BASE + 3]);   \
    unsigned b0 = cvtpk(P[BASE + 4], P[BASE + 5]), b1 = cvtpk(P[BASE + 6], P[BASE + 7]);                              \
    auto r0 = __builtin_amdgcn_permlane32_swap(a0, b0, false, false); auto r1 = __builtin_amdgcn_permlane32_swap(a1, b1, false, false); \
    v4u w = {r0[0], r1[0], r0[1], r1[1]}; OUT = *reinterpret_cast<s16x8*>(&w); } while (0)
    PK4(p0, 0, pa0); PK4(p0, 8, pa1); PK4(p1, 0, pa2); PK4(p1, 8, pa3);
#undef PK4
}
__device__ __forceinline__ void qkt(f32x16& p0, f32x16& p1, const int (&ka)[4], const int (&qa)[4], int koff) {
    p0 = f32x16{}; p1 = f32x16{};
#pragma unroll
    for (int d0 = 0; d0 < 8; ++d0) {
        const LAS unsigned char* kp = (const LAS unsigned char*)(size_t)(unsigned)ka[d0 & 3] + koff + (d0 >> 2) * 128;
        const LAS unsigned char* qp = (const LAS unsigned char*)(size_t)(unsigned)qa[d0 & 3] + (d0 >> 2) * 128;
        const s16x8 b0 = *(const LAS s16x8*)(kp);
        const s16x8 b1 = *(const LAS s16x8*)(kp + 8192);
        const s16x8 q = *(const LAS s16x8*)(qp);
        p0 = __builtin_amdgcn_mfma_f32_32x32x16_bf16(b0, q, p0, 0, 0, 0);
        p1 = __builtin_amdgcn_mfma_f32_32x32x16_bf16(b1, q, p1, 0, 0, 0); }
}
__device__ __forceinline__ int v_st(int k, int c) { const int kk = (k & ~0xC) | ((k & 4) << 1) | ((k & 8) >> 1); return ((kk >> 3) * 4 + (c >> 5)) * 512 + ((kk & 7) * 32 + (c & 31)) * 2; }
__device__ __forceinline__ int v_rd_base(int lane) { return ((lane & 3) << 3) | (((lane >> 2) & 3) << 6) | (((lane >> 4) & 1) << 5) | (((lane >> 5) & 1) << 8); }
constexpr int v_rd_off(int d0, int ks, int half) { return d0 * 512 + ks * 4096 + half * 2048; }
template <int OFF> __device__ __forceinline__ s16x4 tr_read(int vb) {
    s16x4 r; asm volatile("ds_read_b64_tr_b16 %0, %1 offset:%2" : "=&v"(r) : "v"(vb), "i"(OFF) : "memory"); return r;
}
template <int D0> __device__ __forceinline__ void pv_one(f32x16& od, int vb, s16x8 pa0, s16x8 pa1, s16x8 pa2, s16x8 pa3) {
    const s16x4 l0 = tr_read<v_rd_off(D0, 0, 0)>(vb), h0 = tr_read<v_rd_off(D0, 0, 1)>(vb), l1 = tr_read<v_rd_off(D0, 1, 0)>(vb), h1 = tr_read<v_rd_off(D0, 1, 1)>(vb);
    const s16x4 l2 = tr_read<v_rd_off(D0, 2, 0)>(vb), h2 = tr_read<v_rd_off(D0, 2, 1)>(vb), l3 = tr_read<v_rd_off(D0, 3, 0)>(vb), h3 = tr_read<v_rd_off(D0, 3, 1)>(vb);
    asm volatile("s_waitcnt lgkmcnt(0)" ::: "memory"); SBAR();
#define PK(L, H) (s16x8){L[0], L[1], L[2], L[3], H[0], H[1], H[2], H[3]}
    od = __builtin_amdgcn_mfma_f32_32x32x16_bf16(pa0, PK(l0, h0), od, 0, 0, 0);
    od = __builtin_amdgcn_mfma_f32_32x32x16_bf16(pa1, PK(l1, h1), od, 0, 0, 0);
    od = __builtin_amdgcn_mfma_f32_32x32x16_bf16(pa2, PK(l2, h2), od, 0, 0, 0);
    od = __builtin_amdgcn_mfma_f32_32x32x16_bf16(pa3, PK(l3, h3), od, 0, 0, 0);
#undef PK
}
__device__ __forceinline__ void pv_d0(f32x16* o, int vb, s16x8 pa0, s16x8 pa1, s16x8 pa2, s16x8 pa3) {
    pv_one<0>(o[0], vb, pa0, pa1, pa2, pa3); pv_one<1>(o[1], vb, pa0, pa1, pa2, pa3); pv_one<2>(o[2], vb, pa0, pa1, pa2, pa3); pv_one<3>(o[3], vb, pa0, pa1, pa2, pa3);
}
__device__ __forceinline__ void attn_unit(const bf16* __restrict__ Qb, int qrow0, int qcol0, int krow0, int kcol0, int vcol0, bf16* __restrict__ Ob, int orow0, int ocol0, int NT,
                                          const unsigned* __restrict__ selq, int i0, LAS unsigned char* lds, float tbv) {
    int tid_ = threadIdx.x; asm volatile("" : "+v"(tid_));
    const int tid = tid_, wid = __builtin_amdgcn_readfirstlane(tid >> 6), lane = tid & 63, r32 = lane & 31, hi = lane >> 5;
    LAS unsigned char* V_lds = lds; LAS unsigned char* K_lds = lds + 2 * SHM_V;
    LAS float* ws = (LAS float*)(lds + OFF_WS) + wid * 64; LAS float* li_l = ws; LAS float* al_l = ws + 32;
    const LAS float* tbq = (const LAS float*)(lds + OFF_TB);
    const int tq = i0 + wid * QBLK + r32, tqmin = i0 + wid * QBLK;
    float m_reg = -1e30f, l_reg = 0.f; f32x16 o[4] = {};
    LAS unsigned char* Q_lds = lds + OFF_Q; const int qrow = wid * QBLK + r32;
    const int sr = tid >> 4, sc = (tid & 15) * 8;
    const int vb0 = (int)(unsigned)(size_t)V_lds + v_rd_base(lane);
    { const int tcQ = (int)blk_off(sr, qcol0 + sc, LD);
#pragma unroll
      for (int r = 0; r < 8; ++r) { const int row = sr + 32 * r; *(LAS s16x8*)(Q_lds + KSWZ(row, sc * 2)) = *(const s16x8*)(Qb + (size_t)(qrow0 + 32 * r) * LD + tcQ); } }
    int gK, gV;
    { const int L = tid * 16;
      { const int row = L >> 8, cb = (L & 255) ^ ((row & 7) << 4); gK = (int)blk_off(row, kcol0 + (cb >> 1), LD); }
      { const int s = L >> 9, w = (L & 511) >> 1, kk = ((s >> 2) << 3) | (w >> 5), k = (kk & ~0xC) | ((kk & 4) << 1) | ((kk & 8) >> 1), c = (s & 3) * 32 + (w & 31); gV = (int)blk_off(k, vcol0 + c, LD); } }
    const int dmaw = __builtin_amdgcn_readfirstlane(wid) * 1024;
    int ka[4], qa[4];
#pragma unroll
    for (int i = 0; i < 4; ++i) { ka[i] = (int)(unsigned)(size_t)K_lds + KSWZ(r32, i * 32 + hi * 16); qa[i] = (int)(unsigned)(size_t)Q_lds + KSWZ(qrow, i * 32 + hi * 16); }
#define KDMA(b, k0) do { const bf16* tb_ = Qb + (size_t)(krow0 + (k0)) * LD; _Pragma("unroll") for (int i_ = 0; i_ < 2; ++i_) \
    __builtin_amdgcn_global_load_lds((const unsigned*)(tb_ + (size_t)i_ * 32 * LD + gK), (LAS unsigned*)(K_lds + (b) * SHM_K + dmaw + i_ * 8192), 16, 0, 0); } while (0)
#define VDMA(b, k0) do { const bf16* tb_ = Qb + (size_t)(krow0 + (k0)) * LD; _Pragma("unroll") for (int i_ = 0; i_ < 2; ++i_) \
    __builtin_amdgcn_global_load_lds((const unsigned*)(tb_ + (size_t)i_ * 32 * LD + gV), (LAS unsigned*)(V_lds + (b) * SHM_V + dmaw + i_ * 8192), 16, 0, 0); } while (0)
#define VMW(n) asm volatile("s_waitcnt vmcnt(" #n ")" ::: "memory")
#define WGBAR() asm volatile("s_barrier" ::: "memory")
#define RESC(a) do { if (__any((a) < 1.f)) { if (hi == 0) al_l[r32] = (a); asm volatile("s_waitcnt lgkmcnt(0)" ::: "memory"); \
    _Pragma("unroll") for (int d = 0; d < 4; ++d) _Pragma("unroll") for (int r = 0; r < 16; ++r) o[d][r] *= al_l[crow(r, hi)]; } } while (0)
#define FAR(j) (64 * (j) + 63 + 113 <= tqmin)
#define DBASE(j) (tq - 64 * (j) - 4 * hi)
#define MLOAD(j) (*(const unsigned long long*)mptr)
    f32x16 pA0, pA1, pB0, pB1; float mnA, mnB, alA, alB; s16x8 pa0, pa1, pa2, pa3; const unsigned* mptr = selq; unsigned long long mwA, mwB;
#define MNEXT(mw) do { mw = *(const unsigned long long*)mptr; mptr += SEQ * 2; } while (0)
#define FIN(P0, P1, AL, MW) finishSM(P0, P1, AL, l_reg, (unsigned)(MW) >> (4 * hi), (unsigned)((MW) >> 32) >> (4 * hi), pa0, pa1, pa2, pa3)
    KDMA(0, 0); VDMA(0, 0); MNEXT(mwA); KDMA(1, KVBLK); MNEXT(mwB);
    ((LAS float*)(lds + OFF_TB))[tid] = tbv;
    VMW(0); __syncthreads();
    const float bfar = tbq[256 + 127];
    qkt(pA0, pA1, ka, qa, 0); partialSM(pA0, pA1, m_reg, mnA, alA, FAR(0), bfar, tbq + (DBASE(0) + 197), 0);
    WGBAR();
    for (int j = 1; j + 1 < NT; j += 2) {
        KDMA(0, (j + 1) * KVBLK); VDMA(1, j * KVBLK);
        SBAR(); qkt(pB0, pB1, ka, qa, (int)SHM_K);
        FIN(pA0, pA1, alA, mwA); SBAR();
        MNEXT(mwA); SBAR();
        pv_d0(o, vb0, pa0, pa1, pa2, pa3); partialSM(pB0, pB1, m_reg, mnB, alB, FAR(j), bfar, tbq + (DBASE(j) + 197), 0);
        RESC(alB); VMW(0); asm volatile("" : "+v"(mwA)); WGBAR();
        KDMA(1, (j + 2) * KVBLK); VDMA(0, (j + 1) * KVBLK);
        SBAR(); qkt(pA0, pA1, ka, qa, 0);
        FIN(pB0, pB1, alB, mwB); SBAR();
        MNEXT(mwB); SBAR();
        pv_d0(o, vb0 + (int)SHM_V, pa0, pa1, pa2, pa3); partialSM(pA0, pA1, m_reg, mnA, alA, FAR(j + 1), bfar, tbq + (DBASE(j + 1) + 197), 0);
        RESC(alA); VMW(0); asm volatile("" : "+v"(mwB)); WGBAR();
    }
    VDMA(1, (NT - 1) * KVBLK);
    SBAR(); qkt(pB0, pB1, ka, qa, (int)SHM_K);
    FIN(pA0, pA1, alA, mwA); SBAR();
    pv_d0(o, vb0, pa0, pa1, pa2, pa3); partialSM(pB0, pB1, m_reg, mnB, alB, FAR(NT - 1), bfar, tbq + (DBASE(NT - 1) + 197), 0);
    RESC(alB); VMW(0); __syncthreads();
    FIN(pB0, pB1, alB, mwB); SBAR();
    pv_d0(o, vb0 + (int)SHM_V, pa0, pa1, pa2, pa3);
    __syncthreads();
#undef MNEXT
#undef FIN
    if (hi == 0) li_l[r32] = l_reg; asm volatile("s_waitcnt lgkmcnt(0)" ::: "memory");
    { LAS unsigned char* osl = lds + wid * 8704;
      int le = lane; asm volatile("" : "+v"(le)); const int r32e = le & 31, hie = le >> 5;
#pragma unroll
      for (int r = 0; r < 16; ++r) { const int orow = crow(r, hie); const float rl = __builtin_amdgcn_rcpf(li_l[orow]);
#pragma unroll
          for (int d0 = 0; d0 < 4; ++d0) *(LAS bf16*)(osl + orow * 272 + (d0 * 32 + r32e) * 2) = (bf16)f2bf(o[d0][r] * rl); }
      asm volatile("s_waitcnt lgkmcnt(0)" ::: "memory");
#pragma unroll
      for (int i = 0; i < 8; ++i) { const int p = le + 64 * i, row = p >> 4, pc = p & 15; *(v4u*)(Ob + blk_off(orow0 + wid * QBLK + row, ocol0 + pc * 8, DM)) = *(const LAS v4u*)(osl + row * 272 + pc * 16); }
      asm volatile("s_waitcnt lgkmcnt(0)" ::: "memory"); }
#undef KDMA
#undef VDMA
#undef VMW
#undef WGBAR
#undef RESC
#undef FAR
#undef DBASE
#undef MLOAD
}
}
__device__ __forceinline__ void ph_attention(Frame& F) {
    const bf16* P1 = (const bf16*)(F.ws + WS_PROJ); bf16* ATT = (bf16*)(F.ws + WS_H); const unsigned* SEL = (const unsigned*)(F.ws + WS_SEL); const float* tb = (const float*)(F.ws + WS_TB);
    LAS float* tbq = (LAS float*)(F.lds + att::OFF_TB);
    for (int pi = F.vcu; pi < 1024; pi += F.G) {
        const int combo = pi >> 4, within = pi & 15, b = combo >> 2, kvh = combo & 3, hq = kvh * 4 + (within >> 2), pr = within & 3;
        for (int half = 0; half < 2; ++half) {
            const int qb = half ? 7 - pr : pr, i0 = qb * 256;
            __syncthreads();
            int t_ = threadIdx.x; asm volatile("" : "+v"(t_));
            const int d_ = t_ - 256; const float tbv = tb[(d_ < 0 ? 0 : (d_ > 127 ? 127 : d_)) * 16 + hq] * (1.0f / att::SCALE);
            const size_t tok0 = (size_t)b * SEQ;
            att::attn_unit(P1, (int)(tok0 + i0), C1_Q + hq * 128, (int)tok0, C1_K + kvh * 128, C1_V + kvh * 128,
                           ATT, (int)(tok0 + i0), hq * 128, 4 * (qb + 1), SEL + (size_t)b * 32 * SEQ * 2 + (size_t)(i0 + F.wave * 32 + (t_ & 31)) * 2, i0, F.lds, tbv);
        }
    }
}
__device__ __forceinline__ void ph_dsa_naive_sel(Frame& F) {
    LAS float* qil = (LAS float*)(F.lds);
    LAS float* wl = (LAS float*)(F.lds + 4096);
    LAS float* ql = (LAS float*)(F.lds + 8192);
    LAS unsigned* sc = (LAS unsigned*)(F.lds + 16384);
    LAS int* idxl = (LAS int*)(F.lds + 24576);
    LAS float* pl = (LAS float*)(F.lds + 25600);
    LAS float* red = (LAS float*)(F.lds + 26624);
    LAS int* cntl = (LAS int*)(F.lds + 26752);
    LAS int* wtot = (LAS int*)(F.lds + 26880);
    LAS float* op = (LAS float*)(F.lds + 28672);
    const bf16* P1 = (const bf16*)(F.ws + WS_PROJ); bf16* ATT = (bf16*)(F.ws + WS_H); const float* tb = (const float*)(F.ws + WS_TB);
    const int tid = F.tid, lane = F.lane, wave = F.wave;
    for (int unit = F.vcu; unit < MTOK; unit += F.G) {
        const int b = unit >> 11, t = unit & 2047; const bf16* P = P1 + (size_t)unit * O_INP;
        for (int i = tid; i < 1024; i += NTHR) qil[i] = bf2f(P[C1_QI + i]);
        if (tid < 16) wl[tid] = bf2f(P[C1_WI + tid]) * 0.03125f;
        for (int i = tid; i < 2048; i += NTHR) ql[i] = bf2f(P[C1_Q + i]);
        __syncthreads();
        bool sel[4];
        { const unsigned* SELr = (const unsigned*)(F.ws + WS_SEL) + (size_t)unit * 64;
#pragma unroll
          for (int j = 0; j < 4; ++j) { const int s = tid + 512 * j; sel[j] = (SELr[s >> 5] >> (s & 31)) & 1u; } }
        int pre[4];
#pragma unroll
        for (int j = 0; j < 4; ++j) { const unsigned long long bal = __ballot(sel[j]); pre[j] = __popcll(bal & ((1ull << lane) - 1ull)); if (lane == 0) wtot[j * 8 + wave] = __popcll(bal); }
        __syncthreads();
        int nsel = 0;
        { int run = 0; int base[4];
#pragma unroll
          for (int j = 0; j < 4; ++j) {
#pragma unroll
              for (int w = 0; w < 8; ++w) { if (w == wave) base[j] = run; run += wtot[j * 8 + w]; } }
          nsel = run;
#pragma unroll
          for (int j = 0; j < 4; ++j) if (sel[j]) idxl[base[j] + pre[j]] = tid + 512 * j; }
        __syncthreads();
        for (int hq = 0; hq < 16; ++hq) { const int kvh = hq >> 2;
            float logit = -INFINITY;
            if (tid < nsel) { const int s = idxl[tid]; const v4u* kp = (const v4u*)(P1 + (size_t)(b * SEQ + s) * O_INP + C1_K + kvh * 128); float d = 0.f;
#pragma unroll
                for (int q = 0; q < 16; ++q) { const v4u w = kp[q]; const f32x4 a0 = *(const LAS f32x4*)(ql + hq * 128 + 8 * q), a1 = *(const LAS f32x4*)(ql + hq * 128 + 8 * q + 4);
                    d += a0.x * __uint_as_float(w.x << 16) + a0.y * __uint_as_float(w.x & 0xffff0000u) + a0.z * __uint_as_float(w.y << 16) + a0.w * __uint_as_float(w.y & 0xffff0000u)
                       + a1.x * __uint_as_float(w.z << 16) + a1.y * __uint_as_float(w.z & 0xffff0000u) + a1.z * __uint_as_float(w.w << 16) + a1.w * __uint_as_float(w.w & 0xffff0000u); }
                const int dist = t - s; logit = d * 0.08838834764831845f + tb[(dist < 127 ? dist : 127) * 16 + hq]; }
            float mx = wave_max(logit); if (lane == 0) red[wave] = mx;
            __syncthreads();
            mx = fmaxf(fmaxf(fmaxf(red[0], red[1]), fmaxf(red[2], red[3])), fmaxf(fmaxf(red[4], red[5]), fmaxf(red[6], red[7])));
            const float p = (tid < nsel) ? __expf(logit - mx) : 0.f;
            if (tid < 256) pl[tid] = p;
            float sm = wave_sum(p); if (lane == 0) red[8 + wave] = sm;
            __syncthreads();
            sm = ((red[8] + red[9]) + (red[10] + red[11])) + ((red[12] + red[13]) + (red[14] + red[15]));
            { const int d = tid & 127, part = tid >> 7; float a = 0.f; const int j1 = (part * 64 + 64) < nsel ? (part * 64 + 64) : nsel;
              for (int j = part * 64; j < j1; ++j) a += pl[j] * bf2f(P1[(size_t)(b * SEQ + idxl[j]) * O_INP + C1_V + kvh * 128 + d]);
              op[part * 128 + d] = a; }
            __syncthreads();
            if (tid < 128) ATT[(size_t)unit * DM + hq * 128 + tid] = (bf16)f2bf(((op[tid] + op[128 + tid]) + (op[256 + tid] + op[384 + tid])) / sm);
            __syncthreads();
        }
    }
}


constexpr int N_PHASES = 15;
#ifndef PROBE_DUP
#define PROBE_DUP -1
#endif
#ifndef MIXER0
#define MIXER0 1
#endif
#ifndef DSA_ATT
#define DSA_ATT 1
#endif

__global__ void __launch_bounds__(NTHR, 2) mega_fwd(Args args) {
    extern __shared__ __attribute__((aligned(16))) unsigned char lds_raw[];
    Frame F;
    F.lds = (LAS unsigned char*)lds_raw;
    F.tid = threadIdx.x; F.lane = F.tid & 63; F.wave = __builtin_amdgcn_readfirstlane(F.tid >> 6);
    F.G = gridDim.x; { const int bx = blockIdx.x; F.vcu = (F.G % 8 == 0) ? (bx % 8) * (F.G / 8) + bx / 8 : bx; }
    F.ws = args.ws;
    unsigned char* ws = args.ws;
    volatile LAS unsigned* MISC = (volatile LAS unsigned*)(F.lds + MISC_OFF);
    if (F.tid < 32) ((LAS unsigned*)(F.lds + MISC_OFF))[F.tid] = 0u;
    __syncthreads();
    const int lo = args.ph_lo, hi = args.ph_hi;
    const bool multi = (hi - lo) > 1;
    XcdBarrier bar; bar.bar = (unsigned*)(ws + WS_CTL) + CW_BAR; bar.x = 0; bar.st = nullptr;
    if (multi) bar = xcd_barrier_post((unsigned*)(ws + WS_CTL) + CW_BAR, MISC + 8);
#define IN(k) (lo <= (k) && (k) < hi)
#define SEAM(k) do { if (IN(k) && IN((k) + 1)) xcd_barrier(bar); { int t_ = threadIdx.x; asm volatile("" : "+v"(t_)); F.tid = t_; F.lane = t_ & 63; } } while (0)
    float* const rss = (float*)(ws + WS_RSS); float* const rstd = (float*)(ws + WS_RSTD);
#define RSTD_PHASE(k, site) do { if (IN(k)) { int t_ = threadIdx.x; asm volatile("" : "+v"(t_));   const int gt = F.vcu * NTHR + t_; if (gt < MTOK) { const f32x4* p = (const f32x4*)(rss + (site) * RSW + (size_t)gt * 32); float s = 0.f; \
            _Pragma("unroll") for (int q = 0; q < 8; ++q) { const f32x4 v = p[q]; s += (v.x + v.y) + (v.z + v.w); } rstd[(site) * MTOK + gt] = rstd_of(s); } } SEAM(k); } while (0)
#define GEMM_PHASE_(k, ABLK, EpiT, Aptr, Wptr, N_, K_, ...) do { if (IN(k)) { pg8::Gemm g{(const bf16*)(Aptr), (const bf16*)(Wptr), MTOK, (N_), (K_)}; pg8::StaticOrder S; S.init(MTOK, (N_), F.G, (int)blockIdx.x); \
            EpiT E{__VA_ARGS__}; pg8::gemm_phase<EpiT, pg8::StaticOrder, true, true, ABLK, true>(F.lds, g, S, E); } SEAM(k); } while (0)
#define GEMM_PHASE(k, ...) GEMM_PHASE_(k, false, __VA_ARGS__)
#define GEMM_PHASE_B(k, ...) GEMM_PHASE_(k, true, __VA_ARGS__)
    if (IN(0)) p0_prologue(F, args);
    SEAM(0);
    GEMM_PHASE_B(1, EpiBf16Rs, ws + WS_XB, ws + WS_WIN0, E_IN, DM, (bf16*)(ws + WS_PROJ), E_IN, rstd);
    if (IN(2)) ph_mixer0(F, args);
    SEAM(2);
    GEMM_PHASE_B(3, EpiResMid, ws + WS_H, ws + WS_WOUT0, DM, DM, (const void*)(ws + WS_XB), (void*)(ws + WS_XB), rss + RSW, DM);
    GEMM_PHASE_B(4, EpiGuFused, ws + WS_XB, ws + WS_WGU0, GUW, DM, (bf16*)(ws + WS_ACTF), rss + RSW, args.in[17], args.in[18], (float*)(ws + WS_SIDEG), (float*)(ws + WS_SIDEU), F.lds + 131072);
    if (IN(5)) ph_ffn_fixup(F, (bf16*)(ws + WS_ACTF), (const float*)(ws + WS_SIDEG), (const float*)(ws + WS_SIDEU), args.in[17], args.in[18]);
    SEAM(5);
    GEMM_PHASE_B(6, EpiResMid, ws + WS_ACTF, ws + WS_WDN0, DM, DFF, (const void*)(ws + WS_XB), (void*)(ws + WS_XB), rss + 2 * RSW, DM);
    if (IN(7)) { pg8::Gemm g{(const bf16*)(ws + WS_XB), (const bf16*)(ws + WS_WIN1), MTOK, O_INP, DM}; pg8::StaticOrder S; S.init(MTOK, O_INP, F.G, (int)blockIdx.x);
        EpiBf16RsP E{(bf16*)(ws + WS_PROJ), O_INP, rss + 2 * RSW, F.lds}; pg8::gemm_phase<EpiBf16RsP, pg8::StaticOrder, true, true, true, true>(F.lds, g, S, E);
        drain_conv_queue(F, args, 2112, L1_I0 + L1_I1, L1_ITEMS); }
    SEAM(7);
    if (IN(8)) ph_indexer(F);
    SEAM(8);
    if (IN(9)) ph_attention(F);
    SEAM(9);
    GEMM_PHASE_B(10, EpiResMid, ws + WS_H, ws + WS_WOUT1, DM, DM, (const void*)(ws + WS_XB), (void*)(ws + WS_XB), rss + 3 * RSW, DM);
    GEMM_PHASE_B(11, EpiGuFused, ws + WS_XB, ws + WS_WGU1, GUW, DM, (bf16*)(ws + WS_ACTF), rss + 3 * RSW, args.in[17] + 3 * DFF, args.in[18] + DFF, (float*)(ws + WS_SIDEG), (float*)(ws + WS_SIDEU), F.lds + 131072);
    if (IN(12)) ph_ffn_fixup(F, (bf16*)(ws + WS_ACTF), (const float*)(ws + WS_SIDEG), (const float*)(ws + WS_SIDEU), args.in[17] + 3 * DFF, args.in[18] + DFF);
    SEAM(12);
    GEMM_PHASE_B(13, EpiResMid, ws + WS_ACTF, ws + WS_WDN1, DM, DFF, (const void*)(ws + WS_XB), (void*)(ws + WS_XB), rss + 4 * RSW, DM);
    if (IN(14)) { const int ln = (int)__builtin_amdgcn_mbcnt_hi(~0u, __builtin_amdgcn_mbcnt_lo(~0u, 0u));
        const int gw = F.vcu * NWAVES + F.wave, NGW = F.G * NWAVES; const bf16* xb_ = (const bf16*)(ws + WS_XB);
        for (int rb = gw; rb < MTOK / 16; rb += NGW) { const int row = rb * 16 + (ln >> 2); float rs;
            { const f32x4* p = (const f32x4*)(rss + 4 * RSW + (size_t)row * 32) + 2 * (ln & 3); const f32x4 a = p[0], b = p[1];
              float s = ((a.x + a.y) + (a.z + a.w)) + ((b.x + b.y) + (b.z + b.w)); s += __shfl_xor(s, 1); s += __shfl_xor(s, 2); rs = rstd_of(s); }
            const bf16* ib = xb_ + (size_t)rb * (DM / 32) * 512 + ln * 8; float* orow = args.out + (size_t)row * DM + (ln & 3) * 8; const float* gp = args.in[20] + (ln & 3) * 8;
#pragma unroll 8
            for (int cb = 0; cb < DM / 32; ++cb) { const v4u w = *(const v4u*)(ib + cb * 512); const f32x4 ga = *(const f32x4*)(gp + cb * 32), gb = *(const f32x4*)(gp + cb * 32 + 4);
                *(f32x4*)(orow + cb * 32) = (f32x4){__uint_as_float(w.x << 16), __uint_as_float(w.x & 0xffff0000u), __uint_as_float(w.y << 16), __uint_as_float(w.y & 0xffff0000u)} * rs * ga;
                *(f32x4*)(orow + cb * 32 + 4) = (f32x4){__uint_as_float(w.z << 16), __uint_as_float(w.z & 0xffff0000u), __uint_as_float(w.w << 16), __uint_as_float(w.w & 0xffff0000u)} * rs * gb; } } }
#undef IN
#undef SEAM
}

#ifndef ONE_LAUNCH
#define ONE_LAUNCH 0
#endif
extern "C" void kernel_launch(void* const* d_in, const int* in_sizes, int n_in, void* d_out, int out_size, void* d_ws, size_t ws_size, hipStream_t stream) {
    static int grid = 0;
    if (grid == 0) {
        if (n_in != 21 || in_sizes[0] != MTOK * DM || out_size != MTOK * DM || ws_size < WS_END) { fprintf(stderr, "kernel_launch: unexpected shapes (n_in %d in0 %d out %d ws %zu)\n", n_in, n_in > 0 ? in_sizes[0] : -1, out_size, ws_size); grid = -1; return; }
        int dev = 0, cus = 0, per_cu = 0;
        if (hipGetDevice(&dev) != hipSuccess || hipDeviceGetAttribute(&cus, hipDeviceAttributeMultiprocessorCount, dev) != hipSuccess) { grid = -1; return; }
        if (hipFuncSetAttribute((const void*)mega_fwd, hipFuncAttributeMaxDynamicSharedMemorySize, LDS_BYTES) != hipSuccess) { fprintf(stderr, "kernel_launch: hipFuncSetAttribute failed\n"); grid = -1; return; }
        if (hipOccupancyMaxActiveBlocksPerMultiprocessor(&per_cu, (const void*)mega_fwd, NTHR, LDS_BYTES) != hipSuccess || per_cu < 1) { fprintf(stderr, "kernel_launch: occupancy query says %d\n", per_cu); }
        (void)hipGetLastError();
        grid = cus;
    }
    if (grid < 0) return;
    (void)hipMemsetAsync((char*)d_ws + WS_CTL, 0, CTL_ZERO_BYTES, stream);
    Args a{};
    for (int i = 0; i < 21; ++i) a.in[i] = (const float*)d_in[i];
    a.out = (float*)d_out; a.ws = (unsigned char*)d_ws;
#if ONE_LAUNCH
    a.ph_lo = 0; a.ph_hi = N_PHASES;
    hipLaunchKernelGGL(mega_fwd, dim3(grid), dim3(NTHR), LDS_BYTES, stream, a);
#else
    for (int p = 0; p < N_PHASES; ++p) { a.ph_lo = p; a.ph_hi = p + 1; hipLaunchKernelGGL(mega_fwd, dim3(grid), dim3(NTHR), LDS_BYTES, stream, a); }
#endif
}
```

```cpp
#include <hip/hip_runtime.h>
#include <cstdio>
#include <cstdint>
#define ONE_LAUNCH 1
#define WDROP 2
namespace pg8 {
#define PG8_LAS __attribute__((address_space(3)))
typedef unsigned short bf16_t;
typedef short bf16x8 __attribute__((ext_vector_type(8)));
typedef float f32x4 __attribute__((ext_vector_type(4)));
typedef unsigned u32x4 __attribute__((ext_vector_type(4)));
constexpr int BM = 256, BK = 64, HALF = 128, HTB = HALF * BK * 2  , STAGE_BYTES = 8 * HTB, NXCD = 8, WGM = 8;

__host__ __device__ __forceinline__ int lds_byte(int r, int c) { const int st = (r >> 4) * 2 + (c >> 5), rr = r & 15, cc = c & 31, ob = rr * 64 + cc * 2; return st * 1024 + (ob ^ (((ob >> 9) & 1) << 5)); }
__host__ __device__ __forceinline__ void stage_rc(int b, int& R, int& C) { const int st = b / 1024, sb = b % 1024, swz = sb ^ (((sb >> 9) & 1) << 5); R = (st >> 1) * 16 + swz / 64; C = (st & 1) * 32 + (swz % 64) / 2; }
__host__ __device__ __forceinline__ int perm32(int rho) { const int n = rho >> 4, i = rho & 15; return 8 * (i >> 2) + 4 * n + (i & 3); }

struct Unit { int pm, pn; };
struct Gemm { const bf16_t* A; const bf16_t* Bt; int M, N, K; };

struct StaticOrder {
    int nM, nN, nwg, G, c;
    __host__ __device__ void init(int M, int N, int G_, int c_) { nM = M / BM; nN = N / BM; nwg = nM * nN; G = G_; c = c_; }
    __host__ __device__ bool next(int i, Unit& u) const {
        const long L = (long)i * G + c; if (L >= nwg) return false;
        int wgid = (int)L; { const int q = nwg / NXCD, r = nwg % NXCD, xcd = wgid % NXCD, off = wgid / NXCD; wgid = (xcd < r ? xcd * (q + 1) : r * (q + 1) + (xcd - r) * q) + off; }
        const int nig = WGM * nN, gid = wgid / nig, fm = gid * WGM, gsz = (nM - fm) < WGM ? (nM - fm) : WGM;
        u.pm = fm + ((wgid % nig) % gsz); u.pn = (wgid % nig) / gsz; return true;
    }
    __device__ __forceinline__ void a_ready(const Unit&) const {}
    __device__ __forceinline__ void done(const Unit&) const {}
};
__device__ __forceinline__ unsigned cvt_pk_bf16(float lo, float hi) { unsigned r; asm volatile("v_cvt_pk_bf16_f32 %0, %1, %2" : "=v"(r) : "v"(lo), "v"(hi)); return r; }
typedef float f32x2 __attribute__((ext_vector_type(2)));
template <class E_> struct RowsLds { static constexpr bool value = false; };
template <class Epi, class Sched, bool ALIGN_EPI = false, bool SP2 = false, bool A_BLK = false, bool B_BLK = false>
__device__ __forceinline__ void gemm_phase(PG8_LAS unsigned char* lds, const Gemm g, const Sched& S, const Epi& E) {
    const int tid = threadIdx.x, wid = __builtin_amdgcn_readfirstlane(tid >> 6), lane = tid & 63, wr = wid >> 2, wc = wid & 3, fr = lane & 15, fq = lane >> 4;
    const int K = g.K, nt = K / BK;
    unsigned voffA[2], voffB[2];
#pragma unroll
    for (int i = 0; i < 2; ++i) { int R, C; stage_rc(tid * 16 + i * 8192, R, C); const int Rb = Epi::PERM ? ((R & ~31) + perm32(R & 31)) : R;
        voffA[i] = A_BLK ? (unsigned)((((R >> 4) * (K >> 5) + (C >> 5)) * 512 + (R & 15) * 32 + (C & 31)) * 2) : (unsigned)(R * K + C) * 2u;
        voffB[i] = B_BLK ? (unsigned)((((R >> 4) * (K >> 5) + (C >> 5)) * 512 + (R & 15) * 32 + (C & 31)) * 2) : (unsigned)(Rb * K + C) * 2u; }
    const size_t kstep = (size_t)(BK * 2), kstepA = A_BLK ? (size_t)2048 : kstep, kstepB = B_BLK ? (size_t)2048 : kstep;
    const size_t hstep = (size_t)HALF * K * 2;
    const size_t tstep = 2 * hstep;
    const unsigned ldsw = (unsigned)wid * 1024u;
    const int aoff = lds_byte(wr * 64 + fr, fq * 8), boff = lds_byte(wc * 32 + fr, fq * 8);
#define PG8_SA(b, h) (((b) * 2 + (h)) * HTB)
#define PG8_SB(b, h) ((4 + (b) * 2 + (h)) * HTB)
#define PG8_STAGE(bufoff, gbase, voff) do { _Pragma("unroll") for (int _i = 0; _i < 2; ++_i) \
        __builtin_amdgcn_global_load_lds((const unsigned*)((const char*)(gbase) + (voff)[_i]), (PG8_LAS unsigned*)(lds + (bufoff) + ldsw + _i * 8192), 16, 0, 0); } while (0)
#define PG8_LDA(dst, b, h) do { _Pragma("unroll") for (int m = 0; m < 4; ++m) _Pragma("unroll") for (int k = 0; k < 2; ++k) dst[m][k] = *(const PG8_LAS bf16x8*)(lds + PG8_SA(b, h) + aoff + m * 2048 + k * 1024); } while (0)
#define PG8_LDB(dst, b, h) do { _Pragma("unroll") for (int n = 0; n < 2; ++n) _Pragma("unroll") for (int k = 0; k < 2; ++k) dst[n][k] = *(const PG8_LAS bf16x8*)(lds + PG8_SB(b, h) + boff + n * 2048 + k * 1024); } while (0)
#define PG8_MMA(ai, bj, At, Bt) do { __builtin_amdgcn_s_setprio(1); _Pragma("unroll") for (int m = 0; m < 4; ++m) _Pragma("unroll") for (int n = 0; n < 2; ++n) _Pragma("unroll") for (int k = 0; k < 2; ++k) \
        acc[ai][bj][m][n] = __builtin_amdgcn_mfma_f32_16x16x32_bf16(Bt[n][k], At[m][k], acc[ai][bj][m][n], 0, 0, 0); __builtin_amdgcn_s_setprio(0); } while (0)
#define PG8_WAIT_V(n) asm volatile("s_waitcnt vmcnt(" #n ")" ::: "memory")
#define PG8_WAIT_L(n) asm volatile("s_waitcnt lgkmcnt(" #n ")" ::: "memory")
#define PG8_BAR __builtin_amdgcn_s_barrier()
#define PG8_SCHED __builtin_amdgcn_sched_barrier(0)
    Unit cur, nxt; int ui = 0; int prev_pm = -1;
    if (!S.next(0, cur)) return;
    f32x4 acc[2][2][4][2];
#pragma unroll
    for (int a = 0; a < 2; ++a)
#pragma unroll
        for (int b = 0; b < 2; ++b)
#pragma unroll
            for (int m = 0; m < 4; ++m)
#pragma unroll
                for (int n = 0; n < 2; ++n) acc[a][b][m][n] = (f32x4){0.f, 0.f, 0.f, 0.f};
    bf16x8 At[4][2], B0[2][2], B1[2][2];
    const char* cA = (const char*)g.A + (size_t)cur.pm * tstep; const char* cB = (const char*)g.Bt + (size_t)cur.pn * tstep;
    S.a_ready(cur);
    if constexpr (SP2) {
        PG8_STAGE(PG8_SB(0, 0), cB, voffB); PG8_STAGE(PG8_SB(0, 1), cB + hstep, voffB); PG8_STAGE(PG8_SA(0, 0), cA, voffA); PG8_STAGE(PG8_SA(0, 1), cA + hstep, voffA);
        if (wr == 1) PG8_BAR;
        PG8_WAIT_V(2); PG8_BAR;
        PG8_STAGE(PG8_SB(1, 0), cB + kstepB, voffB); PG8_STAGE(PG8_SA(1, 0), cA + kstepA, voffA); PG8_STAGE(PG8_SB(1, 1), cB + hstep + kstepB, voffB);
        PG8_WAIT_V(6); PG8_BAR;
    } else {
        PG8_STAGE(PG8_SB(0, 0), cB, voffB); PG8_STAGE(PG8_SA(0, 0), cA, voffA); PG8_STAGE(PG8_SB(0, 1), cB + hstep, voffB); PG8_STAGE(PG8_SA(0, 1), cA + hstep, voffA);
        if (wr == 1) PG8_BAR;
        PG8_WAIT_V(4); PG8_BAR;
        PG8_STAGE(PG8_SB(1, 0), cB + kstepB, voffB); PG8_STAGE(PG8_SA(1, 0), cA + kstepA, voffA); PG8_STAGE(PG8_SB(1, 1), cB + hstep + kstepB, voffB);
        PG8_WAIT_V(6); PG8_BAR;
    }
    for (;;) {
        const bool has_next = S.next(ui + 1, nxt);
        const char* nA = has_next ? (const char*)g.A + (size_t)nxt.pm * tstep : cA; const char* nB = has_next ? (const char*)g.Bt + (size_t)nxt.pn * tstep : cB;
        for (int t = 0; t < nt; t += 2) {
            const bool last = (t == nt - 2);
            const char* a1 = cA + (size_t)(t + 1) * kstepA;
            const char* a2 = last ? nA : cA + (size_t)(t + 2) * kstepA; const char* b2 = last ? nB : cB + (size_t)(t + 2) * kstepB;
            const char* a3 = a2 + kstepA; const char* b3 = b2 + kstepB;
            if (last && has_next) S.a_ready(nxt);
            if constexpr (SP2) {
            PG8_LDB(B0, 0, 0); PG8_LDB(B1, 0, 1); PG8_SCHED; PG8_LDA(At, 0, 0); PG8_STAGE(PG8_SA(1, 1), a1 + hstep, voffA);
            PG8_WAIT_V(8); PG8_WAIT_L(0); PG8_BAR; PG8_MMA(0, 0, At, B0); PG8_MMA(0, 1, At, B1); PG8_BAR; PG8_SCHED;
            PG8_LDA(At, 0, 1); PG8_STAGE(PG8_SB(0, 0), b2, voffB); PG8_STAGE(PG8_SB(0, 1), b2 + hstep, voffB); PG8_STAGE(PG8_SA(0, 0), a2, voffA);
            PG8_WAIT_V(8); PG8_WAIT_L(0); PG8_BAR; PG8_MMA(1, 0, At, B0); PG8_MMA(1, 1, At, B1); PG8_BAR; PG8_SCHED;
            PG8_LDB(B0, 1, 0); PG8_LDB(B1, 1, 1); PG8_SCHED; PG8_LDA(At, 1, 0); PG8_STAGE(PG8_SA(0, 1), a2 + hstep, voffA);
            PG8_WAIT_V(8); PG8_WAIT_L(0); PG8_BAR; PG8_MMA(0, 0, At, B0); PG8_MMA(0, 1, At, B1); PG8_BAR; PG8_SCHED;
            PG8_LDA(At, 1, 1); PG8_STAGE(PG8_SB(1, 0), b3, voffB); PG8_STAGE(PG8_SB(1, 1), b3 + hstep, voffB); PG8_STAGE(PG8_SA(1, 0), a3, voffA);
            PG8_WAIT_V(8); PG8_WAIT_L(0); PG8_BAR; PG8_MMA(1, 0, At, B0); PG8_MMA(1, 1, At, B1); PG8_BAR; PG8_SCHED;
            } else {
            PG8_LDB(B0, 0, 0); PG8_SCHED; PG8_LDA(At, 0, 0); PG8_STAGE(PG8_SA(1, 1), a1 + hstep, voffA);
            PG8_WAIT_L(8); PG8_BAR; PG8_WAIT_L(0); PG8_MMA(0, 0, At, B0); PG8_BAR; PG8_SCHED;
            PG8_LDB(B1, 0, 1); PG8_STAGE(PG8_SB(0, 0), b2, voffB);
            PG8_BAR; PG8_WAIT_L(0); PG8_MMA(0, 1, At, B1); PG8_BAR;
            PG8_LDA(At, 0, 1); PG8_STAGE(PG8_SA(0, 0), a2, voffA);
            PG8_BAR; PG8_WAIT_L(0); PG8_MMA(1, 0, At, B0); PG8_BAR; PG8_SCHED;
            PG8_STAGE(PG8_SB(0, 1), b2 + hstep, voffB);
            PG8_WAIT_V(6); PG8_BAR; PG8_MMA(1, 1, At, B1); PG8_BAR;
            PG8_LDB(B0, 1, 0); PG8_SCHED; PG8_LDA(At, 1, 0); PG8_STAGE(PG8_SA(0, 1), a2 + hstep, voffA);
            PG8_WAIT_L(8); PG8_BAR; PG8_WAIT_L(0); PG8_MMA(0, 0, At, B0); PG8_BAR; PG8_SCHED;
            PG8_LDB(B1, 1, 1); PG8_STAGE(PG8_SB(1, 0), b3, voffB);
            PG8_BAR; PG8_WAIT_L(0); PG8_MMA(0, 1, At, B1); PG8_BAR;
            PG8_LDA(At, 1, 1); PG8_STAGE(PG8_SA(1, 0), a3, voffA);
            PG8_BAR; PG8_WAIT_L(0); PG8_MMA(1, 0, At, B0); PG8_BAR; PG8_SCHED;
            PG8_STAGE(PG8_SB(1, 1), b3 + hstep, voffB);
            PG8_WAIT_V(6); PG8_BAR; PG8_MMA(1, 1, At, B1); PG8_BAR;
            }
        }
        if constexpr (ALIGN_EPI) { if (wr == 0) PG8_BAR; }
        if constexpr (RowsLds<Epi>::value) { static_assert(ALIGN_EPI, "row-scale tile: all eight waves must be in the epilogue together");
            if (cur.pm != prev_pm) { E.load_rows(cur.pm, tid, lds); prev_pm = cur.pm; } }
        if constexpr (!Epi::AFTER_DRAIN) { E(acc, cur, wr, wc, fr, fq); S.done(cur); }
        if (!has_next) break;
#pragma unroll
        for (int a = 0; a < 2; ++a)
#pragma unroll
            for (int b = 0; b < 2; ++b)
#pragma unroll
                for (int m = 0; m < 4; ++m)
#pragma unroll
                    for (int n = 0; n < 2; ++n) acc[a][b][m][n] = (f32x4){0.f, 0.f, 0.f, 0.f};
        cur = nxt; cA = nA; cB = nB; ++ui;
        if constexpr (ALIGN_EPI) { if (wr == 1) PG8_BAR; }
    }
    PG8_WAIT_V(0);
    if constexpr (!ALIGN_EPI) { if (wr == 0) PG8_BAR; }
    PG8_BAR;
    if constexpr (Epi::AFTER_DRAIN) { E.fused(acc, cur, wr, wc, fr, fq, lds, wid, lane); S.done(cur); }
#undef PG8_SA
#undef PG8_SB
#undef PG8_STAGE
#undef PG8_LDA
#undef PG8_LDB
#undef PG8_MMA
#undef PG8_WAIT_V
#undef PG8_WAIT_L
#undef PG8_BAR
#undef PG8_SCHED
}
}
#define LAS __attribute__((address_space(3)))
#define XB_TMO      128
#define XB_XCNT(j)  (256  + 64 * (j))
#define XB_XSUB(j)  (1280 + 64 * (j))
#define XB_XGEN(j)  (2304 + 64 * (j))
#define XB_TOP      3328
#define XB_TOPGEN   3392
#define XCD_BAR_WORDS 3456
#define XB_SPIN_CAP (1u << 18)

__device__ __forceinline__ unsigned xb_ld(unsigned* p)              { return __hip_atomic_load(p, __ATOMIC_RELAXED, __HIP_MEMORY_SCOPE_AGENT); }
__device__ __forceinline__ unsigned xb_add(unsigned* p, unsigned v) { return __hip_atomic_fetch_add(p, v, __ATOMIC_RELAXED, __HIP_MEMORY_SCOPE_AGENT); }
__device__ __forceinline__ unsigned xb_xcc_id() { return (unsigned)__builtin_amdgcn_s_getreg((3 << 11) | 20) & 0xFu; }
#define XB_SPIN(cond, bar) do { unsigned _sp = 0; while (cond) { __builtin_amdgcn_s_sleep(1); \
    if ((++_sp & 255u) == 0u) { if (xb_ld(&(bar)[XB_TMO])) break; if (_sp > XB_SPIN_CAP) { atomicAdd(&(bar)[XB_TMO], 1u); break; } } } } while (0)

struct XcdBarrier {
    unsigned* bar; unsigned x;
    volatile LAS unsigned* st;
};

__device__ __forceinline__ XcdBarrier xcd_barrier_post(unsigned* bar, volatile LAS unsigned* st) {
    XcdBarrier b; b.bar = bar; b.x = xb_xcc_id(); b.st = st;
    if (threadIdx.x == 0) (void)xb_add(&bar[XB_XCNT(b.x)], 1u);
    return b;
}
__device__ __forceinline__ void xcd_barrier_complete(unsigned* bar, unsigned x, unsigned& nloc, unsigned& nx) {
    const unsigned G = gridDim.x * gridDim.y * gridDim.z;
    unsigned sum, cnt, mine, sp = 0u;
    for (;;) {
        sum = 0u; cnt = 0u; mine = 0u;
#pragma unroll
        for (unsigned j = 0; j < 16; ++j) { const unsigned c = xb_ld(&bar[XB_XCNT(j)]); sum += c; cnt += (c > 0u) ? 1u : 0u; mine = (j == x) ? c : mine; }
        if (sum == G) break;
        __builtin_amdgcn_s_sleep(1);
        if ((++sp & 255u) == 0u) { if (xb_ld(&bar[XB_TMO])) break; if (sp > XB_SPIN_CAP) { atomicAdd(&bar[XB_TMO], 1u); break; } }
    }
    nloc = mine > 0u ? mine : 1u; nx = cnt > 0u ? cnt : 1u;
}

__device__ __forceinline__ void xcd_barrier(const XcdBarrier& b) {
    asm volatile("s_waitcnt vmcnt(0)" ::: "memory");
    __syncthreads();
    if (threadIdx.x == 0) {
        unsigned* bar = b.bar;
        __builtin_amdgcn_s_waitcnt(0);
        unsigned nloc = b.st[0], nx = b.st[1];
        if (nloc == 0u) { xcd_barrier_complete(bar, b.x, nloc, nx); b.st[0] = nloc; b.st[1] = nx; }
        const unsigned old = xb_add(&bar[XB_XSUB(b.x)], 1u);
        const unsigned gen = old / nloc;
        if (old + 1u == (gen + 1u) * nloc) {
            __builtin_amdgcn_fence(__ATOMIC_RELEASE, "agent");
            asm volatile("s_waitcnt vmcnt(0)" ::: "memory");
            const unsigned og = xb_add(&bar[XB_TOP], 1u);
            const unsigned tg = og / nx;
            if (og + 1u == (tg + 1u) * nx) xb_add(&bar[XB_TOPGEN], 1u);
            else XB_SPIN(xb_ld(&bar[XB_TOPGEN]) == tg, bar);
            __builtin_amdgcn_fence(__ATOMIC_ACQUIRE, "agent");
            xb_add(&bar[XB_XGEN(b.x)], 1u);
            asm volatile("s_waitcnt vmcnt(0)" ::: "memory");
        } else {
            XB_SPIN(xb_ld(&bar[XB_XGEN(b.x)]) == gen, bar);
            __builtin_amdgcn_fence(__ATOMIC_ACQUIRE, "agent");
            asm volatile("s_waitcnt vmcnt(0)" ::: "memory");
        }
    }
    __syncthreads();
}
#define GAS __attribute__((address_space(1)))
typedef unsigned short bf16;
typedef unsigned v4u __attribute__((ext_vector_type(4)));
typedef unsigned v2u __attribute__((ext_vector_type(2)));
typedef float f32x4 __attribute__((ext_vector_type(4)));
typedef float f32x2 __attribute__((ext_vector_type(2)));

constexpr int NB = 16, SEQ = 2048, DM = 2048, MTOK = NB * SEQ;
constexpr int E_IN = 6144, O_IN = 4176, O_INP = 4352, DFF = 5632, GUW = 2 * DFF;
constexpr int NWAVES = 8, NTHR = 512;
constexpr float EPS = 1e-6f;
constexpr int C0_Q = 0, C0_K = 1024, C0_V = 2048, C0_G = 3072, C0_XR = 4096, C0_YR = 5120;
constexpr int C1_Q = 0, C1_K = 2048, C1_V = 2560, C1_QI = 3072, C1_KI = 4096, C1_WI = 4160;

constexpr size_t MiB = 1u << 20;
constexpr size_t WS_CTL = 0, CTL_ZERO_BYTES = 1 * MiB;
constexpr size_t WS_ROT = 1 * MiB;
constexpr size_t WS_GT = 2 * MiB;
constexpr size_t WS_TB = 2 * MiB + 512 * 1024;
constexpr size_t WS_SP = WS_TB + 8192;
constexpr size_t WS_WIN0 = 4 * MiB, WS_WOUT0 = 28 * MiB, WS_WGU0 = 36 * MiB, WS_WDN0 = 80 * MiB;
constexpr size_t WS_WIN1 = 102 * MiB, WS_WOUT1 = 119 * MiB, WS_WGU1 = 127 * MiB, WS_WDN1 = 171 * MiB;
constexpr size_t WS_H = 194 * MiB;
constexpr size_t WS_PROJ = 322 * MiB;
constexpr size_t WS_SEL = 594 * MiB;
constexpr size_t WS_ACTF = WS_PROJ;
constexpr size_t WS_XB = 706 * MiB;
constexpr size_t WS_SIDEG = 834 * MiB;
constexpr size_t WS_SIDEU = 878 * MiB;
constexpr size_t WS_RSS = 900 * MiB;
constexpr size_t RSW = (size_t)32768 * 32;
constexpr size_t WS_RSTD = 3 * MiB;
constexpr size_t WS_ACT = 706 * MiB;
constexpr size_t WS_END = 920 * MiB;
constexpr int CW_BAR = 4096;

#ifndef FOLD
#define FOLD 1
#endif
#ifndef DEFER_L1
#define DEFER_L1 1
#endif
constexpr int LDS_BYTES = 147456;
constexpr int MISC_OFF = LDS_BYTES - 128;

__device__ __forceinline__ float bf2f(bf16 b) { return __uint_as_float(((unsigned)b) << 16); }
__device__ __forceinline__ unsigned f2bf(float f) { unsigned u = __float_as_uint(f); return (u + 0x7fffu + ((u >> 16) & 1u)) >> 16; }
__device__ __forceinline__ unsigned pk2(float lo, float hi) { return f2bf(lo) | (f2bf(hi) << 16); }
#ifndef WDROP
#define WDROP 0
#endif
__device__ __forceinline__ unsigned f2bfw(float x) { const unsigned u = __float_as_uint(x); return WDROP ? (((u + (0x8000u << WDROP)) >> 16) & (0xffffu << WDROP)) & 0xffffu : f2bf(x); }
__device__ __forceinline__ unsigned pk2w(float lo, float hi) { return f2bfw(lo) | (f2bfw(hi) << 16); }
__device__ __forceinline__ float wave_sum(float v) {
#pragma unroll
    for (int o = 1; o < 64; o <<= 1) v += __shfl_xor(v, o);
    return v;
}
__device__ __forceinline__ float wave_max(float v) {
#pragma unroll
    for (int o = 1; o < 64; o <<= 1) v = fmaxf(v, __shfl_xor(v, o));
    return v;
}
__device__ __forceinline__ int wave_sum_i(int v) {
#pragma unroll
    for (int o = 1; o < 64; o <<= 1) v += __shfl_xor(v, o);
    return v;
}
__device__ __forceinline__ float sigmoidf_(float x) { return __builtin_amdgcn_rcpf(1.0f + __builtin_amdgcn_exp2f(-1.4426950408889634f * x)); }
__device__ __forceinline__ float siluf_(float x) { return x * __builtin_amdgcn_rcpf(1.0f + __builtin_amdgcn_exp2f(-1.4426950408889634f * x)); }
__device__ __forceinline__ float gelu_tanh(float y) { const float u = 0.7978845608028654f * (y + 0.044715f * y * y * y); return 0.5f * y * (1.0f + tanhf(u)); }

#ifndef USE_NT
#define USE_NT 0
#endif
#if USE_NT
#define NT_STORE(p, v) __builtin_nontemporal_store((v), (p))
#else
#define NT_STORE(p, v) (*(p) = (v))
#endif
struct EpiBf16P {
    static constexpr bool PERM = true, AFTER_DRAIN = false;
    bf16* O; int ldc;
    __device__ __forceinline__ void operator()(const pg8::f32x4 (&acc)[2][2][4][2], const pg8::Unit& u, int wr, int wc, int fr, int fq) const {
        const int row0 = u.pm * 256 + wr * 64 + fr, col0 = u.pn * 256 + wc * 32 + 8 * fq;
#pragma unroll
        for (int ai = 0; ai < 2; ++ai)
#pragma unroll
            for (int m = 0; m < 4; ++m) { bf16* rowp = O + (size_t)(row0 + ai * 128 + m * 16) * ldc + col0;
#pragma unroll
                for (int bj = 0; bj < 2; ++bj) { const pg8::f32x4 v0 = acc[ai][bj][m][0], v1 = acc[ai][bj][m][1];
                    pg8::u32x4 w; w.x = pg8::cvt_pk_bf16(v0[0], v0[1]); w.y = pg8::cvt_pk_bf16(v0[2], v0[3]); w.z = pg8::cvt_pk_bf16(v1[0], v1[1]); w.w = pg8::cvt_pk_bf16(v1[2], v1[3]);
                    NT_STORE((pg8::u32x4*)(rowp + bj * 128), w); } }
    }
};
struct EpiResF32 {
    static constexpr bool PERM = false, AFTER_DRAIN = false;
    const float* base; float* out; int ldc;
    __device__ __forceinline__ void operator()(const pg8::f32x4 (&acc)[2][2][4][2], const pg8::Unit& u, int wr, int wc, int fr, int fq) const {
        const int row0 = u.pm * 256 + wr * 64 + fr, col0 = u.pn * 256 + wc * 32 + 4 * fq;
#pragma unroll
        for (int ai = 0; ai < 2; ++ai)
#pragma unroll
            for (int m = 0; m < 4; ++m) { const size_t off = (size_t)(row0 + ai * 128 + m * 16) * ldc + col0;
#pragma unroll
                for (int bj = 0; bj < 2; ++bj)
#pragma unroll
                    for (int n = 0; n < 2; ++n) { const size_t i = off + bj * 128 + n * 16; const pg8::f32x4 b = *(const pg8::f32x4*)(base + i); *(pg8::f32x4*)(out + i) = b + acc[ai][bj][m][n]; } }
    }
};

__device__ __forceinline__ size_t blk_off(int R, int C, int ld) { return ((size_t)(R >> 4) * (ld >> 5) + (C >> 5)) * 512 + (R & 15) * 32 + (C & 31); }
__device__ __forceinline__ float rstd_of(float ss) { return __builtin_amdgcn_rsqf(ss * (1.0f / DM) + EPS); }
__device__ __forceinline__ float rstd_row(const float* rssp, int row, int fq) {
    const f32x4* p = (const f32x4*)(rssp + (size_t)row * 32) + 2 * fq; const f32x4 a = p[0], b = p[1];
    float s = ((a.x + a.y) + (a.z + a.w)) + ((b.x + b.y) + (b.z + b.w)); s += __shfl_xor(s, 16); s += __shfl_xor(s, 32); return rstd_of(s);
}
__device__ __forceinline__ void rstd_rows8(const float* rssp, int row0, int fq, float (&rs)[8]) {
#pragma unroll
    for (int h = 0; h < 2; ++h) { f32x4 pa[4], pb[4];
#pragma unroll
        for (int q = 0; q < 4; ++q) { const f32x4* p = (const f32x4*)(rssp + (size_t)(row0 + h * 128 + q * 16) * 32) + 2 * fq; pa[q] = p[0]; pb[q] = p[1]; }
        asm volatile("" ::: "memory");
#pragma unroll
        for (int q = 0; q < 4; ++q) { float s = ((pa[q].x + pa[q].y) + (pa[q].z + pa[q].w)) + ((pb[q].x + pb[q].y) + (pb[q].z + pb[q].w)); s += __shfl_xor(s, 16); s += __shfl_xor(s, 32); rs[h * 4 + q] = rstd_of(s); } }
}
constexpr int ROWTILE_OFF = 131072 + 8192;
struct RowTile {
    static __device__ __forceinline__ void load(const float* part, int pm, int tid, LAS unsigned char* lds) {
        const int row = tid >> 1, half = tid & 1; const f32x4* p = (const f32x4*)(part + (size_t)(pm * 256 + row) * 32 + half * 16);
        const f32x4 a = p[0], b = p[1], c = p[2], d = p[3];
        float s = (((a.x + a.y) + (a.z + a.w)) + ((b.x + b.y) + (b.z + b.w))) + (((c.x + c.y) + (c.z + c.w)) + ((d.x + d.y) + (d.z + d.w)));
        s += __shfl_xor(s, 1);
        if (half == 0) ((LAS float*)(lds + ROWTILE_OFF))[row] = rstd_of(s);
        asm volatile("s_waitcnt lgkmcnt(0)" ::: "memory"); __builtin_amdgcn_s_barrier(); asm volatile("" ::: "memory");
    }
};
template <bool PART>
struct EpiBf16RsT {
    static constexpr bool PERM = true, AFTER_DRAIN = false;
    bf16* O; int ldc; const float* rss; LAS unsigned char* lds;
    __device__ __forceinline__ void load_rows(int pm, int tid, LAS unsigned char* l) const { RowTile::load(rss, pm, tid, l); }
    __device__ __forceinline__ void operator()(const pg8::f32x4 (&acc)[2][2][4][2], const pg8::Unit& u, int wr, int wc, int fr, int fq) const {
        const int row0 = u.pm * 256 + wr * 64 + fr;
        const size_t rbs = (size_t)(ldc >> 5) * 512, lane_blk = ((size_t)(u.pm * 16 + wr * 4) * (ldc >> 5) + u.pn * 8 + wc) * 512 + fr * 32 + 8 * fq;
        float rsv[8];
#pragma unroll
        for (int q = 0; q < 8; ++q) rsv[q] = PART ? ((const LAS float*)(lds + ROWTILE_OFF))[wr * 64 + fr + (q >> 2) * 128 + (q & 3) * 16] : rss[row0 + (q >> 2) * 128 + (q & 3) * 16];
        asm volatile("" ::: "memory");
#pragma unroll
        for (int ai = 0; ai < 2; ++ai)
#pragma unroll
            for (int m = 0; m < 4; ++m) { const float rs = rsv[ai * 4 + m]; bf16* rowp = O + lane_blk + (size_t)(ai * 8 + m) * rbs;
#pragma unroll
                for (int bj = 0; bj < 2; ++bj) { const pg8::f32x4 v0 = acc[ai][bj][m][0] * rs, v1 = acc[ai][bj][m][1] * rs;
                    pg8::u32x4 w; w.x = pg8::cvt_pk_bf16(v0[0], v0[1]); w.y = pg8::cvt_pk_bf16(v0[2], v0[3]); w.z = pg8::cvt_pk_bf16(v1[0], v1[1]); w.w = pg8::cvt_pk_bf16(v1[2], v1[3]);
                    NT_STORE((pg8::u32x4*)(rowp + bj * 2048), w); } }
    }
};
typedef EpiBf16RsT<false> EpiBf16Rs; typedef EpiBf16RsT<true> EpiBf16RsP;
namespace pg8 { template <> struct RowsLds<EpiBf16RsP> { static constexpr bool value = true; }; }
struct EpiBf16RsLocal {
    static constexpr bool PERM = true, AFTER_DRAIN = false;
    bf16* O; int ldc; const float* rss;
    __device__ __forceinline__ void operator()(const pg8::f32x4 (&acc)[2][2][4][2], const pg8::Unit& u, int wr, int wc, int fr, int fq) const {
        const int row0 = u.pm * 256 + wr * 64 + fr, col0 = wc * 32 + 8 * fq; bf16* Ow = O + (size_t)blockIdx.x * 65536;
#pragma unroll
        for (int ai = 0; ai < 2; ++ai)
#pragma unroll
            for (int m = 0; m < 4; ++m) { const int row = row0 + ai * 128 + m * 16; const float rs = rstd_row(rss, row, fq); bf16* rowp = Ow + (size_t)(row & 255) * 256 + col0;
#pragma unroll
                for (int bj = 0; bj < 2; ++bj) { const pg8::f32x4 v0 = acc[ai][bj][m][0] * rs, v1 = acc[ai][bj][m][1] * rs;
                    pg8::u32x4 w; w.x = pg8::cvt_pk_bf16(v0[0], v0[1]); w.y = pg8::cvt_pk_bf16(v0[2], v0[3]); w.z = pg8::cvt_pk_bf16(v1[0], v1[1]); w.w = pg8::cvt_pk_bf16(v1[2], v1[3]);
                    *(pg8::u32x4*)(rowp + bj * 128) = w; } }
    }
};
struct EpiStoreOnly {
    static constexpr bool PERM = true, AFTER_DRAIN = false;
    bf16* O; int ldc;
    __device__ __forceinline__ void operator()(const pg8::f32x4 (&acc)[2][2][4][2], const pg8::Unit& u, int wr, int wc, int fr, int fq) const {
        const int row0 = wr * 64 + fr, col0 = wc * 32 + 8 * fq; bf16* Ow = O + (size_t)blockIdx.x * 65536;
#pragma unroll
        for (int ai = 0; ai < 2; ++ai)
#pragma unroll
            for (int m = 0; m < 4; ++m) { bf16* rowp = Ow + (size_t)(row0 + ai * 128 + m * 16) * 256 + col0;
#pragma unroll
                for (int bj = 0; bj < 2; ++bj) { const pg8::f32x4 v0 = acc[ai][bj][m][0] * 1.0009765625f, v1 = acc[ai][bj][m][1] * 1.0009765625f;
                    pg8::u32x4 w; w.x = pg8::cvt_pk_bf16(v0[0], v0[1]); w.y = pg8::cvt_pk_bf16(v0[2], v0[3]); w.z = pg8::cvt_pk_bf16(v1[0], v1[1]); w.w = pg8::cvt_pk_bf16(v1[2], v1[3]);
                    *(pg8::u32x4*)(rowp + bj * 128) = w; } }
    }
};
struct EpiValuOnly {
    static constexpr bool PERM = true, AFTER_DRAIN = false;
    bf16* O; int ldc; const float* rss;
    __device__ __forceinline__ void operator()(const pg8::f32x4 (&acc)[2][2][4][2], const pg8::Unit& u, int wr, int wc, int fr, int fq) const {
        const int row0 = u.pm * 256 + wr * 64 + fr; float rsv[8];
#pragma unroll
        for (int q = 0; q < 8; ++q) rsv[q] = rss[row0 + (q >> 2) * 128 + (q & 3) * 16];
        pg8::u32x4 s = {0u, 0u, 0u, 0u};
#pragma unroll
        for (int ai = 0; ai < 2; ++ai)
#pragma unroll
            for (int m = 0; m < 4; ++m) { const float rs = rsv[ai * 4 + m];
#pragma unroll
                for (int bj = 0; bj < 2; ++bj) { const pg8::f32x4 v0 = acc[ai][bj][m][0] * rs, v1 = acc[ai][bj][m][1] * rs;
                    s.x ^= pg8::cvt_pk_bf16(v0[0], v0[1]); s.y ^= pg8::cvt_pk_bf16(v0[2], v0[3]); s.z ^= pg8::cvt_pk_bf16(v1[0], v1[1]); s.w ^= pg8::cvt_pk_bf16(v1[2], v1[3]); } }
        *(pg8::u32x4*)(O + (size_t)blockIdx.x * 65536 + threadIdx.x * 8) = s;
    }
};
struct SameOrder {
    int n;
    __device__ bool next(int i, pg8::Unit& u) const { if (i >= n) return false; u.pm = 0; u.pn = 0; return true; }
    __device__ __forceinline__ void a_ready(const pg8::Unit&) const {}
    __device__ __forceinline__ void done(const pg8::Unit&) const {}
};
struct EpiNone {
    static constexpr bool PERM = true, AFTER_DRAIN = false;
    float* O; int never;
    __device__ __forceinline__ void operator()(const pg8::f32x4 (&acc)[2][2][4][2], const pg8::Unit& u, int wr, int wc, int fr, int fq) const {
        pg8::f32x4 s = {0.f, 0.f, 0.f, 0.f};
#pragma unroll
        for (int ai = 0; ai < 2; ++ai)
#pragma unroll
            for (int m = 0; m < 4; ++m)
#pragma unroll
                for (int bj = 0; bj < 2; ++bj)
#pragma unroll
                    for (int n = 0; n < 2; ++n) s += acc[ai][bj][m][n];
        if (never < 0) *(pg8::f32x4*)(O + threadIdx.x * 4) = s;
    }
};
template <bool BASE_F32, bool OUT_F32>
struct EpiResNorm {
    static constexpr bool PERM = true, AFTER_DRAIN = false;
    const void* base; void* out; float* rssn; int ldc;
    __device__ __forceinline__ void operator()(const pg8::f32x4 (&acc)[2][2][4][2], const pg8::Unit& u, int wr, int wc, int fr, int fq) const {
        const int row0 = u.pm * 256 + wr * 64 + fr, col0 = u.pn * 256 + wc * 32 + 8 * fq;
        const size_t rbs = (size_t)(ldc >> 5) * 512, lane_blk = ((size_t)(u.pm * 16 + wr * 4) * (ldc >> 5) + u.pn * 8 + wc) * 512 + fr * 32 + 8 * fq;
        pg8::u32x4 bw[2][4][2];
        if (!BASE_F32) {
#pragma unroll
            for (int ai = 0; ai < 2; ++ai)
#pragma unroll
                for (int m = 0; m < 4; ++m)
#pragma unroll
                    for (int bj = 0; bj < 2; ++bj) bw[ai][m][bj] = *(const pg8::u32x4*)((const bf16*)base + lane_blk + (size_t)(ai * 8 + m) * rbs + bj * 2048);
            asm volatile("" ::: "memory");
        }
#pragma unroll
        for (int ai = 0; ai < 2; ++ai) {
            pg8::f32x4 bf[4][2][2];
            if (BASE_F32) {
#pragma unroll
                for (int m = 0; m < 4; ++m)
#pragma unroll
                    for (int bj = 0; bj < 2; ++bj) { const float* p = (const float*)base + (size_t)(row0 + ai * 128 + m * 16) * ldc + col0 + bj * 128; bf[m][bj][0] = *(const pg8::f32x4*)p; bf[m][bj][1] = *(const pg8::f32x4*)(p + 4); }
                asm volatile("" ::: "memory");
            }
#pragma unroll
            for (int m = 0; m < 4; ++m) { const int row = row0 + ai * 128 + m * 16; const size_t off = (size_t)row * ldc + col0; float ss = 0.f;
#pragma unroll
                for (int bj = 0; bj < 2; ++bj) { const size_t i = off + bj * 128; pg8::f32x4 x0, x1;
                    if (BASE_F32) { x0 = bf[m][bj][0]; x1 = bf[m][bj][1]; }
                    else { const pg8::u32x4 w = bw[ai][m][bj];
                        x0 = (pg8::f32x4){__uint_as_float(w.x << 16), __uint_as_float(w.x & 0xffff0000u), __uint_as_float(w.y << 16), __uint_as_float(w.y & 0xffff0000u)};
                        x1 = (pg8::f32x4){__uint_as_float(w.z << 16), __uint_as_float(w.z & 0xffff0000u), __uint_as_float(w.w << 16), __uint_as_float(w.w & 0xffff0000u)}; }
                    x0 += acc[ai][bj][m][0]; x1 += acc[ai][bj][m][1];
                    if (OUT_F32) { *(pg8::f32x4*)((float*)out + i) = x0; *(pg8::f32x4*)((float*)out + i + 4) = x1; }
                    else { pg8::u32x4 w; w.x = pg8::cvt_pk_bf16(x0[0], x0[1]); w.y = pg8::cvt_pk_bf16(x0[2], x0[3]); w.z = pg8::cvt_pk_bf16(x1[0], x1[1]); w.w = pg8::cvt_pk_bf16(x1[2], x1[3]); NT_STORE((pg8::u32x4*)((bf16*)out + lane_blk + (size_t)(ai * 8 + m) * rbs + bj * 2048), w); }
                    ss += ((x0[0] * x0[0] + x0[1] * x0[1]) + (x0[2] * x0[2] + x0[3] * x0[3])) + ((x1[0] * x1[0] + x1[1] * x1[1]) + (x1[2] * x1[2] + x1[3] * x1[3])); }
                ss += __shfl_xor(ss, 16); ss += __shfl_xor(ss, 32);
                if (fq == 0) rssn[(size_t)row * 32 + u.pn * 4 + wc] = ss; }
        }
    }
};
typedef EpiResNorm<true, false> EpiResFirst; typedef EpiResNorm<false, false> EpiResMid; typedef EpiResNorm<false, true> EpiResLast;
__device__ __forceinline__ float dpp_ror1(float v) { return __int_as_float(__builtin_amdgcn_update_dpp(0, __float_as_int(v), 0x121, 0xf, 0xf, false)); }
__device__ __forceinline__ float dpp_ror2(float v) { return __int_as_float(__builtin_amdgcn_update_dpp(0, __float_as_int(v), 0x122, 0xf, 0xf, false)); }
constexpr float LOG2E_ = 1.4426950408889634f;
struct EpiGuFused {
    static constexpr bool PERM = true, AFTER_DRAIN = false;
    bf16* ACT; const float* rss; const float* cw; const float* cb; float* sideG; float* sideU; LAS unsigned char* halo;
    __device__ __forceinline__ void load_rows(int pm, int tid, LAS unsigned char* l) const { RowTile::load(rss, pm, tid, l); }
    __device__ __forceinline__ void operator()(const pg8::f32x4 (&acc)[2][2][4][2], const pg8::Unit& u, int wr, int wc, int fr, int fq) const {
        const int ch0 = u.pn * 128 + wc * 32 + 8 * fq;
        const size_t act_blk = ((size_t)(u.pm * 16 + wr * 4) * (DFF >> 5) + u.pn * 4 + wc) * 512 + fr * 32 + 8 * fq;
        float rsv[8];
#pragma unroll
        for (int q = 0; q < 8; ++q) rsv[q] = ((const LAS float*)(halo - 131072 + ROWTILE_OFF))[wr * 64 + fr + (q >> 2) * 128 + (q & 3) * 16];
        float w0[8], w1[8], w2[8], bb[8];
#pragma unroll
        for (int k = 0; k < 8; ++k) { w0[k] = cw[ch0 + k] * LOG2E_; w1[k] = cw[DFF + ch0 + k] * LOG2E_; w2[k] = cw[2 * DFF + ch0 + k] * LOG2E_; bb[k] = cb[ch0 + k] * LOG2E_; }
        asm volatile("" ::: "memory");
#pragma unroll
        for (int ai = 0; ai < 2; ++ai) { if (fr >= 14) { LAS float* hs = (LAS float*)(halo + (((ai * 2 + wr) * 4 + wc) * 8 + (fr - 14) * 4 + fq) * 32); const float rs = rsv[ai * 4 + 3];
                *(LAS pg8::f32x4*)hs = acc[ai][0][3][0] * rs; *(LAS pg8::f32x4*)(hs + 4) = acc[ai][0][3][1] * rs; } }
        asm volatile("s_waitcnt lgkmcnt(0)" ::: "memory"); __builtin_amdgcn_s_barrier(); asm volatile("" ::: "memory");
#pragma unroll
        for (int ai = 0; ai < 2; ++ai) {
            float rot[5][2][8];
            { const bool has_above = (ai | wr) != 0; const int sa = wr ? ai : 0, sw = wr ? 0 : 1;
              const LAS float* h62 = (const LAS float*)(halo + (((sa * 2 + sw) * 4 + wc) * 8 + fq) * 32); const LAS float* h63 = h62 + 32;
              const pg8::f32x4 a0 = *(const LAS pg8::f32x4*)h62, a1 = *(const LAS pg8::f32x4*)(h62 + 4), b0 = *(const LAS pg8::f32x4*)h63, b1 = *(const LAS pg8::f32x4*)(h63 + 4);
#pragma unroll
              for (int k = 0; k < 8; ++k) { const float r62 = k < 4 ? a0[k & 3] : a1[k & 3], r63 = k < 4 ? b0[k & 3] : b1[k & 3];
                  rot[0][0][k] = has_above ? r63 : 0.f; rot[0][1][k] = has_above ? (fr == 0 ? r62 : r63) : 0.f; } }
#pragma unroll
            for (int m = 0; m < 4; ++m) { const int row = u.pm * 256 + ai * 128 + wr * 64 + m * 16 + fr; const float rs = rsv[ai * 4 + m];
                float g[8], uu[8], o[8];
#pragma unroll
                for (int k = 0; k < 8; ++k) { g[k] = acc[ai][0][m][k >> 2][k & 3] * rs; uu[k] = acc[ai][1][m][k >> 2][k & 3] * (rs * (1.0f / LOG2E_)); }
#pragma unroll
                for (int k = 0; k < 8; ++k) { rot[m + 1][0][k] = dpp_ror1(g[k]); rot[m + 1][1][k] = dpp_ror2(g[k]);
                    const float g1 = (fr == 0) ? rot[m][0][k] : rot[m + 1][0][k], g2 = (fr < 2) ? rot[m][1][k] : rot[m + 1][1][k];
                    const float v = __builtin_fmaf(w2[k], g[k], __builtin_fmaf(w1[k], g1, __builtin_fmaf(w0[k], g2, bb[k])));
                    o[k] = v * __builtin_amdgcn_rcpf(1.0f + __builtin_amdgcn_exp2f(-v)) * uu[k]; }
                pg8::u32x4 ow; ow.x = pg8::cvt_pk_bf16(o[0], o[1]); ow.y = pg8::cvt_pk_bf16(o[2], o[3]); ow.z = pg8::cvt_pk_bf16(o[4], o[5]); ow.w = pg8::cvt_pk_bf16(o[6], o[7]);
                NT_STORE((pg8::u32x4*)(ACT + act_blk + (size_t)(ai * 8 + m) * ((DFF >> 5) * 512)), ow);
                if (m == 0 && fr < 2 && ai == 0 && wr == 0) { float* sg = sideG + ((size_t)u.pm * 4 + fr) * DFF + ch0; float* su = sideU + ((size_t)u.pm * 2 + fr) * DFF + ch0;
                    *(pg8::f32x4*)sg = (pg8::f32x4){g[0], g[1], g[2], g[3]}; *(pg8::f32x4*)(sg + 4) = (pg8::f32x4){g[4], g[5], g[6], g[7]};
                    *(pg8::f32x4*)su = (pg8::f32x4){uu[0], uu[1], uu[2], uu[3]} * LOG2E_; *(pg8::f32x4*)(su + 4) = (pg8::f32x4){uu[4], uu[5], uu[6], uu[7]} * LOG2E_; }
                if (m == 3 && fr >= 14 && ai == 1 && wr == 1) { float* sg = sideG + ((size_t)u.pm * 4 + 2 + (fr - 14)) * DFF + ch0;
                    *(pg8::f32x4*)sg = (pg8::f32x4){g[0], g[1], g[2], g[3]}; *(pg8::f32x4*)(sg + 4) = (pg8::f32x4){g[4], g[5], g[6], g[7]}; }
            }
        }
    }
};
namespace pg8 { template <> struct RowsLds<EpiGuFused> { static constexpr bool value = true; }; }
struct Args { const float* in[21]; float* out; unsigned char* ws; int ph_lo, ph_hi; };
struct Frame {
    LAS unsigned char* lds;
    int tid, lane, wave, G, vcu;
    unsigned char* ws;
};

__device__ __forceinline__ void ph_ffn_fixup(Frame& F, bf16* ACT, const float* sideG, const float* sideU, const float* cw, const float* cb) {
    const int gt = F.vcu * NTHR + F.tid, NT = F.G * NTHR;
    for (int it = gt; it < 128 * 2 * 704; it += NT) {
        const int oct = it % 704, rr = (it / 704) & 1, pm = it / 1408, ch0 = oct * 8; const bool first = (pm & 7) == 0;
        const float* pm2 = rr == 0 ? sideG + ((size_t)(pm - 1) * 4 + 2) * DFF + ch0 : sideG + ((size_t)(pm - 1) * 4 + 3) * DFF + ch0;
        const float* pm1 = rr == 0 ? sideG + ((size_t)(pm - 1) * 4 + 3) * DFF + ch0 : sideG + ((size_t)pm * 4 + 0) * DFF + ch0;
        const float* p0 = sideG + ((size_t)pm * 4 + rr) * DFF + ch0; const float* pu = sideU + ((size_t)pm * 2 + rr) * DFF + ch0;
        float gm2[8], gm1[8], g0[8], uu[8], o[8];
#pragma unroll
        for (int k = 0; k < 8; ++k) { gm2[k] = first ? 0.f : pm2[k]; gm1[k] = (first && rr == 0) ? 0.f : pm1[k]; g0[k] = p0[k]; uu[k] = pu[k]; }
#pragma unroll
        for (int k = 0; k < 8; ++k) { const float v = cb[ch0 + k] + cw[ch0 + k] * gm2[k] + cw[DFF + ch0 + k] * gm1[k] + cw[2 * DFF + ch0 + k] * g0[k];
            o[k] = v * __builtin_amdgcn_rcpf(1.0f + __builtin_amdgcn_exp2f(-1.4426950408889634f * v)) * uu[k]; }
        v4u ow; ow.x = pk2(o[0], o[1]); ow.y = pk2(o[2], o[3]); ow.z = pk2(o[4], o[5]); ow.w = pk2(o[6], o[7]);
        *(v4u*)(ACT + blk_off(pm * 256 + rr, ch0, DFF)) = ow;
    }
}
__device__ __forceinline__ int dest_row(int kind, int n0) { if (kind == 0) return n0; const int c = n0 < DFF ? n0 : n0 - DFF; return (c >> 7) * 256 + (c & 127) + (n0 < DFF ? 0 : 128); }
__device__ __forceinline__ void p0_transpose_item(const float* W, int K, int N, bf16* WT, int kind, LAS unsigned char* scr, int item, int lane, const float* gain) {
    constexpr int TP = 264;
    const int nblk = (N + 127) / 128;
    const int kb = item / nblk, nb = item % nblk, k0 = 64 * kb, n0 = 128 * nb;
    const int nn = n0 + 4 * (lane & 31); const bool ok = nn < N;
    f32x4 v[32];
#pragma unroll
    for (int i = 0; i < 32; ++i) { const int kk = 2 * i + (lane >> 5); v[i] = ok ? *(const f32x4*)(W + (size_t)(k0 + kk) * N + nn) : (f32x4){0.f, 0.f, 0.f, 0.f}; }
#pragma unroll
    for (int i = 0; i < 32; ++i) { const int kk = 2 * i + (lane >> 5); f32x4 x = v[i]; if (gain) x = x * gain[k0 + kk];
        v2u w; w.x = pk2w(x.x, x.y); w.y = pk2w(x.z, x.w); *(LAS v2u*)(scr + kk * TP + 8 * (lane & 31)) = w; }
    asm volatile("s_waitcnt lgkmcnt(0)" ::: "memory");
    const int r0 = dest_row(kind, n0);
#pragma unroll 4
    for (int i = 0; i < 16; ++i) { const int p = lane + 64 * i, c = p & 7, n = p >> 3; const LAS unsigned char* s = scr + (8 * c) * TP + 2 * n;
        unsigned e[8];
#pragma unroll
        for (int q = 0; q < 8; ++q) e[q] = *(const LAS bf16*)(s + q * TP);
        v4u o; o.x = e[0] | (e[1] << 16); o.y = e[2] | (e[3] << 16); o.z = e[4] | (e[5] << 16); o.w = e[6] | (e[7] << 16);
        { const int cc = n & 31, rho = 16 * ((cc >> 2) & 1) + 4 * (cc >> 3) + (cc & 3);
          *(v4u*)(WT + blk_off(r0 + (n & ~31) + rho, k0 + 8 * c, K)) = o; } }
    asm volatile("s_waitcnt lgkmcnt(0)" ::: "memory");
}
__device__ __forceinline__ void p0_transpose(const float* W, int K, int N, bf16* WT, int kind, LAS unsigned char* scr, int gw, int NGW, int lane, const float* gain = nullptr) {
    const int nitems = (K / 64) * ((N + 127) / 128);
    for (int item = gw; item < nitems; item += NGW) p0_transpose_item(W, K, N, WT, kind, scr, item, lane, gain);
}
constexpr int L1_I0 = (DM / 64) * ((O_IN + 127) / 128), L1_I1 = (DM / 64) * (DM / 128), L1_I2 = (DM / 64) * (GUW / 128), L1_I3 = (DFF / 64) * (DM / 128), L1_ITEMS = L1_I0 + L1_I1 + L1_I2 + L1_I3;
__device__ __forceinline__ void conv_l1_item(Frame& F, const Args& A, int it, LAS unsigned char* scr) {
    unsigned char* ws = F.ws;
    if (it < L1_I0) { p0_transpose_item(A.in[13], DM, O_IN, (bf16*)(ws + WS_WIN1), 0, scr, it, F.lane, FOLD ? A.in[1] + DM : nullptr); return; } it -= L1_I0;
    if (it < L1_I1) { p0_transpose_item(A.in[14], DM, DM, (bf16*)(ws + WS_WOUT1), 0, scr, it, F.lane, nullptr); return; } it -= L1_I1;
    if (it < L1_I2) { p0_transpose_item(A.in[16] + (size_t)DM * GUW, DM, GUW, (bf16*)(ws + WS_WGU1), 1, scr, it, F.lane, FOLD ? A.in[2] + DM : nullptr); return; } it -= L1_I2;
    p0_transpose_item(A.in[19] + (size_t)DFF * DM, DFF, DM, (bf16*)(ws + WS_WDN1), 0, scr, it, F.lane, nullptr);
}
__device__ __forceinline__ int t5_bucket(int n) {
    if (n < 16) return n;
    int lg = 16 + (int)(logf((float)n / 16.0f) / logf(8.0f) * 16.0f);
    return lg < 31 ? lg : 31;
}
template <bool OUT_BF16>
__device__ __forceinline__ void rmsnorm_rows(Frame& F, const float* X, const float* g, void* out) {
    const int gw = F.vcu * NWAVES + F.wave, NGW = F.G * NWAVES;
    for (int row = gw; row < MTOK; row += NGW) {
        const f32x4* xr = (const f32x4*)(X + (size_t)row * DM) + F.lane;
        f32x4 v[8]; float s = 0.f;
#pragma unroll
        for (int j = 0; j < 8; ++j) { v[j] = xr[64 * j]; s += (v[j].x * v[j].x + v[j].y * v[j].y) + (v[j].z * v[j].z + v[j].w * v[j].w); }
        const float rstd = 1.0f / sqrtf(wave_sum(s) * (1.0f / DM) + EPS);
#pragma unroll
        for (int j = 0; j < 8; ++j) { const f32x4 gg = ((const f32x4*)g)[F.lane + 64 * j]; const f32x4 o = v[j] * rstd * gg;
            if (OUT_BF16) { v2u w; w.x = pk2(o.x, o.y); w.y = pk2(o.z, o.w); *((v2u*)((bf16*)out + (size_t)row * DM) + F.lane + 64 * j) = w; }
            else *((f32x4*)((float*)out + (size_t)row * DM) + F.lane + 64 * j) = o; }
    }
}
__device__ __forceinline__ void p0_prologue(Frame& F, const Args& A) {
    LAS unsigned char* scr = F.lds + F.wave * 17408;
    const int gw = F.vcu * NWAVES + F.wave, NGW = F.G * NWAVES;
    unsigned char* ws = F.ws;
#if DEFER_L1
    { constexpr int I0 = (DM / 64) * (E_IN / 128), I1 = (DM / 64) * (DM / 128), I2 = (DM / 64) * (GUW / 128), I3 = (DFF / 64) * (DM / 128);
      for (int it0 = gw; it0 < I0 + I1 + I2 + I3 + L1_I0 + L1_I1; it0 += NGW) { int it = it0;
          if (it < I0) { p0_transpose_item(A.in[3], DM, E_IN, (bf16*)(ws + WS_WIN0), 0, scr, it, F.lane, FOLD ? A.in[1] : nullptr); continue; } it -= I0;
          if (it < I1) { p0_transpose_item(A.in[12], DM, DM, (bf16*)(ws + WS_WOUT0), 0, scr, it, F.lane, nullptr); continue; } it -= I1;
          if (it < I2) { p0_transpose_item(A.in[16], DM, GUW, (bf16*)(ws + WS_WGU0), 1, scr, it, F.lane, FOLD ? A.in[2] : nullptr); continue; } it -= I2;
          if (it < I3) { p0_transpose_item(A.in[19], DFF, DM, (bf16*)(ws + WS_WDN0), 0, scr, it, F.lane, nullptr); continue; } it -= I3;
          if (it < L1_I0) { p0_transpose_item(A.in[13], DM, O_IN, (bf16*)(ws + WS_WIN1), 0, scr, it, F.lane, FOLD ? A.in[1] + DM : nullptr); continue; } it -= L1_I0;
          p0_transpose_item(A.in[14], DM, DM, (bf16*)(ws + WS_WOUT1), 0, scr, it, F.lane, nullptr); } }
#else
    p0_transpose(A.in[3], DM, E_IN, (bf16*)(ws + WS_WIN0), 0, scr, gw, NGW, F.lane, FOLD ? A.in[1] : nullptr);
    p0_transpose(A.in[12], DM, DM, (bf16*)(ws + WS_WOUT0), 0, scr, gw, NGW, F.lane);
#if !DEFER_L1
    p0_transpose(A.in[13], DM, O_IN, (bf16*)(ws + WS_WIN1), 0, scr, gw, NGW, F.lane, FOLD ? A.in[1] + DM : nullptr);
#endif
#if !DEFER_L1
    p0_transpose(A.in[14], DM, DM, (bf16*)(ws + WS_WOUT1), 0, scr, gw, NGW, F.lane);
#endif
    p0_transpose(A.in[16], DM, GUW, (bf16*)(ws + WS_WGU0), 1, scr, gw, NGW, F.lane, FOLD ? A.in[2] : nullptr);
#if !DEFER_L1
    p0_transpose(A.in[16] + (size_t)DM * GUW, DM, GUW, (bf16*)(ws + WS_WGU1), 1, scr, gw, NGW, F.lane, FOLD ? A.in[2] + DM : nullptr);
#endif
    p0_transpose(A.in[19], DFF, DM, (bf16*)(ws + WS_WDN0), 0, scr, gw, NGW, F.lane);
#if !DEFER_L1
    p0_transpose(A.in[19] + (size_t)DFF * DM, DFF, DM, (bf16*)(ws + WS_WDN1), 0, scr, gw, NGW, F.lane);
#endif
#endif
    const int gt = F.vcu * NTHR + F.tid, NT = F.G * NTHR;
    { v4u* z = (v4u*)((bf16*)(ws + WS_WIN1) + (size_t)4224 * DM); const int n16 = (O_INP - 4224) * DM / 8; for (int i = gt; i < n16; i += NT) z[i] = (v4u){0u, 0u, 0u, 0u}; }
    { f32x2* rot = (f32x2*)(ws + WS_ROT);
      for (int i = gt; i < SEQ * 64; i += NT) { const int t = i >> 6, j = i & 63; const float freq = exp2f(-(float)j * (13.287712379549449f / 64.0f)); const float ang = (float)t * freq;
          const float rev = ang * 0.15915494309189535f; const float fr = rev - floorf(rev); rot[i] = (f32x2){__builtin_amdgcn_cosf(fr), __builtin_amdgcn_sinf(fr)}; } }
    { bf16* waT = (bf16*)(ws + WS_GT); bf16* wxT = waT + 8 * 128 * 128;
      for (int i = gt; i < 8 * 128 * 128; i += NT) { const int n = i >> 14, e = (i >> 7) & 127, d = i & 127; waT[i] = (bf16)f2bf(A.in[7][(n * 128 + d) * 128 + e]); wxT[i] = (bf16)f2bf(A.in[9][(n * 128 + d) * 128 + e]); } }
    { float* tb = (float*)(ws + WS_TB); for (int i = gt; i < 128 * 16; i += NT) { const int n = i >> 4, h = i & 15; tb[i] = A.in[15][t5_bucket(n) * 16 + h]; }
      float* sp = (float*)(ws + WS_SP); for (int i = gt; i < 1024; i += NT) { const float x = -A.in[11][i]; sp[i] = fmaxf(x, 0.f) + log1pf(__expf(-fabsf(x))); } }
#if FOLD == 0
    rmsnorm_rows<true>(F, A.in[0], A.in[1], ws + WS_H);
#else
    { bf16* XB = (bf16*)(ws + WS_XB); float* rstd0 = (float*)(ws + WS_RSTD);
      for (int rb = gw; rb < MTOK / 16; rb += NGW) { const int row = rb * 16 + (F.lane >> 2); const float* xr = A.in[0] + (size_t)row * DM + (F.lane & 3) * 8; bf16* ob = XB + (size_t)rb * (DM / 32) * 512 + F.lane * 8; float s = 0.f;
#pragma unroll 8
          for (int cb = 0; cb < DM / 32; ++cb) { const f32x4 v0 = *(const f32x4*)(xr + cb * 32), v1 = *(const f32x4*)(xr + cb * 32 + 4);
              s += ((v0.x * v0.x + v0.y * v0.y) + (v0.z * v0.z + v0.w * v0.w)) + ((v1.x * v1.x + v1.y * v1.y) + (v1.z * v1.z + v1.w * v1.w));
              v4u w; w.x = pk2(v0.x, v0.y); w.y = pk2(v0.z, v0.w); w.z = pk2(v1.x, v1.y); w.w = pk2(v1.z, v1.w); *(v4u*)(ob + cb * 512) = w; }
          s += __shfl_xor(s, 1); s += __shfl_xor(s, 2);
          if ((F.lane & 3) == 0) rstd0[row] = rstd_of(s); } }
#endif
}

__device__ __forceinline__ void ret_naive_unit(Frame& F, const Args& A, int b, int h) {
    LAS float* ql = (LAS float*)(F.lds); LAS float* kl = ql + 16 * 128; LAS float* vl = kl + 16 * 128; LAS float* yp = vl + 16 * 128;
    const bf16* PROJ = (const bf16*)(F.ws + WS_PROJ); bf16* MIX = (bf16*)(F.ws + WS_H); const f32x2* rot = (const f32x2*)(F.ws + WS_ROT);
    const float* gn = A.in[4];
    const int tid = F.tid, e = tid & 127, dg = tid >> 7;
    const float gamma = 1.0f - exp2f(-5.0f - (float)h);
    float S[32];
#pragma unroll
    for (int i = 0; i < 32; ++i) S[i] = 0.f;
    for (int t0 = 0; t0 < SEQ; t0 += 16) {
        { const int row = tid >> 5, t = t0 + row; const bf16* prow = PROJ + (size_t)(b * SEQ + t) * E_IN;
#pragma unroll
          for (int rep = 0; rep < 2; ++rep) { const int i = (tid & 31) + 32 * rep; const f32x2 cs = rot[t * 64 + i];
              const float q1 = bf2f(prow[C0_Q + h * 128 + i]), q2 = bf2f(prow[C0_Q + h * 128 + i + 64]);
              const float k1 = bf2f(prow[C0_K + h * 128 + i]), k2 = bf2f(prow[C0_K + h * 128 + i + 64]);
              ql[row * 128 + i] = q1 * cs.x - q2 * cs.y; ql[row * 128 + i + 64] = q2 * cs.x + q1 * cs.y;
              kl[row * 128 + i] = (k1 * cs.x - k2 * cs.y) * 0.08838834764831845f; kl[row * 128 + i + 64] = (k2 * cs.x + k1 * cs.y) * 0.08838834764831845f;
              vl[row * 128 + i] = bf2f(prow[C0_V + h * 128 + i]); vl[row * 128 + i + 64] = bf2f(prow[C0_V + h * 128 + i + 64]); } }
        __syncthreads();
        for (int r = 0; r < 16; ++r) {
            const float vv = vl[r * 128 + e]; float yacc = 0.f;
#pragma unroll
            for (int q4 = 0; q4 < 8; ++q4) { const f32x4 k4 = *(const LAS f32x4*)(kl + r * 128 + dg * 32 + 4 * q4); const f32x4 qq = *(const LAS f32x4*)(ql + r * 128 + dg * 32 + 4 * q4);
#pragma unroll
                for (int j = 0; j < 4; ++j) { S[4 * q4 + j] = gamma * S[4 * q4 + j] + k4[j] * vv; yacc += qq[j] * S[4 * q4 + j]; } }
            yp[(r * 4 + dg) * 128 + e] = yacc;
        }
        __syncthreads();
#pragma unroll
        for (int rr = 0; rr < 2; ++rr) { const int r = 2 * F.wave + rr; const int l = F.lane;
            const float y0 = (yp[(r * 4 + 0) * 128 + l] + yp[(r * 4 + 1) * 128 + l]) + (yp[(r * 4 + 2) * 128 + l] + yp[(r * 4 + 3) * 128 + l]);
            const float y1 = (yp[(r * 4 + 0) * 128 + l + 64] + yp[(r * 4 + 1) * 128 + l + 64]) + (yp[(r * 4 + 2) * 128 + l + 64] + yp[(r * 4 + 3) * 128 + l + 64]);
            const float rstd = 1.0f / sqrtf(wave_sum(y0 * y0 + y1 * y1) * (1.0f / 128.0f) + EPS);
            const size_t tok = (size_t)(b * SEQ + t0 + r);
            const float g0 = bf2f(PROJ[tok * E_IN + C0_G + h * 128 + l]), g1 = bf2f(PROJ[tok * E_IN + C0_G + h * 128 + l + 64]);
            MIX[tok * DM + h * 128 + l] = (bf16)f2bf(y0 * rstd * gn[h * 128 + l] * siluf_(g0));
            MIX[tok * DM + h * 128 + l + 64] = (bf16)f2bf(y1 * rstd * gn[h * 128 + l + 64] * siluf_(g1)); }
        __syncthreads();
    }
}
__device__ __forceinline__ void lru_naive_unit(Frame& F, const Args& A, int b, int n) {
    LAS float* xc = (LAS float*)(F.lds); LAS float* pr = xc + 8 * 128; LAS float* pi = pr + 8 * 4 * 128;
    const bf16* PROJ = (const bf16*)(F.ws + WS_PROJ); bf16* MIX = (bf16*)(F.ws + WS_H);
    const float* cw = A.in[5]; const float* cb = A.in[6]; const float* wa = A.in[7]; const float* ba = A.in[8]; const float* wx = A.in[9]; const float* bx = A.in[10];
    const float* sp = (const float*)(F.ws + WS_SP);
    const int tid = F.tid, e = tid & 127, part = tid >> 7;
    float war[32], wxr[32];
#pragma unroll
    for (int dd = 0; dd < 32; ++dd) { war[dd] = wa[(size_t)(n * 128 + part * 32 + dd) * 128 + e]; wxr[dd] = wx[(size_t)(n * 128 + part * 32 + dd) * 128 + e]; }
    const int ce = n * 128 + e;
    const float bae = ba[ce], bxe = bx[ce], spe = sp[ce];
    float cwr[2][4], cbr[2];
#pragma unroll
    for (int rep = 0; rep < 2; ++rep) { const int c = n * 128 + (tid & 63) + 64 * rep; cbr[rep] = cb[c];
#pragma unroll
        for (int j = 0; j < 4; ++j) cwr[rep][j] = cw[j * 1024 + c]; }
    float hst = 0.f;
    for (int t0 = 0; t0 < SEQ; t0 += 8) {
        { const int row = tid >> 6, t = t0 + row;
#pragma unroll
          for (int rep = 0; rep < 2; ++rep) { const int c = (tid & 63) + 64 * rep; float a = cbr[rep];
#pragma unroll
              for (int j = 0; j < 4; ++j) { const int tt = t - 3 + j; if (tt >= 0) a += cwr[rep][j] * bf2f(PROJ[(size_t)(b * SEQ + tt) * E_IN + C0_XR + n * 128 + c]); }
              xc[row * 128 + c] = a; } }
        __syncthreads();
        for (int r = 0; r < 8; ++r) { float pa = 0.f, px = 0.f;
#pragma unroll
            for (int q4 = 0; q4 < 8; ++q4) { const f32x4 x4 = *(const LAS f32x4*)(xc + r * 128 + part * 32 + 4 * q4);
#pragma unroll
                for (int j = 0; j < 4; ++j) { pa += x4[j] * war[4 * q4 + j]; px += x4[j] * wxr[4 * q4 + j]; } }
            pr[(r * 4 + part) * 128 + e] = pa; pi[(r * 4 + part) * 128 + e] = px; }
        __syncthreads();
        if (tid < 128) {
            for (int r = 0; r < 8; ++r) {
                const float ra = (pr[(r * 4 + 0) * 128 + e] + pr[(r * 4 + 1) * 128 + e]) + (pr[(r * 4 + 2) * 128 + e] + pr[(r * 4 + 3) * 128 + e]) + bae;
                const float ia = (pi[(r * 4 + 0) * 128 + e] + pi[(r * 4 + 1) * 128 + e]) + (pi[(r * 4 + 2) * 128 + e] + pi[(r * 4 + 3) * 128 + e]) + bxe;
                const float rg = sigmoidf_(ra), ig = sigmoidf_(ia);
                const float log_a = -8.0f * rg * spe; const float a = __expf(log_a);
                const float em = -expm1f(2.0f * log_a); const float mult = sqrtf(fmaxf(em, 0.f));
                const float bb = mult * (ig * xc[r * 128 + e]);
                hst = a * hst + bb;
                const size_t tok = (size_t)(b * SEQ + t0 + r);
                const float y = bf2f(PROJ[tok * E_IN + C0_YR + n * 128 + e]);
                MIX[tok * DM + 1024 + n * 128 + e] = (bf16)f2bf(hst * gelu_tanh(y));
            }
        }
        __syncthreads();
    }
}
__device__ __forceinline__ void ph_mixer0_naive(Frame& F, const Args& A) {
    for (int u = F.vcu; u < 256; u += F.G) {
        if (u < 128) ret_naive_unit(F, A, u >> 3, u & 7); else lru_naive_unit(F, A, (u - 128) >> 3, (u - 128) & 7);
        __syncthreads();
    }
}
namespace mx {
typedef float f32x16 __attribute__((ext_vector_type(16)));
typedef short s16x8 __attribute__((ext_vector_type(8)));
constexpr int PB = 272;
constexpr int OFF_KH = 0, OFF_KT = 34816, OFF_VT = 69632, OFF_ST = 104448, OFF_SSQ = 139264;
__device__ __forceinline__ int crow(int r, int hi) { return (r & 3) + 8 * (r >> 2) + 4 * hi; }
__device__ __forceinline__ unsigned cvtpk(float lo, float hi) { unsigned r; asm volatile("v_cvt_pk_bf16_f32 %0, %1, %2" : "=v"(r) : "v"(lo), "v"(hi)); return r; }
__device__ __forceinline__ float blo(unsigned w) { return __uint_as_float(w << 16); }
__device__ __forceinline__ float bhi(unsigned w) { return __uint_as_float(w & 0xffff0000u); }
#define MFMA32(a, b, c) __builtin_amdgcn_mfma_f32_32x32x16_bf16((a), (b), (c), 0, 0, 0)
typedef short s16x4 __attribute__((ext_vector_type(4)));
__device__ __forceinline__ s16x4 trr(int addr) { s16x4 r; asm volatile("ds_read_b64_tr_b16 %0, %1" : "=&v"(r) : "v"(addr) : "memory"); return r; }
#define TRWAIT() do { asm volatile("s_waitcnt lgkmcnt(0)" ::: "memory"); __builtin_amdgcn_sched_barrier(0); } while (0)
__device__ __forceinline__ void rot_cs(int t, float freq, float& c, float& s) {
    const float rev = ((float)t * freq) * 0.15915494309189535f, fr = rev - floorf(rev); c = __builtin_amdgcn_cosf(fr); s = __builtin_amdgcn_sinf(fr);
}
__device__ __forceinline__ void ret_unit(Frame& F, const Args& A, int b, int h) {
    LAS unsigned char* KH = F.lds + OFF_KH; LAS unsigned char* GT = F.lds + OFF_KT;     LAS unsigned char* VT = F.lds + OFF_VT; LAS unsigned char* STB = F.lds + OFF_ST;
    LAS float* SSQ = (LAS float*)(F.lds + OFF_SSQ); LAS float* FRQ = SSQ + 256;
    const bf16* PROJ = (const bf16*)(F.ws + WS_PROJ); bf16* MIX = (bf16*)(F.ws + WS_H);
    const float* gn = A.in[4];
    const int tid = F.tid, lane = F.lane, wave = F.wave, c = lane & 31, hi = lane >> 5, I = wave >> 1, E = wave & 1;
    const float lg = log2f(1.0f - exp2f(-5.0f - (float)h));
    const float g128 = exp2f(128.0f * lg);
    f32x16 st0 = {}, st1 = {};
    const int trl = ((lane & 15) >> 2) * PB + (16 * ((lane >> 4) & 1) + 4 * (lane & 3)) * 2;
    const int vtr = (int)(unsigned)(size_t)VT + trl, ktr = (int)(unsigned)(size_t)KH + trl;
    for (int i = tid; i < 34816 / 16; i += NTHR) ((LAS v4u*)STB)[i] = (v4u){0u, 0u, 0u, 0u};
    if (tid < 64) FRQ[tid] = exp2f(-(float)tid * (13.287712379549449f / 64.0f));
    v4u kraw[2][2], vraw[4], qraw[4][2], graw[4];
    const int il = 32 * I + c;
    const int tcK = (int)blk_off(tid >> 3, C0_K + h * 128 + (tid & 7) * 8, E_IN), tcV = (int)blk_off(tid >> 4, C0_V + h * 128 + (tid & 15) * 8, E_IN), tcQ = (int)blk_off(il, C0_Q + h * 128 + 8 * hi, E_IN);
#define RET_LOAD(n_) do { const bf16* cb_ = PROJ + ((size_t)b * SEQ + (n_) * 128) * E_IN; \
        _Pragma("unroll") for (int rep = 0; rep < 2; ++rep) { kraw[rep][0] = *(const v4u*)(cb_ + (size_t)(64 * rep) * E_IN + tcK); kraw[rep][1] = *(const v4u*)(cb_ + (size_t)(64 * rep) * E_IN + tcK + 1024); } } while (0)
#define RET_LOADVG(n_) do { const bf16* cb_ = PROJ + ((size_t)b * SEQ + (n_) * 128) * E_IN; \
        _Pragma("unroll") for (int rep = 0; rep < 4; ++rep) { vraw[rep] = *(const v4u*)(cb_ + (size_t)(32 * rep) * E_IN + tcV); graw[rep] = *(const v4u*)(cb_ + (size_t)(32 * rep) * E_IN + tcV + 32 * 512); } } while (0)
#define RET_LOADQ(n_) do { const bf16* cb_ = PROJ + ((size_t)b * SEQ + (n_) * 128) * E_IN + tcQ; \
        _Pragma("unroll") for (int ks = 0; ks < 4; ++ks) { qraw[ks][0] = *(const v4u*)(cb_ + (ks >> 1) * 512 + 16 * (ks & 1)); qraw[ks][1] = *(const v4u*)(cb_ + (ks >> 1) * 512 + 16 * (ks & 1) + 1024); } } while (0)
    __syncthreads();
    for (int n = 0; n < SEQ / 128; ++n) {
        const size_t tok0 = (size_t)b * SEQ + n * 128;
        RET_LOAD(n);
#pragma unroll
        for (int rep = 0; rep < 2; ++rep) { const int idx = tid + 512 * rep, j = idx >> 3, d0 = (idx & 7) * 8;
            const v4u xlo = kraw[rep][0], xhi = kraw[rep][1];
            const float ks = 0.08838834764831845f * __builtin_amdgcn_exp2f(-(float)j * lg);
            const f32x4 f0 = *(const LAS f32x4*)(FRQ + d0), f1 = *(const LAS f32x4*)(FRQ + d0 + 4); const float fq_[8] = {f0.x, f0.y, f0.z, f0.w, f1.x, f1.y, f1.z, f1.w};
            float o1[8], o2[8];
#pragma unroll
            for (int q = 0; q < 4; ++q) { float c0, s0, c1, s1; rot_cs(n * 128 + j, fq_[2 * q], c0, s0); rot_cs(n * 128 + j, fq_[2 * q + 1], c1, s1);
                const float a1 = blo(xlo[q]), a2 = blo(xhi[q]), b1 = bhi(xlo[q]), b2 = bhi(xhi[q]);
                o1[2 * q] = (a1 * c0 - a2 * s0) * ks; o2[2 * q] = (a2 * c0 + a1 * s0) * ks;
                o1[2 * q + 1] = (b1 * c1 - b2 * s1) * ks; o2[2 * q + 1] = (b2 * c1 + b1 * s1) * ks; }
            v4u w1, w2;
#pragma unroll
            for (int q = 0; q < 4; ++q) { w1[q] = cvtpk(o1[2 * q], o1[2 * q + 1]); w2[q] = cvtpk(o2[2 * q], o2[2 * q + 1]); }
            *(LAS v4u*)(KH + j * PB + d0 * 2) = w1; *(LAS v4u*)(KH + j * PB + (d0 + 64) * 2) = w2; }
        RET_LOADQ(n); RET_LOADVG(n);
        s16x8 qf[8];
        { const float qs = __builtin_amdgcn_exp2f((float)il * lg);
#pragma unroll
          for (int ks = 0; ks < 4; ++ks) { const int d0 = 16 * ks + 8 * hi; const v4u xlo = qraw[ks][0], xhi = qraw[ks][1];
              const f32x4 f0 = *(const LAS f32x4*)(FRQ + d0), f1 = *(const LAS f32x4*)(FRQ + d0 + 4); const float fq_[8] = {f0.x, f0.y, f0.z, f0.w, f1.x, f1.y, f1.z, f1.w}; v4u w1, w2;
#pragma unroll
              for (int q = 0; q < 4; ++q) { float c0, s0, c1, s1; rot_cs(n * 128 + il, fq_[2 * q], c0, s0); rot_cs(n * 128 + il, fq_[2 * q + 1], c1, s1);
                  const float a1 = blo(xlo[q]), a2 = blo(xhi[q]), b1 = bhi(xlo[q]), b2 = bhi(xhi[q]);
                  w1[q] = cvtpk((a1 * c0 - a2 * s0) * qs, (b1 * c1 - b2 * s1) * qs); w2[q] = cvtpk((a2 * c0 + a1 * s0) * qs, (b2 * c1 + b1 * s1) * qs); }
              qf[ks] = *reinterpret_cast<s16x8*>(&w1); qf[ks + 4] = *reinterpret_cast<s16x8*>(&w2); } }
#pragma unroll
        for (int rep = 0; rep < 4; ++rep) { const int idx = tid + 512 * rep, j = idx >> 4, e0 = (idx & 15) * 8; *(LAS v4u*)(VT + j * PB + e0 * 2) = vraw[rep]; *(LAS v4u*)(GT + j * PB + e0 * 2) = graw[rep]; }
        __syncthreads();
        f32x16 y0 = {}, y1 = {};
#pragma unroll
        for (int ks = 0; ks < 8; ++ks) { const s16x8 a0 = *(const LAS s16x8*)(STB + (64 * E + c) * PB + (16 * ks + 8 * hi) * 2), a1 = *(const LAS s16x8*)(STB + (64 * E + 32 + c) * PB + (16 * ks + 8 * hi) * 2);
            y0 = MFMA32(a0, qf[ks], y0); y1 = MFMA32(a1, qf[ks], y1); __builtin_amdgcn_sched_barrier(0); }
        for (int J = 0; J <= I; ++J) {
            f32x16 s = {};
#pragma unroll
            for (int ks = 0; ks < 8; ++ks) { const s16x8 ak = *(const LAS s16x8*)(KH + (32 * J + c) * PB + (16 * ks + 8 * hi) * 2); s = MFMA32(ak, qf[ks], s); if (ks & 1) __builtin_amdgcn_sched_barrier(0); }
            { const int lim = c + 32 * (I - J);
#pragma unroll
              for (int r = 0; r < 16; ++r) s[r] = (crow(r, hi) <= lim) ? s[r] : 0.f; }
#pragma unroll
            for (int s2 = 0; s2 < 2; ++s2) { v4u pw;
#pragma unroll
                for (int q = 0; q < 4; ++q) pw[q] = cvtpk(s[8 * s2 + 2 * q], s[8 * s2 + 2 * q + 1]);
                const s16x8 pb = *reinterpret_cast<s16x8*>(&pw);
                const int jb = 32 * J + 16 * s2 + 4 * hi;
                { const s16x4 l4 = trr(vtr + jb * PB + (64 * E) * 2), h4 = trr(vtr + (jb + 8) * PB + (64 * E) * 2);
                  const s16x4 l5 = trr(vtr + jb * PB + (64 * E + 32) * 2), h5 = trr(vtr + (jb + 8) * PB + (64 * E + 32) * 2);
                  TRWAIT();
                  y0 = MFMA32(((s16x8){l4[0], l4[1], l4[2], l4[3], h4[0], h4[1], h4[2], h4[3]}), pb, y0);
                  y1 = MFMA32(((s16x8){l5[0], l5[1], l5[2], l5[3], h5[0], h5[1], h5[2], h5[3]}), pb, y1); } }
        }
        { const int et = wave >> 1, dt0 = 2 * (wave & 1);
#pragma unroll
          for (int ks = 0; ks < 8; ++ks) { const int jr = 16 * ks + 8 * hi;
              const s16x4 al = trr(vtr + jr * PB + (32 * et) * 2), ah = trr(vtr + (jr + 4) * PB + (32 * et) * 2);
              const s16x4 bl0 = trr(ktr + jr * PB + (32 * dt0) * 2), bh0 = trr(ktr + (jr + 4) * PB + (32 * dt0) * 2), bl1 = trr(ktr + jr * PB + (32 * dt0 + 32) * 2), bh1 = trr(ktr + (jr + 4) * PB + (32 * dt0 + 32) * 2);
              TRWAIT();
              const s16x8 av = {al[0], al[1], al[2], al[3], ah[0], ah[1], ah[2], ah[3]};
              st0 = MFMA32(av, ((s16x8){bl0[0], bl0[1], bl0[2], bl0[3], bh0[0], bh0[1], bh0[2], bh0[3]}), st0);
              st1 = MFMA32(av, ((s16x8){bl1[0], bl1[1], bl1[2], bl1[3], bh1[0], bh1[1], bh1[2], bh1[3]}), st1); }
#pragma unroll
          for (int r = 0; r < 16; ++r) { st0[r] *= g128; st1[r] *= g128; } }
        { float ss = 0.f;
#pragma unroll
          for (int r = 0; r < 16; ++r) ss += y0[r] * y0[r] + y1[r] * y1[r];
          ss += __shfl_xor(ss, 32);
          if (hi == 0) SSQ[(I * 2 + E) * 32 + c] = ss; }
        __syncthreads();
        { const int et = wave >> 1, dt0 = 2 * (wave & 1);
#pragma unroll
          for (int r = 0; r < 16; ++r) { const int e = 32 * et + crow(r, hi);
              *(LAS bf16*)(STB + e * PB + (32 * dt0 + c) * 2) = (bf16)f2bf(st0[r]); *(LAS bf16*)(STB + e * PB + (32 * dt0 + 32 + c) * 2) = (bf16)f2bf(st1[r]); } }
        { const float tot = SSQ[(I * 2) * 32 + c] + SSQ[(I * 2 + 1) * 32 + c]; const float rstd = __builtin_amdgcn_rsqf(tot * (1.0f / 128.0f) + EPS);
#pragma unroll
          for (int et2 = 0; et2 < 2; ++et2)
#pragma unroll
              for (int rg = 0; rg < 4; ++rg) { const int e0 = 64 * E + 32 * et2 + 8 * rg + 4 * hi;
                  LAS v2u* slot = (LAS v2u*)(GT + il * PB + e0 * 2);
                  const v2u gw = *slot; const f32x4 gv = *(const f32x4*)(gn + h * 128 + e0);
                  const f32x16& yy = et2 ? y1 : y0;
                  const float o0 = yy[4 * rg] * rstd * gv.x * siluf_(blo(gw.x)), o1 = yy[4 * rg + 1] * rstd * gv.y * siluf_(bhi(gw.x));
                  const float o2 = yy[4 * rg + 2] * rstd * gv.z * siluf_(blo(gw.y)), o3 = yy[4 * rg + 3] * rstd * gv.w * siluf_(bhi(gw.y));
                  v2u ow; ow.x = cvtpk(o0, o1); ow.y = cvtpk(o2, o3);
                  *slot = ow; } }
        __syncthreads();
#pragma unroll
        for (int rep = 0; rep < 4; ++rep) { const int idx = tid + 512 * rep, j = idx >> 4, e0 = (idx & 15) * 8;
            *(v4u*)(MIX + blk_off((int)(tok0 + j), h * 128 + e0, DM)) = *(const LAS v4u*)(GT + j * PB + e0 * 2); }
        __syncthreads();
    }
}
constexpr int L_RAW = 0;
constexpr int L_XC = 32768;
constexpr int L_AL = L_XC + 17408;
constexpr int L_BL = L_AL + 32768;
constexpr int L_SEG = L_BL + 32768;
constexpr int L_CAR = L_SEG + 4096;
constexpr int L_CW = L_CAR + 1024;
__device__ __forceinline__ float fsig(float x) { return __builtin_amdgcn_rcpf(1.0f + __builtin_amdgcn_exp2f(-1.4426950408889634f * x)); }
__device__ __forceinline__ void lru_unit(Frame& F, const Args& A, int b, int n) {
    LAS unsigned char* RAW = F.lds + L_RAW; LAS unsigned char* XC = F.lds + L_XC; LAS float* AL = (LAS float*)(F.lds + L_AL); LAS float* BL = (LAS float*)(F.lds + L_BL);
    LAS float* SEGA = (LAS float*)(F.lds + L_SEG); LAS float* SEGB = SEGA + 512; LAS float* CAR = (LAS float*)(F.lds + L_CAR);
    const bf16* PROJ = (const bf16*)(F.ws + WS_PROJ); bf16* MIX = (bf16*)(F.ws + WS_H);
    const bf16* waT = (const bf16*)(F.ws + WS_GT); const bf16* wxT = waT + 8 * 128 * 128;
    const int tid = F.tid, lane = F.lane, wave = F.wave, c = lane & 31, hi = lane >> 5, et = wave & 3, tt = wave >> 2;
    const int e = 32 * et + c, ce = n * 128 + e;
    s16x8 wfa[8], wfx[8];
#pragma unroll
    for (int ks = 0; ks < 8; ++ks) { wfa[ks] = *(const s16x8*)(waT + (size_t)ce * 128 + 16 * ks + 8 * hi); wfx[ks] = *(const s16x8*)(wxT + (size_t)ce * 128 + 16 * ks + 8 * hi); }
    const float bae = A.in[8][ce], bxe = A.in[10][ce], spe = ((const float*)(F.ws + WS_SP))[ce];
    const int c0 = 8 * (tid & 15);
    LAS float* CW = (LAS float*)(F.lds + L_CW);
    if (tid < 128) { CW[512 + tid] = A.in[6][n * 128 + tid];
#pragma unroll
        for (int j = 0; j < 4; ++j) CW[j * 128 + tid] = A.in[5][j * 1024 + n * 128 + tid]; }
    const bf16* xrb = PROJ + (size_t)b * SEQ * E_IN + C0_XR + n * 128;
    const bf16* yrb = PROJ + (size_t)b * SEQ * E_IN + C0_YR + n * 128;
    bf16* outb = MIX + (size_t)b * SEQ * DM + 1024 + n * 128;
    const int ch = tid & 127, seg = tid >> 7;
    if (tid < 128) CAR[tid] = 0.f;
    if (tid < 48) *(LAS v4u*)(RAW + (125 + tid / 16) * 256 + (tid & 15) * 16) = (v4u){0u, 0u, 0u, 0u};
#pragma unroll
    for (int rep = 0; rep < 2; ++rep) { const int idx = tid + 512 * rep, r = idx >> 4, o = idx & 15; *(LAS v4u*)(RAW + r * 256 + o * 16) = *(const v4u*)(PROJ + blk_off(b * SEQ + r, C0_XR + n * 128 + o * 8, E_IN)); }
    __syncthreads();
    for (int k = 0; k < SEQ / 64; ++k) {
        const int t0 = 64 * k;
        v4u pre[2];
        if (k + 1 < SEQ / 64) {
#pragma unroll
            for (int rep = 0; rep < 2; ++rep) { const int idx = tid + 512 * rep, r = idx >> 4, o = idx & 15; pre[rep] = *(const v4u*)(PROJ + blk_off(b * SEQ + t0 + 64 + r, C0_XR + n * 128 + o * 8, E_IN)); } }
        else { pre[0] = (v4u){0u, 0u, 0u, 0u}; pre[1] = pre[0]; }
        unsigned yv[8];
#pragma unroll
        for (int r = 0; r < 8; ++r) yv[r] = (unsigned)PROJ[blk_off(b * SEQ + t0 + 16 * seg + 2 * r, C0_YR + n * 128 + ch, E_IN)] | ((unsigned)PROJ[blk_off(b * SEQ + t0 + 16 * seg + 2 * r + 1, C0_YR + n * 128 + ch, E_IN)] << 16);
#pragma unroll
        for (int rep = 0; rep < 2; ++rep) { const int tl = (tid >> 4) + 32 * rep, t = t0 + tl; float acc[8];
            { const f32x4 b0 = *(const LAS f32x4*)(CW + 512 + c0), b1 = *(const LAS f32x4*)(CW + 512 + c0 + 4);
              acc[0] = b0.x; acc[1] = b0.y; acc[2] = b0.z; acc[3] = b0.w; acc[4] = b1.x; acc[5] = b1.y; acc[6] = b1.z; acc[7] = b1.w; }
#pragma unroll
            for (int j = 0; j < 4; ++j) { const v4u xv = *(const LAS v4u*)(RAW + ((t - 3 + j) & 127) * 256 + c0 * 2);
                const f32x4 w0 = *(const LAS f32x4*)(CW + j * 128 + c0), w1 = *(const LAS f32x4*)(CW + j * 128 + c0 + 4);
                acc[0] += w0.x * blo(xv[0]); acc[1] += w0.y * bhi(xv[0]); acc[2] += w0.z * blo(xv[1]); acc[3] += w0.w * bhi(xv[1]);
                acc[4] += w1.x * blo(xv[2]); acc[5] += w1.y * bhi(xv[2]); acc[6] += w1.z * blo(xv[3]); acc[7] += w1.w * bhi(xv[3]); }
            v4u w;
#pragma unroll
            for (int q = 0; q < 4; ++q) w[q] = cvtpk(acc[2 * q], acc[2 * q + 1]);
            *(LAS v4u*)(XC + tl * PB + c0 * 2) = w; }
        __syncthreads();
        { f32x16 ra = {}, ia = {};
#pragma unroll
          for (int ks = 0; ks < 8; ++ks) { const s16x8 a = *(const LAS s16x8*)(XC + (32 * tt + c) * PB + (16 * ks + 8 * hi) * 2); ra = MFMA32(a, wfa[ks], ra); ia = MFMA32(a, wfx[ks], ia); }
#pragma unroll
          for (int r = 0; r < 16; ++r) { const int tl = 32 * tt + crow(r, hi);
              const float rg = fsig(ra[r] + bae), ig = fsig(ia[r] + bxe);
              const float la2 = -16.0f * rg * spe;
              const float a = __builtin_amdgcn_exp2f(0.7213475204444817f * la2);
              const float em = (la2 > -0.05f) ? -la2 * (1.0f + la2 * (0.5f + la2 * (0.16666667f + la2 * 0.041666668f))) : 1.0f - a * a;
              const float x = bf2f(*(const LAS bf16*)(XC + tl * PB + e * 2));
              AL[tl * 128 + e] = a; BL[tl * 128 + e] = __builtin_amdgcn_sqrtf(fmaxf(em, 0.f)) * (ig * x); } }
        __syncthreads();
        { float As = 1.f, Bs = 0.f;
#pragma unroll
          for (int r = 0; r < 16; ++r) { const float a = AL[(16 * seg + r) * 128 + ch], bb = BL[(16 * seg + r) * 128 + ch]; Bs = a * Bs + bb; As *= a; }
          SEGA[seg * 128 + ch] = As; SEGB[seg * 128 + ch] = Bs; }
#pragma unroll
        for (int rep = 0; rep < 2; ++rep) { const int idx = tid + 512 * rep, r = idx >> 4, o = idx & 15; *(LAS v4u*)(RAW + (((t0 + 64 + r) & 127)) * 256 + o * 16) = pre[rep]; }
        __syncthreads();
        { float hs = CAR[(k & 1) * 128 + ch];
#pragma unroll
          for (int s = 0; s < 3; ++s) if (s < seg) hs = SEGA[s * 128 + ch] * hs + SEGB[s * 128 + ch];
#pragma unroll
          for (int r = 0; r < 16; ++r) { const float a = AL[(16 * seg + r) * 128 + ch], bb = BL[(16 * seg + r) * 128 + ch]; hs = a * hs + bb;
              const float y = (r & 1) ? bhi(yv[r >> 1]) : blo(yv[r >> 1]); const float u = 0.7978845608028654f * (y + 0.044715f * y * y * y);
              const float th = 1.0f - 2.0f * __builtin_amdgcn_rcpf(1.0f + __builtin_amdgcn_exp2f(2.885390081777927f * u));
              MIX[blk_off(b * SEQ + t0 + 16 * seg + r, 1024 + n * 128 + ch, DM)] = (bf16)f2bf(hs * 0.5f * y * (1.0f + th)); }
          if (seg == 3) CAR[((k + 1) & 1) * 128 + ch] = hs; }
    }
}
#undef MFMA32
}
__device__ __forceinline__ void drain_conv_queue(Frame& F, const Args& A, int ctr_word, int lo, int hi) {
    unsigned* ctr = (unsigned*)(F.ws + WS_CTL) + ctr_word; LAS unsigned* slot = (LAS unsigned*)(F.lds + 8 * 17408); LAS unsigned char* scr = F.lds + F.wave * 17408;
    for (;;) { __syncthreads();
        if (F.tid == 0) *slot = __hip_atomic_fetch_add(ctr, 8u, __ATOMIC_RELAXED, __HIP_MEMORY_SCOPE_AGENT);
        __syncthreads();
        const int base = lo + (int)*slot; if (base >= hi) break;
        const int it = base + F.wave; if (it < hi) conv_l1_item(F, A, it, scr); }
}
__device__ __forceinline__ void ph_mixer0(Frame& F, const Args& A) {
#if MIXER0 == 3
    for (int u = F.vcu; u < 128; u += F.G) { __syncthreads(); ret_naive_unit(F, A, u >> 3, u & 7); }
#else
#if PROBE_DUP == 21
    for (int rep_ = 0; rep_ < 2; ++rep_)
#endif
    for (int u = F.vcu; u < 128; u += F.G) { __syncthreads(); mx::ret_unit(F, A, u >> 3, u & 7); }
#endif
#if MIXER0 == 2
    for (int u = F.vcu; u < 256; u += F.G) { if (u < 128) continue; __syncthreads(); lru_naive_unit(F, A, (u - 128) >> 3, (u - 128) & 7); }
#else
#if PROBE_DUP == 22
    for (int rep_ = 0; rep_ < 2; ++rep_)
#endif
    for (int u = F.vcu; u < 256; u += F.G) { if (u < 128) continue; __syncthreads(); mx::lru_unit(F, A, (u - 128) >> 3, (u - 128) & 7); }
#endif
#if DEFER_L1
    drain_conv_queue(F, A, 2048, L1_I0 + L1_I1, L1_I0 + L1_I1);
#endif
}
__device__ __forceinline__ void ph_act_naive(Frame& F, const bf16* GUB, bf16* ACT, const float* cw, const float* cb, int Mh) {
    const int gt = F.vcu * NTHR + F.tid, NT = F.G * NTHR; const int nrb = Mh / 32;
    for (int it = gt; it < nrb * 704; it += NT) {
        const int oct = it % 704, rb = it / 704, c0 = oct * 8, gcol = (c0 >> 7) * 256 + (c0 & 127);
        float w0[8], w1[8], w2[8], bb[8];
#pragma unroll
        for (int k = 0; k < 8; ++k) { w0[k] = cw[c0 + k]; w1[k] = cw[DFF + c0 + k]; w2[k] = cw[2 * DFF + c0 + k]; bb[k] = cb[c0 + k]; }
        const int r0 = rb * 32; const bool first = (r0 % SEQ) == 0;
        float g1[8], g2[8];
        { v4u a = (v4u){0u, 0u, 0u, 0u}, c = a; if (!first) { a = *(const v4u*)(GUB + (size_t)(r0 - 2) * GUW + gcol); c = *(const v4u*)(GUB + (size_t)(r0 - 1) * GUW + gcol); }
#pragma unroll
          for (int k = 0; k < 4; ++k) { g2[2 * k] = __uint_as_float(a[k] << 16); g2[2 * k + 1] = __uint_as_float(a[k] & 0xffff0000u); g1[2 * k] = __uint_as_float(c[k] << 16); g1[2 * k + 1] = __uint_as_float(c[k] & 0xffff0000u); } }
        for (int r = r0; r < r0 + 32; ++r) {
            const v4u gv = *(const v4u*)(GUB + (size_t)r * GUW + gcol), uv = *(const v4u*)(GUB + (size_t)r * GUW + gcol + 128);
            float g[8], u[8], o[8];
#pragma unroll
            for (int k = 0; k < 4; ++k) { g[2 * k] = __uint_as_float(gv[k] << 16); g[2 * k + 1] = __uint_as_float(gv[k] & 0xffff0000u); u[2 * k] = __uint_as_float(uv[k] << 16); u[2 * k + 1] = __uint_as_float(uv[k] & 0xffff0000u); }
#pragma unroll
            for (int k = 0; k < 8; ++k) { const float v = bb[k] + w0[k] * g2[k] + w1[k] * g1[k] + w2[k] * g[k]; o[k] = siluf_(v) * u[k]; g2[k] = g1[k]; g1[k] = g[k]; }
            v4u ov; ov.x = pk2(o[0], o[1]); ov.y = pk2(o[2], o[3]); ov.z = pk2(o[4], o[5]); ov.w = pk2(o[6], o[7]);
            *(v4u*)(ACT + (size_t)r * DFF + c0) = ov;
        }
    }
}
__device__ __forceinline__ unsigned ord_key(float f) { const unsigned u = __float_as_uint(f); return (u & 0x80000000u) ? ~u : (u | 0x80000000u); }
__device__ __forceinline__ void ph_dsa_naive(Frame& F) {
    LAS float* qil = (LAS float*)(F.lds);
    LAS float* wl = (LAS float*)(F.lds + 4096);
    LAS float* ql = (LAS float*)(F.lds + 8192);
    LAS unsigned* sc = (LAS unsigned*)(F.lds + 16384);
    LAS int* idxl = (LAS int*)(F.lds + 24576);
    LAS float* pl = (LAS float*)(F.lds + 25600);
    LAS float* red = (LAS float*)(F.lds + 26624);
    LAS int* cntl = (LAS int*)(F.lds + 26752);
    LAS int* wtot = (LAS int*)(F.lds + 26880);
    LAS float* op = (LAS float*)(F.lds + 28672);
    const bf16* P1 = (const bf16*)(F.ws + WS_PROJ); bf16* ATT = (bf16*)(F.ws + WS_H); const float* tb = (const float*)(F.ws + WS_TB);
    const int tid = F.tid, lane = F.lane, wave = F.wave;
    for (int unit = F.vcu; unit < MTOK; unit += F.G) {
        const int b = unit >> 11, t = unit & 2047; const bf16* P = P1 + (size_t)unit * O_INP;
        for (int i = tid; i < 1024; i += NTHR) qil[i] = bf2f(P[C1_QI + i]);
        if (tid < 16) wl[tid] = bf2f(P[C1_WI + tid]) * 0.03125f;
        for (int i = tid; i < 2048; i += NTHR) ql[i] = bf2f(P[C1_Q + i]);
        __syncthreads();
        bool sel[4];
        if (t >= 256) {
#pragma unroll 1
            for (int j = 0; j < 4; ++j) { const int s = tid + 512 * j; unsigned key = 0u;
                if (s <= t) { const v4u* kp = (const v4u*)(P1 + (size_t)(b * SEQ + s) * O_INP + C1_KI); float kv[64];
#pragma unroll
                    for (int q = 0; q < 8; ++q) { const v4u w = kp[q];
#pragma unroll
                        for (int k = 0; k < 4; ++k) { kv[8 * q + 2 * k] = __uint_as_float(w[k] << 16); kv[8 * q + 2 * k + 1] = __uint_as_float(w[k] & 0xffff0000u); } }
                    float score = 0.f;
#pragma unroll 1
                    for (int h = 0; h < 16; ++h) { float d = 0.f;
#pragma unroll
                        for (int q = 0; q < 16; ++q) { const f32x4 a = *(const LAS f32x4*)(qil + h * 64 + 4 * q); d += a.x * kv[4 * q] + a.y * kv[4 * q + 1] + a.z * kv[4 * q + 2] + a.w * kv[4 * q + 3]; }
                        score += wl[h] * fmaxf(d, 0.f); }
                    key = ord_key(score); }
                sc[s] = key; }
            __syncthreads();
            const unsigned k0 = sc[tid], k1 = sc[tid + 512], k2 = sc[tid + 1024], k3 = sc[tid + 1536];
            unsigned T = 0u;
#pragma unroll 1
            for (int bit = 31; bit >= 0; --bit) { const unsigned cand = T | (1u << bit);
                int c = (k0 >= cand) + (k1 >= cand) + (k2 >= cand) + (k3 >= cand); c = wave_sum_i(c);
                if (lane == 0) cntl[(bit & 1) * 8 + wave] = c;
                __syncthreads();
                int tot = 0;
#pragma unroll
                for (int w = 0; w < 8; ++w) tot += cntl[(bit & 1) * 8 + w];
                if (tot >= 256) T = cand; }
            int cg = (k0 > T) + (k1 > T) + (k2 > T) + (k3 > T), ce = (k0 == T) + (k1 == T) + (k2 == T) + (k3 == T);
            cg = wave_sum_i(cg); ce = wave_sum_i(ce);
            __syncthreads();
            if (lane == 0) { cntl[wave] = cg; cntl[8 + wave] = ce; }
            __syncthreads();
            int ngt = 0, neq = 0;
#pragma unroll
            for (int w = 0; w < 8; ++w) { ngt += cntl[w]; neq += cntl[8 + w]; }
            const int need = 256 - ngt;
            if (neq > need) {
                if (tid == 0) { int taken = 0; for (int s = 0; s <= t; ++s) if (sc[s] == T) { if (taken < need) ++taken; else sc[s] = 0u; } }
                __syncthreads();
            }
#pragma unroll
            for (int j = 0; j < 4; ++j) { const int s = tid + 512 * j; sel[j] = (s <= t) && (sc[s] >= T); }
        } else {
#pragma unroll
            for (int j = 0; j < 4; ++j) sel[j] = (tid + 512 * j) <= t;
        }
        int pre[4];
#pragma unroll
        for (int j = 0; j < 4; ++j) { const unsigned long long bal = __ballot(sel[j]); pre[j] = __popcll(bal & ((1ull << lane) - 1ull)); if (lane == 0) wtot[j * 8 + wave] = __popcll(bal); }
        __syncthreads();
        int nsel = 0;
        { int run = 0; int base[4];
#pragma unroll
          for (int j = 0; j < 4; ++j) {
#pragma unroll
              for (int w = 0; w < 8; ++w) { if (w == wave) base[j] = run; run += wtot[j * 8 + w]; } }
          nsel = run;
#pragma unroll
          for (int j = 0; j < 4; ++j) if (sel[j]) idxl[base[j] + pre[j]] = tid + 512 * j; }
        __syncthreads();
        for (int hq = 0; hq < 16; ++hq) { const int kvh = hq >> 2;
            float logit = -INFINITY;
            if (tid < nsel) { const int s = idxl[tid]; const v4u* kp = (const v4u*)(P1 + (size_t)(b * SEQ + s) * O_INP + C1_K + kvh * 128); float d = 0.f;
#pragma unroll
                for (int q = 0; q < 16; ++q) { const v4u w = kp[q]; const f32x4 a0 = *(const LAS f32x4*)(ql + hq * 128 + 8 * q), a1 = *(const LAS f32x4*)(ql + hq * 128 + 8 * q + 4);
                    d += a0.x * __uint_as_float(w.x << 16) + a0.y * __uint_as_float(w.x & 0xffff0000u) + a0.z * __uint_as_float(w.y << 16) + a0.w * __uint_as_float(w.y & 0xffff0000u)
                       + a1.x * __uint_as_float(w.z << 16) + a1.y * __uint_as_float(w.z & 0xffff0000u) + a1.z * __uint_as_float(w.w << 16) + a1.w * __uint_as_float(w.w & 0xffff0000u); }
                const int dist = t - s; logit = d * 0.08838834764831845f + tb[(dist < 127 ? dist : 127) * 16 + hq]; }
            float mx = wave_max(logit); if (lane == 0) red[wave] = mx;
            __syncthreads();
            mx = fmaxf(fmaxf(fmaxf(red[0], red[1]), fmaxf(red[2], red[3])), fmaxf(fmaxf(red[4], red[5]), fmaxf(red[6], red[7])));
            const float p = (tid < nsel) ? __expf(logit - mx) : 0.f;
            if (tid < 256) pl[tid] = p;
            float sm = wave_sum(p); if (lane == 0) red[8 + wave] = sm;
            __syncthreads();
            sm = ((red[8] + red[9]) + (red[10] + red[11])) + ((red[12] + red[13]) + (red[14] + red[15]));
            { const int d = tid & 127, part = tid >> 7; float a = 0.f; const int j1 = (part * 64 + 64) < nsel ? (part * 64 + 64) : nsel;
              for (int j = part * 64; j < j1; ++j) a += pl[j] * bf2f(P1[(size_t)(b * SEQ + idxl[j]) * O_INP + C1_V + kvh * 128 + d]);
              op[part * 128 + d] = a; }
            __syncthreads();
            if (tid < 128) ATT[(size_t)unit * DM + hq * 128 + tid] = (bf16)f2bf(((op[tid] + op[128 + tid]) + (op[256 + tid] + op[384 + tid])) / sm);
            __syncthreads();
        }
    }
}

typedef float f32x16 __attribute__((ext_vector_type(16)));
typedef short s16x8 __attribute__((ext_vector_type(8)));
typedef short s16x4 __attribute__((ext_vector_type(4)));
constexpr int IDX_ROWB = 144;
constexpr int IDX_CHUNK = 256 * IDX_ROWB;
__device__ __forceinline__ int half_sum_i(int v) {
#pragma unroll
    for (int o = 1; o < 32; o <<= 1) v += __shfl_xor(v, o);
    return v;
}
__device__ __forceinline__ void half_sums(int v, int& s0, int& s1) {
    v += __builtin_amdgcn_update_dpp(0, v, 0x111, 0xf, 0xf, true);
    v += __builtin_amdgcn_update_dpp(0, v, 0x112, 0xf, 0xf, true);
    v += __builtin_amdgcn_update_dpp(0, v, 0x114, 0xf, 0xf, true);
    v += __builtin_amdgcn_update_dpp(0, v, 0x118, 0xf, 0xf, true);
    s0 = __builtin_amdgcn_readlane(v, 15) + __builtin_amdgcn_readlane(v, 31); s1 = __builtin_amdgcn_readlane(v, 47) + __builtin_amdgcn_readlane(v, 63);
}
typedef unsigned short us2 __attribute__((ext_vector_type(2)));
__device__ __forceinline__ void ph_indexer(Frame& F) {
    const bf16* P1 = (const bf16*)(F.ws + WS_PROJ); unsigned* SEL = (unsigned*)(F.ws + WS_SEL);
    const int wave = F.wave;
    LAS unsigned char* kl = F.lds;
    bool pref = false;
    for (int u = F.vcu; u < 2048; u += F.G) {
        const int it = u >> 8, cc = u & 255, tg0 = cc & 127, tg = (it & 1) ? 127 - tg0 : tg0, b = (cc >> 7) + 2 * it;
        int tid = F.tid; asm volatile("" : "+v"(tid));
        const int lane = tid & 63, c = lane & 31, hh = lane >> 5;
        const int t0 = tg * 16, tq = t0 + 2 * wave + hh;
        unsigned* selb = SEL + (size_t)b * 32 * SEQ * 2; const int tw0 = t0 + 2 * wave;
        if (t0 < 256) {
#pragma unroll
            for (int q = 0; q < 2; ++q) { const int t = tw0 + q, lo = 32 * lane;
                selb[((size_t)(lane >> 1) * SEQ + t) * 2 + (lane & 1)] = (t >= lo + 31) ? 0xffffffffu : (t < lo ? 0u : ((2u << (t - lo)) - 1u)); }
            pref = false; continue;
        }
        LAS unsigned char* pf = kl + 2 * IDX_CHUNK + 4096 + 8192 + wave * 6144;
#define PF_DMA(bb, tt0) do { const int qrw_ = (bb) * SEQ + (tt0) + 2 * wave + ((c >> 2) & 1), qcl_ = C1_QI + ((c & 3) + 4 * (c >> 3)) * 64 + 8 * hh; \
            _Pragma("unroll") for (int ks = 0; ks < 4; ++ks) __builtin_amdgcn_global_load_lds((const unsigned*)(P1 + blk_off(qrw_, qcl_ + 16 * ks, O_INP)), (LAS unsigned*)(pf + ks * 1024), 16, 0, 0); \
            const bf16* wp_ = P1 + blk_off((bb) * SEQ + (tt0) + 2 * wave + hh, C1_WI, O_INP); \
            __builtin_amdgcn_global_load_lds((const unsigned*)wp_, (LAS unsigned*)(pf + 4096), 16, 0, 0); __builtin_amdgcn_global_load_lds((const unsigned*)(wp_ + 8), (LAS unsigned*)(pf + 5120), 16, 0, 0); } while (0)
        const int nch = (t0 + 15) / 256 + 1;
        const bf16* kib = P1 + (size_t)(b * SEQ) * O_INP + C1_KI;
        if (!pref) __syncthreads();
#define IDX_DMA_B(b, chunk, buf) do { _Pragma("unroll") for (int n_ = 0; n_ < 5; ++n_) { const int n = wave + 8 * n_; if (n < 36) { const int q = 64 * n + lane, row = q / 9, sg0 = q - 9 * row, sg = sg0 < 8 ? sg0 : 7; \
            __builtin_amdgcn_global_load_lds((const unsigned*)(P1 + blk_off(b * SEQ + (chunk) * 256 + row, C1_KI + sg * 8, O_INP)), (LAS unsigned*)(kl + (buf) * IDX_CHUNK + n * 1024), 16, 0, 0); } } } while (0)
#define IDX_DMA(chunk, buf) IDX_DMA_B(b, chunk, buf)
        if (!pref) { IDX_DMA(0, 0); PF_DMA(b, t0); }
        __syncthreads();
        s16x8 Afr[4];
#pragma unroll
        for (int ks = 0; ks < 4; ++ks) Afr[ks] = *(const LAS s16x8*)(pf + ks * 1024 + lane * 16);
        const v4u w0 = *(const LAS v4u*)(pf + 4096 + lane * 16), w1 = *(const LAS v4u*)(pf + 5120 + lane * 16);
        float wv[16];
        {
#pragma unroll
          for (int k = 0; k < 4; ++k) { wv[2 * k] = __uint_as_float(w0[k] << 16) * 0.03125f; wv[2 * k + 1] = __uint_as_float(w0[k] & 0xffff0000u) * 0.03125f;
              wv[8 + 2 * k] = __uint_as_float(w1[k] << 16) * 0.03125f; wv[8 + 2 * k + 1] = __uint_as_float(w1[k] & 0xffff0000u) * 0.03125f; } }
        unsigned key[64];
#pragma unroll
        for (int ch = 0; ch < 8; ++ch) {
            if (ch < nch) {
                if (ch < 7) IDX_DMA(ch + 1, (ch + 1) & 1);
                const LAS unsigned char* kb = kl + (ch & 1) * IDX_CHUNK;
#pragma unroll
                for (int tp = 0; tp < 4; ++tp) { const int tl = 2 * tp, T = ch * 8 + tl;
                    if (32 * (T + 1) <= t0 + 15) {
                        f32x16 acc = {0.f, 0.f, 0.f, 0.f, 0.f, 0.f, 0.f, 0.f, 0.f, 0.f, 0.f, 0.f, 0.f, 0.f, 0.f, 0.f}, acd = acc;
#pragma unroll
                        for (int ks = 0; ks < 4; ++ks) { const s16x8 Bfr = *(const LAS s16x8*)(kb + (tl * 32 + c) * IDX_ROWB + ks * 32 + hh * 16), Bfs = *(const LAS s16x8*)(kb + (tl * 32 + 32 + c) * IDX_ROWB + ks * 32 + hh * 16);
                            acc = __builtin_amdgcn_mfma_f32_32x32x16_bf16(Afr[ks], Bfr, acc, 0, 0, 0); acd = __builtin_amdgcn_mfma_f32_32x32x16_bf16(Afr[ks], Bfs, acd, 0, 0, 0); }
                        float sc = 0.f, sd = 0.f;
#pragma unroll
                        for (int i = 0; i < 16; ++i) { const int rb = (int)__float_as_uint(acc[i]), rd = (int)__float_as_uint(acd[i]);
                            sc = fmaf(wv[i], __uint_as_float((unsigned)(rb > 0 ? rb : 0)), sc); sd = fmaf(wv[i], __uint_as_float((unsigned)(rd > 0 ? rd : 0)), sd); }
                        key[T] = (32 * T + c <= tq) ? ord_key(sc) : 0u; key[T + 1] = (32 * T + 32 + c <= tq) ? ord_key(sd) : 0u;
                        __builtin_amdgcn_sched_barrier(0);
                    } else if (32 * T <= t0 + 15) {
                        f32x16 acc = {0.f, 0.f, 0.f, 0.f, 0.f, 0.f, 0.f, 0.f, 0.f, 0.f, 0.f, 0.f, 0.f, 0.f, 0.f, 0.f};
#pragma unroll
                        for (int ks = 0; ks < 4; ++ks) { const s16x8 Bfr = *(const LAS s16x8*)(kb + (tl * 32 + c) * IDX_ROWB + ks * 32 + hh * 16);
                            acc = __builtin_amdgcn_mfma_f32_32x32x16_bf16(Afr[ks], Bfr, acc, 0, 0, 0); }
                        float sc = 0.f;
#pragma unroll
                        for (int i = 0; i < 16; ++i) { const int rb = (int)__float_as_uint(acc[i]); sc = fmaf(wv[i], __uint_as_float((unsigned)(rb > 0 ? rb : 0)), sc); }
                        key[T] = (32 * T + c <= tq) ? ord_key(sc) : 0u; key[T + 1] = 0u;
                        __builtin_amdgcn_sched_barrier(0);
                    } else { key[T] = 0u; key[T + 1] = 0u; }
                }
                __syncthreads();
            } else {
#pragma unroll
                for (int tl = 0; tl < 8; ++tl) key[ch * 8 + tl] = 0u;
            }
        }
        { const int un = u + F.G; pref = false;
          if (un < 2048) { const int itn = un >> 8, ccn = un & 255, tg0n = ccn & 127, tgn = (itn & 1) ? 127 - tg0n : tg0n, bn = (ccn >> 7) + 2 * itn;
              if (tgn * 16 >= 256) { IDX_DMA_B(bn, 0, 0); PF_DMA(bn, tgn * 16); pref = true; } } }
#undef PF_DMA
#undef IDX_DMA
#undef IDX_DMA_B
        unsigned T0 = 0u, T1 = 0u; int A0 = 1 << 20, A1 = 1 << 20;
        bool compact = false; int G0 = 0, G1 = 0; unsigned cs0 = 0u, cs1 = 0u, cs2 = 0u, cs3 = 0u;
        unsigned hp[32];
#pragma unroll
        for (int j = 0; j < 32; ++j) hp[j] = __builtin_amdgcn_perm(key[2 * j + 1], key[2 * j], 0x07060302u);
#pragma unroll 1
        for (int bit = 31; bit >= 0; --bit) {
            if (bit == 15) { const unsigned Th = (hh ? T1 : T0) >> 16; LAS unsigned* cs = (LAS unsigned*)(kl + 2 * IDX_CHUNK + 4096 + wave * 1024) + lane; int n = 0;
#pragma unroll
                for (int g8 = 0; g8 < 8; ++g8) if (g8 < nch) {
#pragma unroll
                    for (int i = 0; i < 8; ++i) { const unsigned kv = key[g8 * 8 + i]; if ((kv >> 16) == Th) { if (n < 4) cs[n * 64] = (kv & 0xffffu) + 1u; ++n; } } }
                int q0, q1; half_sums(n, q0, q1);
                if (!__any(n > 4)) { compact = true; G0 = A0 - q0; G1 = A1 - q1;
                    asm volatile("s_waitcnt lgkmcnt(0)" ::: "memory");
                    const unsigned r0 = cs[0], r1 = cs[64], r2 = cs[128], r3 = cs[192]; cs0 = n > 0 ? r0 : 0u; cs1 = n > 1 ? r1 : 0u; cs2 = n > 2 ? r2 : 0u; cs3 = n > 3 ? r3 : 0u; } }
            const unsigned c0 = T0 | (1u << bit), c1 = T1 | (1u << bit), cand = hh ? c1 : c0; int cnt = 0;
            if (bit >= 16) {
                const unsigned cm = (cand >> 16) - 1u, pr = cm | (cm << 16), one2 = 0x00010001u; unsigned accp = 0u;
#pragma unroll
                for (int g8 = 0; g8 < 8; ++g8) if (g8 < nch) {
#pragma unroll
                    for (int i = 0; i < 4; ++i) { unsigned d_, f_; asm("v_pk_sub_u16 %0, %1, %2 clamp" : "=v"(d_) : "v"(hp[g8 * 4 + i]), "v"(pr)); asm("v_pk_min_u16 %0, %1, %2" : "=v"(f_) : "v"(d_), "v"(one2));
                        asm("v_pk_add_u16 %0, %1, %2" : "=v"(accp) : "v"(accp), "v"(f_)); } }
                cnt = (int)((accp & 0xffffu) + (accp >> 16));
            } else if (compact) { const unsigned cl = (cand & 0xffffu) + 1u;
                cnt = (cs0 >= cl ? 1 : 0) + (cs1 >= cl ? 1 : 0) + (cs2 >= cl ? 1 : 0) + (cs3 >= cl ? 1 : 0);
            } else {
#pragma unroll
            for (int g8 = 0; g8 < 8; ++g8) if (g8 < nch) {
#pragma unroll
                for (int i = 0; i < 8; ++i) cnt += (key[g8 * 8 + i] >= cand) ? 1 : 0; }
            }
            int n0, n1; half_sums(cnt, n0, n1); if (compact) { n0 += G0; n1 += G1; }
            if (n0 >= 256) { T0 = c0; A0 = n0; } if (n1 >= 256) { T1 = c1; A1 = n1; }
            if (n0 == 256 && n1 == 256) break; }
        const unsigned Tm = hh ? T1 : T0;
        LAS unsigned long long* selw = (LAS unsigned long long*)(kl + 2 * IDX_CHUNK + wave * 512);
        if (A0 == 256 && A1 == 256) {
#pragma unroll
            for (int i = 0; i < 64; ++i) { const unsigned long long bs = ((i >> 3) < nch) ? __ballot(key[i] >= Tm) : 0ull; if (lane == 0) selw[i] = bs; }
        } else {
        int cg = 0;
#pragma unroll
        for (int g8 = 0; g8 < 8; ++g8) if (g8 < nch) {
#pragma unroll
            for (int i = 0; i < 8; ++i) cg += (key[g8 * 8 + i] > Tm) ? 1 : 0; }
        int g0, g1; half_sums(cg, g0, g1);
        const int need = 256 - (hh ? g1 : g0);
        int run = 0;
#pragma unroll
        for (int i = 0; i < 64; ++i) { if ((i >> 3) >= nch) { if (lane == 0) selw[i] = 0ull; continue; }
            const bool gt = key[i] > Tm, eq = key[i] == Tm;
            const unsigned long long beq = __ballot(eq); const unsigned meq = hh ? (unsigned)(beq >> 32) : (unsigned)beq;
            const int rank = __popc(meq & ((1u << c) - 1u));
            const bool sl = gt || (eq && (run + rank < need));
            run += __popc(meq);
            const unsigned long long bs = __ballot(sl);
            if (lane == 0) selw[i] = bs; }
        }
        asm volatile("s_waitcnt lgkmcnt(0)" ::: "memory");
        unsigned wlo, whi;
        { const unsigned long long mine = selw[lane]; wlo = (unsigned)mine; whi = (unsigned)(mine >> 32); }
        selb[((size_t)(lane >> 1) * SEQ + tw0) * 2 + (lane & 1)] = wlo; selb[((size_t)(lane >> 1) * SEQ + tw0 + 1) * 2 + (lane & 1)] = whi;
    }
}

namespace att {
constexpr int D = 128, NW = 8, QBLK = 32, KVBLK = 64, LD = O_INP;
constexpr float SCALE = 0.088388347648318440f, THR = 8.f;
constexpr int SHM_V = KVBLK * D * 2, SHM_K = KVBLK * D * 2;
constexpr int OFF_Q = 2 * SHM_V + 2 * SHM_K, OFF_WS = OFF_Q + 65536, OFF_TB = OFF_WS + NW * 64 * 4;
#define KSWZ(row, colB) ((row) * 256 + ((colB) ^ (((row) & 7) << 4)))
#define SBAR() __builtin_amdgcn_sched_barrier(0)
__device__ __forceinline__ int crow(int r, int hi) { return (r & 3) + 8 * (r >> 2) + 4 * hi; }
__device__ __forceinline__ unsigned cvtpk(float lo, float hi) { unsigned r; asm volatile("v_cvt_pk_bf16_f32 %0, %1, %2" : "=v"(r) : "v"(lo), "v"(hi)); return r; }
__device__ __forceinline__ void partialSM(f32x16& p0, f32x16& p1, float& m_reg, float& mn, float& alpha, bool far, float bfar, const LAS float* tbq, int dbase) {
    constexpr float C = SCALE * 1.4426950408889634f;
    float boff = bfar;
    if (!far) { boff = 0.f;
#pragma unroll
        for (int r = 0; r < 16; ++r) { const int cbr = (r & 3) + 8 * (r >> 2);
            p0[r] += tbq[59 - cbr]; p1[r] += tbq[27 - cbr]; }
    }
    float pmax = p0[0];
#pragma unroll
    for (int r = 1; r < 16; ++r) pmax = fmaxf(pmax, p0[r]);
#pragma unroll
    for (int r = 0; r < 16; ++r) pmax = fmaxf(pmax, p1[r]);
    { auto rr = __builtin_amdgcn_permlane32_swap(__float_as_uint(pmax), __float_as_uint(pmax), false, false);
      pmax = fmaxf(__uint_as_float(rr[0]), __uint_as_float(rr[1])) + boff; }
    if (__builtin_expect(__all(pmax - m_reg <= THR / SCALE), 1)) { mn = m_reg; alpha = 1.f; }
    else { mn = fmaxf(m_reg, pmax); alpha = __builtin_amdgcn_exp2f((m_reg - mn) * C); m_reg = mn; }
    const float mnC = (boff - mn) * C;
#pragma unroll
    for (int r = 0; r < 16; ++r) p0[r] = fmaf(p0[r], C, mnC);
#pragma unroll
    for (int r = 0; r < 16; ++r) p1[r] = fmaf(p1[r], C, mnC);
#pragma unroll
    for (int r = 0; r < 16; ++r) p0[r] = __builtin_amdgcn_exp2f(p0[r]);
}
template <int R> __device__ __forceinline__ void mask1(f32x16& p0, f32x16& p1, unsigned m0, unsigned m1) {
    constexpr int cb = (R & 3) + 8 * (R >> 2); int t0, t1;
    asm("v_bfe_i32 %0, %1, %2, 1" : "=v"(t0) : "v"(m0), "n"(cb));
    asm("v_bfe_i32 %0, %1, %2, 1" : "=v"(t1) : "v"(m1), "n"(cb));
    p0[R] = __uint_as_float(__float_as_uint(p0[R]) & (unsigned)t0); p1[R] = __uint_as_float(__float_as_uint(p1[R]) & (unsigned)t1);
}
__device__ __forceinline__ void mask16(f32x16& p0, f32x16& p1, unsigned m0, unsigned m1) {
    mask1<0>(p0, p1, m0, m1); mask1<1>(p0, p1, m0, m1); mask1<2>(p0, p1, m0, m1); mask1<3>(p0, p1, m0, m1); mask1<4>(p0, p1, m0, m1); mask1<5>(p0, p1, m0, m1); mask1<6>(p0, p1, m0, m1); mask1<7>(p0, p1, m0, m1);
    mask1<8>(p0, p1, m0, m1); mask1<9>(p0, p1, m0, m1); mask1<10>(p0, p1, m0, m1); mask1<11>(p0, p1, m0, m1); mask1<12>(p0, p1, m0, m1); mask1<13>(p0, p1, m0, m1); mask1<14>(p0, p1, m0, m1); mask1<15>(p0, p1, m0, m1);
}
__device__ __forceinline__ void finishSM(f32x16& p0, f32x16& p1, float alpha, float& l_reg, unsigned m0, unsigned m1, s16x8& pa0, s16x8& pa1, s16x8& pa2, s16x8& pa3) {
#pragma unroll
    for (int r = 0; r < 16; ++r) p1[r] = __builtin_amdgcn_exp2f(p1[r]);
    mask16(p0, p1, m0, m1);
    float ps = 0.f;
#pragma unroll
    for (int r = 0; r < 16; ++r) ps += p0[r];
#pragma unroll
    for (int r = 0; r < 16; ++r) ps += p1[r];
    { auto rr = __builtin_amdgcn_permlane32_swap(__float_as_uint(ps), __float_as_uint(ps), false, false);
      ps = __uint_as_float(rr[0]) + __uint_as_float(rr[1]); }
    l_reg = l_reg * alpha + ps;
#define PK4(P, BASE, OUT) do { unsigned a0 = cvtpk(P[BASE + 0], P[BASE + 1]), a1 = cvtpk(P[BASE + 2], P[BASE + 3]);   \
    unsigned b0 = cvtpk(P[BASE + 4], P[BASE + 5]), b1 = cvtpk(P[BASE + 6], P[BASE + 7]);                              \
    auto r0 = __builtin_amdgcn_permlane32_swap(a0, b0, false, false); auto r1 = __builtin_amdgcn_permlane32_swap(a1, b1, false, false); \
    v4u w = {r0[0], r1[0], r0[1], r1[1]}; OUT = *reinterpret_cast<s16x8*>(&w); } while (0)
    PK4(p0, 0, pa0); PK4(p0, 8, pa1); PK4(p1, 0, pa2); PK4(p1, 8, pa3);
#undef PK4
}
__device__ __forceinline__ void qkt(f32x16& p0, f32x16& p1, const int (&ka)[4], const int (&qa)[4], int koff) {
    p0 = f32x16{}; p1 = f32x16{};
#pragma unroll
    for (int d0 = 0; d0 < 8; ++d0) {
        const LAS unsigned char* kp = (const LAS unsigned char*)(size_t)(unsigned)ka[d0 & 3] + koff + (d0 >> 2) * 128;
        const LAS unsigned char* qp = (const LAS unsigned char*)(size_t)(unsigned)qa[d0 & 3] + (d0 >> 2) * 128;
        const s16x8 b0 = *(const LAS s16x8*)(kp);
        const s16x8 b1 = *(const LAS s16x8*)(kp + 8192);
        const s16x8 q = *(const LAS s16x8*)(qp);
        p0 = __builtin_amdgcn_mfma_f32_32x32x16_bf16(b0, q, p0, 0, 0, 0);
        p1 = __builtin_amdgcn_mfma_f32_32x32x16_bf16(b1, q, p1, 0, 0, 0); }
}
__device__ __forceinline__ int v_st(int k, int c) { const int kk = (k & ~0xC) | ((k & 4) << 1) | ((k & 8) >> 1); return ((kk >> 3) * 4 + (c >> 5)) * 512 + ((kk & 7) * 32 + (c & 31)) * 2; }
__device__ __forceinline__ int v_rd_base(int lane) { return ((lane & 3) << 3) | (((lane >> 2) & 3) << 6) | (((lane >> 4) & 1) << 5) | (((lane >> 5) & 1) << 8); }
constexpr int v_rd_off(int d0, int ks, int half) { return d0 * 512 + ks * 4096 + half * 2048; }
template <int OFF> __device__ __forceinline__ s16x4 tr_read(int vb) {
    s16x4 r; asm volatile("ds_read_b64_tr_b16 %0, %1 offset:%2" : "=&v"(r) : "v"(vb), "i"(OFF) : "memory"); return r;
}
template <int D0> __device__ __forceinline__ void pv_one(f32x16& od, int vb, s16x8 pa0, s16x8 pa1, s16x8 pa2, s16x8 pa3) {
    const s16x4 l0 = tr_read<v_rd_off(D0, 0, 0)>(vb), h0 = tr_read<v_rd_off(D0, 0, 1)>(vb), l1 = tr_read<v_rd_off(D0, 1, 0)>(vb), h1 = tr_read<v_rd_off(D0, 1, 1)>(vb);
    const s16x4 l2 = tr_read<v_rd_off(D0, 2, 0)>(vb), h2 = tr_read<v_rd_off(D0, 2, 1)>(vb), l3 = tr_read<v_rd_off(D0, 3, 0)>(vb), h3 = tr_read<v_rd_off(D0, 3, 1)>(vb);
    asm volatile("s_waitcnt lgkmcnt(0)" ::: "memory"); SBAR();
#define PK(L, H) (s16x8){L[0], L[1], L[2], L[3], H[0], H[1], H[2], H[3]}
    od = __builtin_amdgcn_mfma_f32_32x32x16_bf16(pa0, PK(l0, h0), od, 0, 0, 0);
    od = __builtin_amdgcn_mfma_f32_32x32x16_bf16(pa1, PK(l1, h1), od, 0, 0, 0);
    od = __builtin_amdgcn_mfma_f32_32x32x16_bf16(pa2, PK(l2, h2), od, 0, 0, 0);
    od = __builtin_amdgcn_mfma_f32_32x32x16_bf16(pa3, PK(l3, h3), od, 0, 0, 0);
#undef PK
}
__device__ __forceinline__ void pv_d0(f32x16* o, int vb, s16x8 pa0, s16x8 pa1, s16x8 pa2, s16x8 pa3) {
    pv_one<0>(o[0], vb, pa0, pa1, pa2, pa3); pv_one<1>(o[1], vb, pa0, pa1, pa2, pa3); pv_one<2>(o[2], vb, pa0, pa1, pa2, pa3); pv_one<3>(o[3], vb, pa0, pa1, pa2, pa3);
}
__device__ __forceinline__ void attn_unit(const bf16* __restrict__ Qb, int qrow0, int qcol0, int krow0, int kcol0, int vcol0, bf16* __restrict__ Ob, int orow0, int ocol0, int NT,
                                          const unsigned* __restrict__ selq, int i0, LAS unsigned char* lds, float tbv) {
    int tid_ = threadIdx.x; asm volatile("" : "+v"(tid_));
    const int tid = tid_, wid = __builtin_amdgcn_readfirstlane(tid >> 6), lane = tid & 63, r32 = lane & 31, hi = lane >> 5;
    LAS unsigned char* V_lds = lds; LAS unsigned char* K_lds = lds + 2 * SHM_V;
    LAS float* ws = (LAS float*)(lds + OFF_WS) + wid * 64; LAS float* li_l = ws; LAS float* al_l = ws + 32;
    const LAS float* tbq = (const LAS float*)(lds + OFF_TB);
    const int tq = i0 + wid * QBLK + r32, tqmin = i0 + wid * QBLK;
    float m_reg = -1e30f, l_reg = 0.f; f32x16 o[4] = {};
    LAS unsigned char* Q_lds = lds + OFF_Q; const int qrow = wid * QBLK + r32;
    const int sr = tid >> 4, sc = (tid & 15) * 8;
    const int vb0 = (int)(unsigned)(size_t)V_lds + v_rd_base(lane);
    { const int tcQ = (int)blk_off(sr, qcol0 + sc, LD);
#pragma unroll
      for (int r = 0; r < 8; ++r) { const int row = sr + 32 * r; *(LAS s16x8*)(Q_lds + KSWZ(row, sc * 2)) = *(const s16x8*)(Qb + (size_t)(qrow0 + 32 * r) * LD + tcQ); } }
    int gK, gV;
    { const int L = tid * 16;
      { const int row = L >> 8, cb = (L & 255) ^ ((row & 7) << 4); gK = (int)blk_off(row, kcol0 + (cb >> 1), LD); }
      { const int s = L >> 9, w = (L & 511) >> 1, kk = ((s >> 2) << 3) | (w >> 5), k = (kk & ~0xC) | ((kk & 4) << 1) | ((kk & 8) >> 1), c = (s & 3) * 32 + (w & 31); gV = (int)blk_off(k, vcol0 + c, LD); } }
    const int dmaw = __builtin_amdgcn_readfirstlane(wid) * 1024;
    int ka[4], qa[4];
#pragma unroll
    for (int i = 0; i < 4; ++i) { ka[i] = (int)(unsigned)(size_t)K_lds + KSWZ(r32, i * 32 + hi * 16); qa[i] = (int)(unsigned)(size_t)Q_lds + KSWZ(qrow, i * 32 + hi * 16); }
#define KDMA(b, k0) do { const bf16* tb_ = Qb + (size_t)(krow0 + (k0)) * LD; _Pragma("unroll") for (int i_ = 0; i_ < 2; ++i_) \
    __builtin_amdgcn_global_load_lds((const unsigned*)(tb_ + (size_t)i_ * 32 * LD + gK), (LAS unsigned*)(K_lds + (b) * SHM_K + dmaw + i_ * 8192), 16, 0, 0); } while (0)
#define VDMA(b, k0) do { const bf16* tb_ = Qb + (size_t)(krow0 + (k0)) * LD; _Pragma("unroll") for (int i_ = 0; i_ < 2; ++i_) \
    __builtin_amdgcn_global_load_lds((const unsigned*)(tb_ + (size_t)i_ * 32 * LD + gV), (LAS unsigned*)(V_lds + (b) * SHM_V + dmaw + i_ * 8192), 16, 0, 0); } while (0)
#define VMW(n) asm volatile("s_waitcnt vmcnt(" #n ")" ::: "memory")
#define WGBAR() asm volatile("s_barrier" ::: "memory")
#define RESC(a) do { if (__any((a) < 1.f)) { if (hi == 0) al_l[r32] = (a); asm volatile("s_waitcnt lgkmcnt(0)" ::: "memory"); \
    _Pragma("unroll") for (int d = 0; d < 4; ++d) _Pragma("unroll") for (int r = 0; r < 16; ++r) o[d][r] *= al_l[crow(r, hi)]; } } while (0)
#define FAR(j) (64 * (j) + 63 + 113 <= tqmin)
#define DBASE(j) (tq - 64 * (j) - 4 * hi)
#define MLOAD(j) (*(const unsigned long long*)mptr)
    f32x16 pA0, pA1, pB0, pB1; float mnA, mnB, alA, alB; s16x8 pa0, pa1, pa2, pa3; const unsigned* mptr = selq; unsigned long long mwA, mwB;
#define MNEXT(mw) do { mw = *(const unsigned long long*)mptr; mptr += SEQ * 2; } while (0)
#define FIN(P0, P1, AL, MW) finishSM(P0, P1, AL, l_reg, (unsigned)(MW) >> (4 * hi), (unsigned)((MW) >> 32) >> (4 * hi), pa0, pa1, pa2, pa3)
    KDMA(0, 0); VDMA(0, 0); MNEXT(mwA); KDMA(1, KVBLK); MNEXT(mwB);
    ((LAS float*)(lds + OFF_TB))[tid] = tbv;
    VMW(0); __syncthreads();
    const float bfar = tbq[256 + 127];
    qkt(pA0, pA1, ka, qa, 0); partialSM(pA0, pA1, m_reg, mnA, alA, FAR(0), bfar, tbq + (DBASE(0) + 197), 0);
    WGBAR();
    for (int j = 1; j + 1 < NT; j += 2) {
        KDMA(0, (j + 1) * KVBLK); VDMA(1, j * KVBLK);
        SBAR(); qkt(pB0, pB1, ka, qa, (int)SHM_K);
        FIN(pA0, pA1, alA, mwA); SBAR();
        MNEXT(mwA); SBAR();
        pv_d0(o, vb0, pa0, pa1, pa2, pa3); partialSM(pB0, pB1, m_reg, mnB, alB, FAR(j), bfar, tbq + (DBASE(j) + 197), 0);
        RESC(alB); VMW(0); asm volatile("" : "+v"(mwA)); WGBAR();
        KDMA(1, (j + 2) * KVBLK); VDMA(0, (j + 1) * KVBLK);
        SBAR(); qkt(pA0, pA1, ka, qa, 0);
        FIN(pB0, pB1, alB, mwB); SBAR();
        MNEXT(mwB); SBAR();
        pv_d0(o, vb0 + (int)SHM_V, pa0, pa1, pa2, pa3); partialSM(pA0, pA1, m_reg, mnA, alA, FAR(j + 1), bfar, tbq + (DBASE(j + 1) + 197), 0);
        RESC(alA); VMW(0); asm volatile("" : "+v"(mwB)); WGBAR();
    }
    VDMA(1, (NT - 1) * KVBLK);
    SBAR(); qkt(pB0, pB1, ka, qa, (int)SHM_K);
    FIN(pA0, pA1, alA, mwA); SBAR();
    pv_d0(o, vb0, pa0, pa1, pa2, pa3); partialSM(pB0, pB1, m_reg, mnB, alB, FAR(NT - 1), bfar, tbq + (DBASE(NT - 1) + 197), 0);
    RESC(alB); VMW(0); __syncthreads();
    FIN(pB0, pB1, alB, mwB); SBAR();
    pv_d0(o, vb0 + (int)SHM_V, pa0, pa1, pa2, pa3);
    __syncthreads();
#undef MNEXT
#undef FIN
    if (hi == 0) li_l[r32] = l_reg; asm volatile("s_waitcnt lgkmcnt(0)" ::: "memory");
    { LAS unsigned char* osl = lds + wid * 8704;
      int le = lane; asm volatile("" : "+v"(le)); const int r32e = le & 31, hie = le >> 5;
#pragma unroll
      for (int r = 0; r < 16; ++r) { const int orow = crow(r, hie); const float rl = __builtin_amdgcn_rcpf(li_l[orow]);
#pragma unroll
          for (int d0 = 0; d0 < 4; ++d0) *(LAS bf16*)(osl + orow * 272 + (d0 * 32 + r32e) * 2) = (bf16)f2bf(o[d0][r] * rl); }
      asm volatile("s_waitcnt lgkmcnt(0)" ::: "memory");
#pragma unroll
      for (int i = 0; i < 8; ++i) { const int p = le + 64 * i, row = p >> 4, pc = p & 15; *(v4u*)(Ob + blk_off(orow0 + wid * QBLK + row, ocol0 + pc * 8, DM)) = *(const LAS v4u*)(osl + row * 272 + pc * 16); }
      asm volatile("s_waitcnt lgkmcnt(0)" ::: "memory"); }
#undef KDMA
#undef VDMA
#undef VMW
#undef WGBAR
#undef RESC
#undef FAR
#undef DBASE
#undef MLOAD
}
}
__device__ __forceinline__ void ph_attention(Frame& F) {
    const bf16* P1 = (const bf16*)(F.ws + WS_PROJ); bf16* ATT = (bf16*)(F.ws + WS_H); const unsigned* SEL = (const unsigned*)(F.ws + WS_SEL); const float* tb = (const float*)(F.ws + WS_TB);
    LAS float* tbq = (LAS float*)(F.lds + att::OFF_TB);
    for (int pi = F.vcu; pi < 1024; pi += F.G) {
        const int combo = pi >> 4, within = pi & 15, b = combo >> 2, kvh = combo & 3, hq = kvh * 4 + (within >> 2), pr = within & 3;
        for (int half = 0; half < 2; ++half) {
            const int qb = half ? 7 - pr : pr, i0 = qb * 256;
            __syncthreads();
            int t_ = threadIdx.x; asm volatile("" : "+v"(t_));
            const int d_ = t_ - 256; const float tbv = tb[(d_ < 0 ? 0 : (d_ > 127 ? 127 : d_)) * 16 + hq] * (1.0f / att::SCALE);
            const size_t tok0 = (size_t)b * SEQ;
            att::attn_unit(P1, (int)(tok0 + i0), C1_Q + hq * 128, (int)tok0, C1_K + kvh * 128, C1_V + kvh * 128,
                           ATT, (int)(tok0 + i0), hq * 128, 4 * (qb + 1), SEL + (size_t)b * 32 * SEQ * 2 + (size_t)(i0 + F.wave * 32 + (t_ & 31)) * 2, i0, F.lds, tbv);
        }
    }
}
__device__ __forceinline__ void ph_dsa_naive_sel(Frame& F) {
    LAS float* qil = (LAS float*)(F.lds);
    LAS float* wl = (LAS float*)(F.lds + 4096);
    LAS float* ql = (LAS float*)(F.lds + 8192);
    LAS unsigned* sc = (LAS unsigned*)(F.lds + 16384);
    LAS int* idxl = (LAS int*)(F.lds + 24576);
    LAS float* pl = (LAS float*)(F.lds + 25600);
    LAS float* red = (LAS float*)(F.lds + 26624);
    LAS int* cntl = (LAS int*)(F.lds + 26752);
    LAS int* wtot = (LAS int*)(F.lds + 26880);
    LAS float* op = (LAS float*)(F.lds + 28672);
    const bf16* P1 = (const bf16*)(F.ws + WS_PROJ); bf16* ATT = (bf16*)(F.ws + WS_H); const float* tb = (const float*)(F.ws + WS_TB);
    const int tid = F.tid, lane = F.lane, wave = F.wave;
    for (int unit = F.vcu; unit < MTOK; unit += F.G) {
        const int b = unit >> 11, t = unit & 2047; const bf16* P = P1 + (size_t)unit * O_INP;
        for (int i = tid; i < 1024; i += NTHR) qil[i] = bf2f(P[C1_QI + i]);
        if (tid < 16) wl[tid] = bf2f(P[C1_WI + tid]) * 0.03125f;
        for (int i = tid; i < 2048; i += NTHR) ql[i] = bf2f(P[C1_Q + i]);
        __syncthreads();
        bool sel[4];
        { const unsigned* SELr = (const unsigned*)(F.ws + WS_SEL) + (size_t)unit * 64;
#pragma unroll
          for (int j = 0; j < 4; ++j) { const int s = tid + 512 * j; sel[j] = (SELr[s >> 5] >> (s & 31)) & 1u; } }
        int pre[4];
#pragma unroll
        for (int j = 0; j < 4; ++j) { const unsigned long long bal = __ballot(sel[j]); pre[j] = __popcll(bal & ((1ull << lane) - 1ull)); if (lane == 0) wtot[j * 8 + wave] = __popcll(bal); }
        __syncthreads();
        int nsel = 0;
        { int run = 0; int base[4];
#pragma unroll
          for (int j = 0; j < 4; ++j) {
#pragma unroll
              for (int w = 0; w < 8; ++w) { if (w == wave) base[j] = run; run += wtot[j * 8 + w]; } }
          nsel = run;
#pragma unroll
          for (int j = 0; j < 4; ++j) if (sel[j]) idxl[base[j] + pre[j]] = tid + 512 * j; }
        __syncthreads();
        for (int hq = 0; hq < 16; ++hq) { const int kvh = hq >> 2;
            float logit = -INFINITY;
            if (tid < nsel) { const int s = idxl[tid]; const v4u* kp = (const v4u*)(P1 + (size_t)(b * SEQ + s) * O_INP + C1_K + kvh * 128); float d = 0.f;
#pragma unroll
                for (int q = 0; q < 16; ++q) { const v4u w = kp[q]; const f32x4 a0 = *(const LAS f32x4*)(ql + hq * 128 + 8 * q), a1 = *(const LAS f32x4*)(ql + hq * 128 + 8 * q + 4);
                    d += a0.x * __uint_as_float(w.x << 16) + a0.y * __uint_as_float(w.x & 0xffff0000u) + a0.z * __uint_as_float(w.y << 16) + a0.w * __uint_as_float(w.y & 0xffff0000u)
                       + a1.x * __uint_as_float(w.z << 16) + a1.y * __uint_as_float(w.z & 0xffff0000u) + a1.z * __uint_as_float(w.w << 16) + a1.w * __uint_as_float(w.w & 0xffff0000u); }
                const int dist = t - s; logit = d * 0.08838834764831845f + tb[(dist < 127 ? dist : 127) * 16 + hq]; }
            float mx = wave_max(logit); if (lane == 0) red[wave] = mx;
            __syncthreads();
            mx = fmaxf(fmaxf(fmaxf(red[0], red[1]), fmaxf(red[2], red[3])), fmaxf(fmaxf(red[4], red[5]), fmaxf(red[6], red[7])));
            const float p = (tid < nsel) ? __expf(logit - mx) : 0.f;
            if (tid < 256) pl[tid] = p;
            float sm = wave_sum(p); if (lane == 0) red[8 + wave] = sm;
            __syncthreads();
            sm = ((red[8] + red[9]) + (red[10] + red[11])) + ((red[12] + red[13]) + (red[14] + red[15]));
            { const int d = tid & 127, part = tid >> 7; float a = 0.f; const int j1 = (part * 64 + 64) < nsel ? (part * 64 + 64) : nsel;
              for (int j = part * 64; j < j1; ++j) a += pl[j] * bf2f(P1[(size_t)(b * SEQ + idxl[j]) * O_INP + C1_V + kvh * 128 + d]);
              op[part * 128 + d] = a; }
            __syncthreads();
            if (tid < 128) ATT[(size_t)unit * DM + hq * 128 + tid] = (bf16)f2bf(((op[tid] + op[128 + tid]) + (op[256 + tid] + op[384 + tid])) / sm);
            __syncthreads();
        }
    }
}


constexpr int N_PHASES = 15;
#ifndef PROBE_DUP
#define PROBE_DUP -1
#endif
#ifndef MIXER0
#define MIXER0 1
#endif
#ifndef DSA_ATT
#define DSA_ATT 1
#endif

__global__ void __launch_bounds__(NTHR, 2) mega_fwd(Args args) {
    extern __shared__ __attribute__((aligned(16))) unsigned char lds_raw[];
    Frame F;
    F.lds = (LAS unsigned char*)lds_raw;
    F.tid = threadIdx.x; F.lane = F.tid & 63; F.wave = __builtin_amdgcn_readfirstlane(F.tid >> 6);
    F.G = gridDim.x; { const int bx = blockIdx.x; F.vcu = (F.G % 8 == 0) ? (bx % 8) * (F.G / 8) + bx / 8 : bx; }
    F.ws = args.ws;
    unsigned char* ws = args.ws;
    volatile LAS unsigned* MISC = (volatile LAS unsigned*)(F.lds + MISC_OFF);
    if (F.tid < 32) ((LAS unsigned*)(F.lds + MISC_OFF))[F.tid] = 0u;
    __syncthreads();
    const int lo = args.ph_lo, hi = args.ph_hi;
    const bool multi = (hi - lo) > 1;
    XcdBarrier bar; bar.bar = (unsigned*)(ws + WS_CTL) + CW_BAR; bar.x = 0; bar.st = nullptr;
    if (multi) bar = xcd_barrier_post((unsigned*)(ws + WS_CTL) + CW_BAR, MISC + 8);
#define IN(k) (lo <= (k) && (k) < hi)
#define SEAM(k) do { if (IN(k) && IN((k) + 1)) xcd_barrier(bar); { int t_ = threadIdx.x; asm volatile("" : "+v"(t_)); F.tid = t_; F.lane = t_ & 63; } } while (0)
    float* const rss = (float*)(ws + WS_RSS); float* const rstd = (float*)(ws + WS_RSTD);
#define RSTD_PHASE(k, site) do { if (IN(k)) { int t_ = threadIdx.x; asm volatile("" : "+v"(t_));   const int gt = F.vcu * NTHR + t_; if (gt < MTOK) { const f32x4* p = (const f32x4*)(rss + (site) * RSW + (size_t)gt * 32); float s = 0.f; \
            _Pragma("unroll") for (int q = 0; q < 8; ++q) { const f32x4 v = p[q]; s += (v.x + v.y) + (v.z + v.w); } rstd[(site) * MTOK + gt] = rstd_of(s); } } SEAM(k); } while (0)
#define GEMM_PHASE_(k, ABLK, EpiT, Aptr, Wptr, N_, K_, ...) do { if (IN(k)) { pg8::Gemm g{(const bf16*)(Aptr), (const bf16*)(Wptr), MTOK, (N_), (K_)}; pg8::StaticOrder S; S.init(MTOK, (N_), F.G, (int)blockIdx.x); \
            EpiT E{__VA_ARGS__}; pg8::gemm_phase<EpiT, pg8::StaticOrder, true, true, ABLK, true>(F.lds, g, S, E); } SEAM(k); } while (0)
#define GEMM_PHASE(k, ...) GEMM_PHASE_(k, false, __VA_ARGS__)
#define GEMM_PHASE_B(k, ...) GEMM_PHASE_(k, true, __VA_ARGS__)
    if (IN(0)) p0_prologue(F, args);
    SEAM(0);
    GEMM_PHASE_B(1, EpiBf16Rs, ws + WS_XB, ws + WS_WIN0, E_IN, DM, (bf16*)(ws + WS_PROJ), E_IN, rstd);
    if (IN(2)) ph_mixer0(F, args);
    SEAM(2);
    GEMM_PHASE_B(3, EpiResMid, ws + WS_H, ws + WS_WOUT0, DM, DM, (const void*)(ws + WS_XB), (void*)(ws + WS_XB), rss + RSW, DM);
    GEMM_PHASE_B(4, EpiGuFused, ws + WS_XB, ws + WS_WGU0, GUW, DM, (bf16*)(ws + WS_ACTF), rss + RSW, args.in[17], args.in[18], (float*)(ws + WS_SIDEG), (float*)(ws + WS_SIDEU), F.lds + 131072);
    if (IN(5)) ph_ffn_fixup(F, (bf16*)(ws + WS_ACTF), (const float*)(ws + WS_SIDEG), (const float*)(ws + WS_SIDEU), args.in[17], args.in[18]);
    SEAM(5);
    GEMM_PHASE_B(6, EpiResMid, ws + WS_ACTF, ws + WS_WDN0, DM, DFF, (const void*)(ws + WS_XB), (void*)(ws + WS_XB), rss + 2 * RSW, DM);
    if (IN(7)) { pg8::Gemm g{(const bf16*)(ws + WS_XB), (const bf16*)(ws + WS_WIN1), MTOK, O_INP, DM}; pg8::StaticOrder S; S.init(MTOK, O_INP, F.G, (int)blockIdx.x);
        EpiBf16RsP E{(bf16*)(ws + WS_PROJ), O_INP, rss + 2 * RSW, F.lds}; pg8::gemm_phase<EpiBf16RsP, pg8::StaticOrder, true, true, true, true>(F.lds, g, S, E);
        drain_conv_queue(F, args, 2112, L1_I0 + L1_I1, L1_ITEMS); }
    SEAM(7);
    if (IN(8)) ph_indexer(F);
    SEAM(8);
    if (IN(9)) ph_attention(F);
    SEAM(9);
    GEMM_PHASE_B(10, EpiResMid, ws + WS_H, ws + WS_WOUT1, DM, DM, (const void*)(ws + WS_XB), (void*)(ws + WS_XB), rss + 3 * RSW, DM);
    GEMM_PHASE_B(11, EpiGuFused, ws + WS_XB, ws + WS_WGU1, GUW, DM, (bf16*)(ws + WS_ACTF), rss + 3 * RSW, args.in[17] + 3 * DFF, args.in[18] + DFF, (float*)(ws + WS_SIDEG), (float*)(ws + WS_SIDEU), F.lds + 131072);
    if (IN(12)) ph_ffn_fixup(F, (bf16*)(ws + WS_ACTF), (const float*)(ws + WS_SIDEG), (const float*)(ws + WS_SIDEU), args.in[17] + 3 * DFF, args.in[18] + DFF);
    SEAM(12);
    GEMM_PHASE_B(13, EpiResMid, ws + WS_ACTF, ws + WS_WDN1, DM, DFF, (const void*)(ws + WS_XB), (void*)(ws + WS_XB), rss + 4 * RSW, DM);
    if (IN(14)) { const int ln = (int)__builtin_amdgcn_mbcnt_hi(~0u, __builtin_amdgcn_mbcnt_lo(~0u, 0u));
        const int gw = F.vcu * NWAVES + F.wave, NGW = F.G * NWAVES; const bf16* xb_ = (const bf16*)(ws + WS_XB);
        for (int rb = gw; rb < MTOK / 16; rb += NGW) { const int row = rb * 16 + (ln >> 2); float rs;
            { const f32x4* p = (const f32x4*)(rss + 4 * RSW + (size_t)row * 32) + 2 * (ln & 3); const f32x4 a = p[0], b = p[1];
              float s = ((a.x + a.y) + (a.z + a.w)) + ((b.x + b.y) + (b.z + b.w)); s += __shfl_xor(s, 1); s += __shfl_xor(s, 2); rs = rstd_of(s); }
            const bf16* ib = xb_ + (size_t)rb * (DM / 32) * 512 + ln * 8; float* orow = args.out + (size_t)row * DM + (ln & 3) * 8; const float* gp = args.in[20] + (ln & 3) * 8;
#pragma unroll 8
            for (int cb = 0; cb < DM / 32; ++cb) { const v4u w = *(const v4u*)(ib + cb * 512); const f32x4 ga = *(const f32x4*)(gp + cb * 32), gb = *(const f32x4*)(gp + cb * 32 + 4);
                *(f32x4*)(orow + cb * 32) = (f32x4){__uint_as_float(w.x << 16), __uint_as_float(w.x & 0xffff0000u), __uint_as_float(w.y << 16), __uint_as_float(w.y & 0xffff0000u)} * rs * ga;
                *(f32x4*)(orow + cb * 32 + 4) = (f32x4){__uint_as_float(w.z << 16), __uint_as_float(w.z & 0xffff0000u), __uint_as_float(w.w << 16), __uint_as_float(w.w & 0xffff0000u)} * rs * gb; } } }
#undef IN
#undef SEAM
}

#ifndef ONE_LAUNCH
#define ONE_LAUNCH 0
#endif
extern "C" void kernel_launch(void* const* d_in, const int* in_sizes, int n_in, void* d_out, int out_size, void* d_ws, size_t ws_size, hipStream_t stream) {
    static int grid = 0;
    if (grid == 0) {
        if (n_in != 21 || in_sizes[0] != MTOK * DM || out_size != MTOK * DM || ws_size < WS_END) { fprintf(stderr, "kernel_launch: unexpected shapes (n_in %d in0 %d out %d ws %zu)\n", n_in, n_in > 0 ? in_sizes[0] : -1, out_size, ws_size); grid = -1; return; }
        int dev = 0, cus = 0, per_cu = 0;
        if (hipGetDevice(&dev) != hipSuccess || hipDeviceGetAttribute(&cus, hipDeviceAttributeMultiprocessorCount, dev) != hipSuccess) { grid = -1; return; }
        if (hipFuncSetAttribute((const void*)mega_fwd, hipFuncAttributeMaxDynamicSharedMemorySize, LDS_BYTES) != hipSuccess) { fprintf(stderr, "kernel_launch: hipFuncSetAttribute failed\n"); grid = -1; return; }
        if (hipOccupancyMaxActiveBlocksPerMultiprocessor(&per_cu, (const void*)mega_fwd, NTHR, LDS_BYTES) != hipSuccess || per_cu < 1) { fprintf(stderr, "kernel_launch: occupancy query says %d\n", per_cu); }
        (void)hipGetLastError();
        grid = cus;
    }
    if (grid < 0) return;
    (void)hipMemsetAsync((char*)d_ws + WS_CTL, 0, CTL_ZERO_BYTES, stream);
    Args a{};
    for (int i = 0; i < 21; ++i) a.in[i] = (const float*)d_in[i];
    a.out = (float*)d_out; a.ws = (unsigned char*)d_ws;
#if ONE_LAUNCH
    a.ph_lo = 0; a.ph_hi = N_PHASES;
    hipLaunchKernelGGL(mega_fwd, dim3(grid), dim3(NTHR), LDS_BYTES, stream, a);
#else
    for (int p = 0; p < N_PHASES; ++p) { a.ph_lo = p; a.ph_hi = p + 1; hipLaunchKernelGGL(mega_fwd, dim3(grid), dim3(NTHR), LDS_BYTES, stream, a); }
#endif
}
```

```cpp
#include <hip/hip_runtime.h>
#include <cstdio>
#include <cstdint>
#define ONE_LAUNCH 1
namespace pg8 {
#define PG8_LAS __attribute__((address_space(3)))
typedef unsigned short bf16_t;
typedef short bf16x8 __attribute__((ext_vector_type(8)));
typedef float f32x4 __attribute__((ext_vector_type(4)));
typedef unsigned u32x4 __attribute__((ext_vector_type(4)));
constexpr int BM = 256, BK = 64, HALF = 128, HTB = HALF * BK * 2  , STAGE_BYTES = 8 * HTB, NXCD = 8, WGM = 8;

__host__ __device__ __forceinline__ int lds_byte(int r, int c) { const int st = (r >> 4) * 2 + (c >> 5), rr = r & 15, cc = c & 31, ob = rr * 64 + cc * 2; return st * 1024 + (ob ^ (((ob >> 9) & 1) << 5)); }
__host__ __device__ __forceinline__ void stage_rc(int b, int& R, int& C) { const int st = b / 1024, sb = b % 1024, swz = sb ^ (((sb >> 9) & 1) << 5); R = (st >> 1) * 16 + swz / 64; C = (st & 1) * 32 + (swz % 64) / 2; }
__host__ __device__ __forceinline__ int perm32(int rho) { const int n = rho >> 4, i = rho & 15; return 8 * (i >> 2) + 4 * n + (i & 3); }

struct Unit { int pm, pn; };
struct Gemm { const bf16_t* A; const bf16_t* Bt; int M, N, K; };

struct StaticOrder {
    int nM, nN, nwg, G, c;
    __host__ __device__ void init(int M, int N, int G_, int c_) { nM = M / BM; nN = N / BM; nwg = nM * nN; G = G_; c = c_; }
    __host__ __device__ bool next(int i, Unit& u) const {
        const long L = (long)i * G + c; if (L >= nwg) return false;
        int wgid = (int)L; { const int q = nwg / NXCD, r = nwg % NXCD, xcd = wgid % NXCD, off = wgid / NXCD; wgid = (xcd < r ? xcd * (q + 1) : r * (q + 1) + (xcd - r) * q) + off; }
        const int nig = WGM * nN, gid = wgid / nig, fm = gid * WGM, gsz = (nM - fm) < WGM ? (nM - fm) : WGM;
        u.pm = fm + ((wgid % nig) % gsz); u.pn = (wgid % nig) / gsz; return true;
    }
    __device__ __forceinline__ void a_ready(const Unit&) const {}
    __device__ __forceinline__ void done(const Unit&) const {}
};
__device__ __forceinline__ unsigned cvt_pk_bf16(float lo, float hi) { unsigned r; asm volatile("v_cvt_pk_bf16_f32 %0, %1, %2" : "=v"(r) : "v"(lo), "v"(hi)); return r; }
typedef float f32x2 __attribute__((ext_vector_type(2)));
template <class E_> struct RowsLds { static constexpr bool value = false; };
template <class Epi, class Sched, bool ALIGN_EPI = false, bool SP2 = false, bool A_BLK = false, bool B_BLK = false>
__device__ __forceinline__ void gemm_phase(PG8_LAS unsigned char* lds, const Gemm g, const Sched& S, const Epi& E) {
    const int tid = threadIdx.x, wid = __builtin_amdgcn_readfirstlane(tid >> 6), lane = tid & 63, wr = wid >> 2, wc = wid & 3, fr = lane & 15, fq = lane >> 4;
    const int K = g.K, nt = K / BK;
    unsigned voffA[2], voffB[2];
#pragma unroll
    for (int i = 0; i < 2; ++i) { int R, C; stage_rc(tid * 16 + i * 8192, R, C); const int Rb = Epi::PERM ? ((R & ~31) + perm32(R & 31)) : R;
        voffA[i] = A_BLK ? (unsigned)((((R >> 4) * (K >> 5) + (C >> 5)) * 512 + (R & 15) * 32 + (C & 31)) * 2) : (unsigned)(R * K + C) * 2u;
        voffB[i] = B_BLK ? (unsigned)((((R >> 4) * (K >> 5) + (C >> 5)) * 512 + (R & 15) * 32 + (C & 31)) * 2) : (unsigned)(Rb * K + C) * 2u; }
    const size_t kstep = (size_t)(BK * 2), kstepA = A_BLK ? (size_t)2048 : kstep, kstepB = B_BLK ? (size_t)2048 : kstep;
    const size_t hstep = (size_t)HALF * K * 2;
    const size_t tstep = 2 * hstep;
    const unsigned ldsw = (unsigned)wid * 1024u;
    const int aoff = lds_byte(wr * 64 + fr, fq * 8), boff = lds_byte(wc * 32 + fr, fq * 8);
#define PG8_SA(b, h) (((b) * 2 + (h)) * HTB)
#define PG8_SB(b, h) ((4 + (b) * 2 + (h)) * HTB)
#define PG8_STAGE(bufoff, gbase, voff) do { _Pragma("unroll") for (int _i = 0; _i < 2; ++_i) \
        __builtin_amdgcn_global_load_lds((const unsigned*)((const char*)(gbase) + (voff)[_i]), (PG8_LAS unsigned*)(lds + (bufoff) + ldsw + _i * 8192), 16, 0, 0); } while (0)
#define PG8_LDA(dst, b, h) do { _Pragma("unroll") for (int m = 0; m < 4; ++m) _Pragma("unroll") for (int k = 0; k < 2; ++k) dst[m][k] = *(const PG8_LAS bf16x8*)(lds + PG8_SA(b, h) + aoff + m * 2048 + k * 1024); } while (0)
#define PG8_LDB(dst, b, h) do { _Pragma("unroll") for (int n = 0; n < 2; ++n) _Pragma("unroll") for (int k = 0; k < 2; ++k) dst[n][k] = *(const PG8_LAS bf16x8*)(lds + PG8_SB(b, h) + boff + n * 2048 + k * 1024); } while (0)
#define PG8_MMA(ai, bj, At, Bt) do { __builtin_amdgcn_s_setprio(1); _Pragma("unroll") for (int m = 0; m < 4; ++m) _Pragma("unroll") for (int n = 0; n < 2; ++n) _Pragma("unroll") for (int k = 0; k < 2; ++k) \
        acc[ai][bj][m][n] = __builtin_amdgcn_mfma_f32_16x16x32_bf16(Bt[n][k], At[m][k], acc[ai][bj][m][n], 0, 0, 0); __builtin_amdgcn_s_setprio(0); } while (0)
#define PG8_WAIT_V(n) asm volatile("s_waitcnt vmcnt(" #n ")" ::: "memory")
#define PG8_WAIT_L(n) asm volatile("s_waitcnt lgkmcnt(" #n ")" ::: "memory")
#define PG8_BAR __builtin_amdgcn_s_barrier()
#define PG8_SCHED __builtin_amdgcn_sched_barrier(0)
    Unit cur, nxt; int ui = 0; int prev_pm = -1;
    if (!S.next(0, cur)) return;
    f32x4 acc[2][2][4][2];
#pragma unroll
    for (int a = 0; a < 2; ++a)
#pragma unroll
        for (int b = 0; b < 2; ++b)
#pragma unroll
            for (int m = 0; m < 4; ++m)
#pragma unroll
                for (int n = 0; n < 2; ++n) acc[a][b][m][n] = (f32x4){0.f, 0.f, 0.f, 0.f};
    bf16x8 At[4][2], B0[2][2], B1[2][2];
    const char* cA = (const char*)g.A + (size_t)cur.pm * tstep; const char* cB = (const char*)g.Bt + (size_t)cur.pn * tstep;
    S.a_ready(cur);
    if constexpr (SP2) {
        PG8_STAGE(PG8_SB(0, 0), cB, voffB); PG8_STAGE(PG8_SB(0, 1), cB + hstep, voffB); PG8_STAGE(PG8_SA(0, 0), cA, voffA); PG8_STAGE(PG8_SA(0, 1), cA + hstep, voffA);
        if (wr == 1) PG8_BAR;
        PG8_WAIT_V(2); PG8_BAR;
        PG8_STAGE(PG8_SB(1, 0), cB + kstepB, voffB); PG8_STAGE(PG8_SA(1, 0), cA + kstepA, voffA); PG8_STAGE(PG8_SB(1, 1), cB + hstep + kstepB, voffB);
        PG8_WAIT_V(6); PG8_BAR;
    } else {
        PG8_STAGE(PG8_SB(0, 0), cB, voffB); PG8_STAGE(PG8_SA(0, 0), cA, voffA); PG8_STAGE(PG8_SB(0, 1), cB + hstep, voffB); PG8_STAGE(PG8_SA(0, 1), cA + hstep, voffA);
        if (wr == 1) PG8_BAR;
        PG8_WAIT_V(4); PG8_BAR;
        PG8_STAGE(PG8_SB(1, 0), cB + kstepB, voffB); PG8_STAGE(PG8_SA(1, 0), cA + kstepA, voffA); PG8_STAGE(PG8_SB(1, 1), cB + hstep + kstepB, voffB);
        PG8_WAIT_V(6); PG8_BAR;
    }
    for (;;) {
        const bool has_next = S.next(ui + 1, nxt);
        const char* nA = has_next ? (const char*)g.A + (size_t)nxt.pm * tstep : cA; const char* nB = has_next ? (const char*)g.Bt + (size_t)nxt.pn * tstep : cB;
        for (int t = 0; t < nt; t += 2) {
            const bool last = (t == nt - 2);
            const char* a1 = cA + (size_t)(t + 1) * kstepA;
            const char* a2 = last ? nA : cA + (size_t)(t + 2) * kstepA; const char* b2 = last ? nB : cB + (size_t)(t + 2) * kstepB;
            const char* a3 = a2 + kstepA; const char* b3 = b2 + kstepB;
            if (last && has_next) S.a_ready(nxt);
            if constexpr (SP2) {
            PG8_LDB(B0, 0, 0); PG8_LDB(B1, 0, 1); PG8_SCHED; PG8_LDA(At, 0, 0); PG8_STAGE(PG8_SA(1, 1), a1 + hstep, voffA);
            PG8_WAIT_V(8); PG8_WAIT_L(0); PG8_BAR; PG8_MMA(0, 0, At, B0); PG8_MMA(0, 1, At, B1); PG8_BAR; PG8_SCHED;
            PG8_LDA(At, 0, 1); PG8_STAGE(PG8_SB(0, 0), b2, voffB); PG8_STAGE(PG8_SB(0, 1), b2 + hstep, voffB); PG8_STAGE(PG8_SA(0, 0), a2, voffA);
            PG8_WAIT_V(8); PG8_WAIT_L(0); PG8_BAR; PG8_MMA(1, 0, At, B0); PG8_MMA(1, 1, At, B1); PG8_BAR; PG8_SCHED;
            PG8_LDB(B0, 1, 0); PG8_LDB(B1, 1, 1); PG8_SCHED; PG8_LDA(At, 1, 0); PG8_STAGE(PG8_SA(0, 1), a2 + hstep, voffA);
            PG8_WAIT_V(8); PG8_WAIT_L(0); PG8_BAR; PG8_MMA(0, 0, At, B0); PG8_MMA(0, 1, At, B1); PG8_BAR; PG8_SCHED;
            PG8_LDA(At, 1, 1); PG8_STAGE(PG8_SB(1, 0), b3, voffB); PG8_STAGE(PG8_SB(1, 1), b3 + hstep, voffB); PG8_STAGE(PG8_SA(1, 0), a3, voffA);
            PG8_WAIT_V(8); PG8_WAIT_L(0); PG8_BAR; PG8_MMA(1, 0, At, B0); PG8_MMA(1, 1, At, B1); PG8_BAR; PG8_SCHED;
            } else {
            PG8_LDB(B0, 0, 0); PG8_SCHED; PG8_LDA(At, 0, 0); PG8_STAGE(PG8_SA(1, 1), a1 + hstep, voffA);
            PG8_WAIT_L(8); PG8_BAR; PG8_WAIT_L(0); PG8_MMA(0, 0, At, B0); PG8_BAR; PG8_SCHED;
            PG8_LDB(B1, 0, 1); PG8_STAGE(PG8_SB(0, 0), b2, voffB);
            PG8_BAR; PG8_WAIT_L(0); PG8_MMA(0, 1, At, B1); PG8_BAR;
            PG8_LDA(At, 0, 1); PG8_STAGE(PG8_SA(0, 0), a2, voffA);
            PG8_BAR; PG8_WAIT_L(0); PG8_MMA(1, 0, At, B0); PG8_BAR; PG8_SCHED;
            PG8_STAGE(PG8_SB(0, 1), b2 + hstep, voffB);
            PG8_WAIT_V(6); PG8_BAR; PG8_MMA(1, 1, At, B1); PG8_BAR;
            PG8_LDB(B0, 1, 0); PG8_SCHED; PG8_LDA(At, 1, 0); PG8_STAGE(PG8_SA(0, 1), a2 + hstep, voffA);
            PG8_WAIT_L(8); PG8_BAR; PG8_WAIT_L(0); PG8_MMA(0, 0, At, B0); PG8_BAR; PG8_SCHED;
            PG8_LDB(B1, 1, 1); PG8_STAGE(PG8_SB(1, 0), b3, voffB);
            PG8_BAR; PG8_WAIT_L(0); PG8_MMA(0, 1, At, B1); PG8_BAR;
            PG8_LDA(At, 1, 1); PG8_STAGE(PG8_SA(1, 0), a3, voffA);
            PG8_BAR; PG8_WAIT_L(0); PG8_MMA(1, 0, At, B0); PG8_BAR; PG8_SCHED;
            PG8_STAGE(PG8_SB(1, 1), b3 + hstep, voffB);
            PG8_WAIT_V(6); PG8_BAR; PG8_MMA(1, 1, At, B1); PG8_BAR;
            }
        }
        if constexpr (ALIGN_EPI) { if (wr == 0) PG8_BAR; }
        if constexpr (RowsLds<Epi>::value) { static_assert(ALIGN_EPI, "row-scale tile: all eight waves must be in the epilogue together");
            if (cur.pm != prev_pm) { E.load_rows(cur.pm, tid, lds); prev_pm = cur.pm; } }
        if constexpr (!Epi::AFTER_DRAIN) { E(acc, cur, wr, wc, fr, fq); S.done(cur); }
        if (!has_next) break;
#pragma unroll
        for (int a = 0; a < 2; ++a)
#pragma unroll
            for (int b = 0; b < 2; ++b)
#pragma unroll
                for (int m = 0; m < 4; ++m)
#pragma unroll
                    for (int n = 0; n < 2; ++n) acc[a][b][m][n] = (f32x4){0.f, 0.f, 0.f, 0.f};
        cur = nxt; cA = nA; cB = nB; ++ui;
        if constexpr (ALIGN_EPI) { if (wr == 1) PG8_BAR; }
    }
    PG8_WAIT_V(0);
    if constexpr (!ALIGN_EPI) { if (wr == 0) PG8_BAR; }
    PG8_BAR;
    if constexpr (Epi::AFTER_DRAIN) { E.fused(acc, cur, wr, wc, fr, fq, lds, wid, lane); S.done(cur); }
#undef PG8_SA
#undef PG8_SB
#undef PG8_STAGE
#undef PG8_LDA
#undef PG8_LDB
#undef PG8_MMA
#undef PG8_WAIT_V
#undef PG8_WAIT_L
#undef PG8_BAR
#undef PG8_SCHED
}
}
#define LAS __attribute__((address_space(3)))
#define XB_TMO      128
#define XB_XCNT(j)  (256  + 64 * (j))
#define XB_XSUB(j)  (1280 + 64 * (j))
#define XB_XGEN(j)  (2304 + 64 * (j))
#define XB_TOP      3328
#define XB_TOPGEN   3392
#define XCD_BAR_WORDS 3456
#define XB_SPIN_CAP (1u << 18)

__device__ __forceinline__ unsigned xb_ld(unsigned* p)              { return __hip_atomic_load(p, __ATOMIC_RELAXED, __HIP_MEMORY_SCOPE_AGENT); }
__device__ __forceinline__ unsigned xb_add(unsigned* p, unsigned v) { return __hip_atomic_fetch_add(p, v, __ATOMIC_RELAXED, __HIP_MEMORY_SCOPE_AGENT); }
__device__ __forceinline__ unsigned xb_xcc_id() { return (unsigned)__builtin_amdgcn_s_getreg((3 << 11) | 20) & 0xFu; }
#define XB_SPIN(cond, bar) do { unsigned _sp = 0; while (cond) { __builtin_amdgcn_s_sleep(1); \
    if ((++_sp & 255u) == 0u) { if (xb_ld(&(bar)[XB_TMO])) break; if (_sp > XB_SPIN_CAP) { atomicAdd(&(bar)[XB_TMO], 1u); break; } } } } while (0)

struct XcdBarrier {
    unsigned* bar; unsigned x;
    volatile LAS unsigned* st;
};

__device__ __forceinline__ XcdBarrier xcd_barrier_post(unsigned* bar, volatile LAS unsigned* st) {
    XcdBarrier b; b.bar = bar; b.x = xb_xcc_id(); b.st = st;
    if (threadIdx.x == 0) (void)xb_add(&bar[XB_XCNT(b.x)], 1u);
    return b;
}
__device__ __forceinline__ void xcd_barrier_complete(unsigned* bar, unsigned x, unsigned& nloc, unsigned& nx) {
    const unsigned G = gridDim.x * gridDim.y * gridDim.z;
    unsigned sum, cnt, mine, sp = 0u;
    for (;;) {
        sum = 0u; cnt = 0u; mine = 0u;
#pragma unroll
        for (unsigned j = 0; j < 16; ++j) { const unsigned c = xb_ld(&bar[XB_XCNT(j)]); sum += c; cnt += (c > 0u) ? 1u : 0u; mine = (j == x) ? c : mine; }
        if (sum == G) break;
        __builtin_amdgcn_s_sleep(1);
        if ((++sp & 255u) == 0u) { if (xb_ld(&bar[XB_TMO])) break; if (sp > XB_SPIN_CAP) { atomicAdd(&bar[XB_TMO], 1u); break; } }
    }
    nloc = mine > 0u ? mine : 1u; nx = cnt > 0u ? cnt : 1u;
}

__device__ __forceinline__ void xcd_barrier(const XcdBarrier& b) {
    asm volatile("s_waitcnt vmcnt(0)" ::: "memory");
    __syncthreads();
    if (threadIdx.x == 0) {
        unsigned* bar = b.bar;
        __builtin_amdgcn_s_waitcnt(0);
        unsigned nloc = b.st[0], nx = b.st[1];
        if (nloc == 0u) { xcd_barrier_complete(bar, b.x, nloc, nx); b.st[0] = nloc; b.st[1] = nx; }
        const unsigned old = xb_add(&bar[XB_XSUB(b.x)], 1u);
        const unsigned gen = old / nloc;
        if (old + 1u == (gen + 1u) * nloc) {
            __builtin_amdgcn_fence(__ATOMIC_RELEASE, "agent");
            asm volatile("s_waitcnt vmcnt(0)" ::: "memory");
            const unsigned og = xb_add(&bar[XB_TOP], 1u);
            const unsigned tg = og / nx;
            if (og + 1u == (tg + 1u) * nx) xb_add(&bar[XB_TOPGEN], 1u);
            else XB_SPIN(xb_ld(&bar[XB_TOPGEN]) == tg, bar);
            __builtin_amdgcn_fence(__ATOMIC_ACQUIRE, "agent");
            xb_add(&bar[XB_XGEN(b.x)], 1u);
            asm volatile("s_waitcnt vmcnt(0)" ::: "memory");
        } else {
            XB_SPIN(xb_ld(&bar[XB_XGEN(b.x)]) == gen, bar);
            __builtin_amdgcn_fence(__ATOMIC_ACQUIRE, "agent");
            asm volatile("s_waitcnt vmcnt(0)" ::: "memory");
        }
    }
    __syncthreads();
}
#define GAS __attribute__((address_space(1)))
typedef unsigned short bf16;
typedef unsigned v4u __attribute__((ext_vector_type(4)));
typedef unsigned v2u __attribute__((ext_vector_type(2)));
typedef float f32x4 __attribute__((ext_vector_type(4)));
typedef float f32x2 __attribute__((ext_vector_type(2)));

constexpr int NB = 16, SEQ = 2048, DM = 2048, MTOK = NB * SEQ;
constexpr int E_IN = 6144, O_IN = 4176, O_INP = 4352, DFF = 5632, GUW = 2 * DFF;
constexpr int NWAVES = 8, NTHR = 512;
constexpr float EPS = 1e-6f;
constexpr int C0_Q = 0, C0_K = 1024, C0_V = 2048, C0_G = 3072, C0_XR = 4096, C0_YR = 5120;
constexpr int C1_Q = 0, C1_K = 2048, C1_V = 2560, C1_QI = 3072, C1_KI = 4096, C1_WI = 4160;

constexpr size_t MiB = 1u << 20;
constexpr size_t WS_CTL = 0, CTL_ZERO_BYTES = 32 * 1024;
constexpr size_t WS_ROT = 1 * MiB;
constexpr size_t WS_GT = 2 * MiB;
constexpr size_t WS_TB = 2 * MiB + 512 * 1024;
constexpr size_t WS_SP = WS_TB + 8192;
constexpr size_t WS_WIN0 = 4 * MiB, WS_WOUT0 = 28 * MiB, WS_WGU0 = 36 * MiB, WS_WDN0 = 80 * MiB;
constexpr size_t WS_WIN1 = 102 * MiB, WS_WOUT1 = 119 * MiB, WS_WGU1 = 127 * MiB, WS_WDN1 = 171 * MiB;
constexpr size_t WS_H = 194 * MiB;
constexpr size_t WS_PROJ = 322 * MiB;
constexpr size_t WS_SEL = 594 * MiB;
constexpr size_t WS_ACTF = WS_PROJ;
constexpr size_t WS_XB = 706 * MiB;
constexpr size_t WS_SIDEG = 834 * MiB;
constexpr size_t WS_SIDEU = 878 * MiB;
constexpr size_t WS_RSS = 900 * MiB;
constexpr size_t RSW = (size_t)32768 * 32;
constexpr size_t WS_RSTD = 3 * MiB;
constexpr size_t WS_ACT = 706 * MiB;
constexpr size_t WS_END = 920 * MiB;
constexpr int CW_BAR = 4096;

#ifndef FOLD
#define FOLD 1
#endif
#ifndef DEFER_L1
#define DEFER_L1 1
#endif
constexpr int LDS_BYTES = 147456;
constexpr int MISC_OFF = LDS_BYTES - 128;

__device__ __forceinline__ float bf2f(bf16 b) { return __uint_as_float(((unsigned)b) << 16); }
__device__ __forceinline__ unsigned f2bf(float f) { unsigned u = __float_as_uint(f); return (u + 0x7fffu + ((u >> 16) & 1u)) >> 16; }
__device__ __forceinline__ unsigned pk2(float lo, float hi) { return f2bf(lo) | (f2bf(hi) << 16); }
#ifndef WDROP
#define WDROP 2
#endif
__device__ __forceinline__ unsigned f2bfw(float x) { const unsigned u = __float_as_uint(x); return WDROP ? (((u + (0x8000u << WDROP)) >> 16) & (0xffffu << WDROP)) & 0xffffu : f2bf(x); }
__device__ __forceinline__ unsigned pk2w(float lo, float hi) { return f2bfw(lo) | (f2bfw(hi) << 16); }
__device__ __forceinline__ float wave_sum(float v) {
#pragma unroll
    for (int o = 1; o < 64; o <<= 1) v += __shfl_xor(v, o);
    return v;
}
__device__ __forceinline__ float wave_max(float v) {
#pragma unroll
    for (int o = 1; o < 64; o <<= 1) v = fmaxf(v, __shfl_xor(v, o));
    return v;
}
__device__ __forceinline__ int wave_sum_i(int v) {
#pragma unroll
    for (int o = 1; o < 64; o <<= 1) v += __shfl_xor(v, o);
    return v;
}
__device__ __forceinline__ float sigmoidf_(float x) { return __builtin_amdgcn_rcpf(1.0f + __builtin_amdgcn_exp2f(-1.4426950408889634f * x)); }
__device__ __forceinline__ float siluf_(float x) { return x * __builtin_amdgcn_rcpf(1.0f + __builtin_amdgcn_exp2f(-1.4426950408889634f * x)); }
__device__ __forceinline__ float gelu_tanh(float y) { const float u = 0.7978845608028654f * (y + 0.044715f * y * y * y); return 0.5f * y * (1.0f + tanhf(u)); }

#ifndef USE_NT
#define USE_NT 0
#endif
#if USE_NT
#define NT_STORE(p, v) __builtin_nontemporal_store((v), (p))
#else
#define NT_STORE(p, v) (*(p) = (v))
#endif
struct EpiBf16P {
    static constexpr bool PERM = true, AFTER_DRAIN = false;
    bf16* O; int ldc;
    __device__ __forceinline__ void operator()(const pg8::f32x4 (&acc)[2][2][4][2], const pg8::Unit& u, int wr, int wc, int fr, int fq) const {
        const int row0 = u.pm * 256 + wr * 64 + fr, col0 = u.pn * 256 + wc * 32 + 8 * fq;
#pragma unroll
        for (int ai = 0; ai < 2; ++ai)
#pragma unroll
            for (int m = 0; m < 4; ++m) { bf16* rowp = O + (size_t)(row0 + ai * 128 + m * 16) * ldc + col0;
#pragma unroll
                for (int bj = 0; bj < 2; ++bj) { const pg8::f32x4 v0 = acc[ai][bj][m][0], v1 = acc[ai][bj][m][1];
                    pg8::u32x4 w; w.x = pg8::cvt_pk_bf16(v0[0], v0[1]); w.y = pg8::cvt_pk_bf16(v0[2], v0[3]); w.z = pg8::cvt_pk_bf16(v1[0], v1[1]); w.w = pg8::cvt_pk_bf16(v1[2], v1[3]);
                    NT_STORE((pg8::u32x4*)(rowp + bj * 128), w); } }
    }
};
struct EpiResF32 {
    static constexpr bool PERM = false, AFTER_DRAIN = false;
    const float* base; float* out; int ldc;
    __device__ __forceinline__ void operator()(const pg8::f32x4 (&acc)[2][2][4][2], const pg8::Unit& u, int wr, int wc, int fr, int fq) const {
        const int row0 = u.pm * 256 + wr * 64 + fr, col0 = u.pn * 256 + wc * 32 + 4 * fq;
#pragma unroll
        for (int ai = 0; ai < 2; ++ai)
#pragma unroll
            for (int m = 0; m < 4; ++m) { const size_t off = (size_t)(row0 + ai * 128 + m * 16) * ldc + col0;
#pragma unroll
                for (int bj = 0; bj < 2; ++bj)
#pragma unroll
                    for (int n = 0; n < 2; ++n) { const size_t i = off + bj * 128 + n * 16; const pg8::f32x4 b = *(const pg8::f32x4*)(base + i); *(pg8::f32x4*)(out + i) = b + acc[ai][bj][m][n]; } }
    }
};

__device__ __forceinline__ size_t blk_off(int R, int C, int ld) { return ((size_t)(R >> 4) * (ld >> 5) + (C >> 5)) * 512 + (R & 15) * 32 + (C & 31); }
__device__ __forceinline__ float rstd_of(float ss) { return __builtin_amdgcn_rsqf(ss * (1.0f / DM) + EPS); }
__device__ __forceinline__ float rstd_row(const float* rssp, int row, int fq) {
    const f32x4* p = (const f32x4*)(rssp + (size_t)row * 32) + 2 * fq; const f32x4 a = p[0], b = p[1];
    float s = ((a.x + a.y) + (a.z + a.w)) + ((b.x + b.y) + (b.z + b.w)); s += __shfl_xor(s, 16); s += __shfl_xor(s, 32); return rstd_of(s);
}
__device__ __forceinline__ void rstd_rows8(const float* rssp, int row0, int fq, float (&rs)[8]) {
#pragma unroll
    for (int h = 0; h < 2; ++h) { f32x4 pa[4], pb[4];
#pragma unroll
        for (int q = 0; q < 4; ++q) { const f32x4* p = (const f32x4*)(rssp + (size_t)(row0 + h * 128 + q * 16) * 32) + 2 * fq; pa[q] = p[0]; pb[q] = p[1]; }
        asm volatile("" ::: "memory");
#pragma unroll
        for (int q = 0; q < 4; ++q) { float s = ((pa[q].x + pa[q].y) + (pa[q].z + pa[q].w)) + ((pb[q].x + pb[q].y) + (pb[q].z + pb[q].w)); s += __shfl_xor(s, 16); s += __shfl_xor(s, 32); rs[h * 4 + q] = rstd_of(s); } }
}
constexpr int ROWTILE_OFF = 131072 + 8192;
struct RowTile {
    static __device__ __forceinline__ void load(const float* part, int pm, int tid, LAS unsigned char* lds) {
        const int row = tid >> 1, half = tid & 1; const f32x4* p = (const f32x4*)(part + (size_t)(pm * 256 + row) * 32 + half * 16);
        const f32x4 a = p[0], b = p[1], c = p[2], d = p[3];
        float s = (((a.x + a.y) + (a.z + a.w)) + ((b.x + b.y) + (b.z + b.w))) + (((c.x + c.y) + (c.z + c.w)) + ((d.x + d.y) + (d.z + d.w)));
        s += __shfl_xor(s, 1);
        if (half == 0) ((LAS float*)(lds + ROWTILE_OFF))[row] = rstd_of(s);
        asm volatile("s_waitcnt lgkmcnt(0)" ::: "memory"); __builtin_amdgcn_s_barrier(); asm volatile("" ::: "memory");
    }
};
template <bool PART>
struct EpiBf16RsT {
    static constexpr bool PERM = true, AFTER_DRAIN = false;
    bf16* O; int ldc; const float* rss; LAS unsigned char* lds;
    __device__ __forceinline__ void load_rows(int pm, int tid, LAS unsigned char* l) const { RowTile::load(rss, pm, tid, l); }
    __device__ __forceinline__ void operator()(const pg8::f32x4 (&acc)[2][2][4][2], const pg8::Unit& u, int wr, int wc, int fr, int fq) const {
        const int row0 = u.pm * 256 + wr * 64 + fr;
        const size_t rbs = (size_t)(ldc >> 5) * 512, lane_blk = ((size_t)(u.pm * 16 + wr * 4) * (ldc >> 5) + u.pn * 8 + wc) * 512 + fr * 32 + 8 * fq;
        float rsv[8];
#pragma unroll
        for (int q = 0; q < 8; ++q) rsv[q] = PART ? ((const LAS float*)(lds + ROWTILE_OFF))[wr * 64 + fr + (q >> 2) * 128 + (q & 3) * 16] : rss[row0 + (q >> 2) * 128 + (q & 3) * 16];
        asm volatile("" ::: "memory");
#pragma unroll
        for (int ai = 0; ai < 2; ++ai)
#pragma unroll
            for (int m = 0; m < 4; ++m) { const float rs = rsv[ai * 4 + m]; bf16* rowp = O + lane_blk + (size_t)(ai * 8 + m) * rbs;
#pragma unroll
                for (int bj = 0; bj < 2; ++bj) { const pg8::f32x4 v0 = acc[ai][bj][m][0] * rs, v1 = acc[ai][bj][m][1] * rs;
                    pg8::u32x4 w; w.x = pg8::cvt_pk_bf16(v0[0], v0[1]); w.y = pg8::cvt_pk_bf16(v0[2], v0[3]); w.z = pg8::cvt_pk_bf16(v1[0], v1[1]); w.w = pg8::cvt_pk_bf16(v1[2], v1[3]);
                    __builtin_nontemporal_store(w, (pg8::u32x4*)(rowp + bj * 2048)); } }
    }
};
typedef EpiBf16RsT<false> EpiBf16Rs; typedef EpiBf16RsT<true> EpiBf16RsP;
namespace pg8 { template <> struct RowsLds<EpiBf16RsP> { static constexpr bool value = true; }; }
struct EpiBf16RsLocal {
    static constexpr bool PERM = true, AFTER_DRAIN = false;
    bf16* O; int ldc; const float* rss;
    __device__ __forceinline__ void operator()(const pg8::f32x4 (&acc)[2][2][4][2], const pg8::Unit& u, int wr, int wc, int fr, int fq) const {
        const int row0 = u.pm * 256 + wr * 64 + fr, col0 = wc * 32 + 8 * fq; bf16* Ow = O + (size_t)blockIdx.x * 65536;
#pragma unroll
        for (int ai = 0; ai < 2; ++ai)
#pragma unroll
            for (int m = 0; m < 4; ++m) { const int row = row0 + ai * 128 + m * 16; const float rs = rstd_row(rss, row, fq); bf16* rowp = Ow + (size_t)(row & 255) * 256 + col0;
#pragma unroll
                for (int bj = 0; bj < 2; ++bj) { const pg8::f32x4 v0 = acc[ai][bj][m][0] * rs, v1 = acc[ai][bj][m][1] * rs;
                    pg8::u32x4 w; w.x = pg8::cvt_pk_bf16(v0[0], v0[1]); w.y = pg8::cvt_pk_bf16(v0[2], v0[3]); w.z = pg8::cvt_pk_bf16(v1[0], v1[1]); w.w = pg8::cvt_pk_bf16(v1[2], v1[3]);
                    *(pg8::u32x4*)(rowp + bj * 128) = w; } }
    }
};
struct EpiStoreOnly {
    static constexpr bool PERM = true, AFTER_DRAIN = false;
    bf16* O; int ldc;
    __device__ __forceinline__ void operator()(const pg8::f32x4 (&acc)[2][2][4][2], const pg8::Unit& u, int wr, int wc, int fr, int fq) const {
        const int row0 = wr * 64 + fr, col0 = wc * 32 + 8 * fq; bf16* Ow = O + (size_t)blockIdx.x * 65536;
#pragma unroll
        for (int ai = 0; ai < 2; ++ai)
#pragma unroll
            for (int m = 0; m < 4; ++m) { bf16* rowp = Ow + (size_t)(row0 + ai * 128 + m * 16) * 256 + col0;
#pragma unroll
                for (int bj = 0; bj < 2; ++bj) { const pg8::f32x4 v0 = acc[ai][bj][m][0] * 1.0009765625f, v1 = acc[ai][bj][m][1] * 1.0009765625f;
                    pg8::u32x4 w; w.x = pg8::cvt_pk_bf16(v0[0], v0[1]); w.y = pg8::cvt_pk_bf16(v0[2], v0[3]); w.z = pg8::cvt_pk_bf16(v1[0], v1[1]); w.w = pg8::cvt_pk_bf16(v1[2], v1[3]);
                    *(pg8::u32x4*)(rowp + bj * 128) = w; } }
    }
};
struct EpiValuOnly {
    static constexpr bool PERM = true, AFTER_DRAIN = false;
    bf16* O; int ldc; const float* rss;
    __device__ __forceinline__ void operator()(const pg8::f32x4 (&acc)[2][2][4][2], const pg8::Unit& u, int wr, int wc, int fr, int fq) const {
        const int row0 = u.pm * 256 + wr * 64 + fr; float rsv[8];
#pragma unroll
        for (int q = 0; q < 8; ++q) rsv[q] = rss[row0 + (q >> 2) * 128 + (q & 3) * 16];
        pg8::u32x4 s = {0u, 0u, 0u, 0u};
#pragma unroll
        for (int ai = 0; ai < 2; ++ai)
#pragma unroll
            for (int m = 0; m < 4; ++m) { const float rs = rsv[ai * 4 + m];
#pragma unroll
                for (int bj = 0; bj < 2; ++bj) { const pg8::f32x4 v0 = acc[ai][bj][m][0] * rs, v1 = acc[ai][bj][m][1] * rs;
                    s.x ^= pg8::cvt_pk_bf16(v0[0], v0[1]); s.y ^= pg8::cvt_pk_bf16(v0[2], v0[3]); s.z ^= pg8::cvt_pk_bf16(v1[0], v1[1]); s.w ^= pg8::cvt_pk_bf16(v1[2], v1[3]); } }
        *(pg8::u32x4*)(O + (size_t)blockIdx.x * 65536 + threadIdx.x * 8) = s;
    }
};
struct SameOrder {
    int n;
    __device__ bool next(int i, pg8::Unit& u) const { if (i >= n) return false; u.pm = 0; u.pn = 0; return true; }
    __device__ __forceinline__ void a_ready(const pg8::Unit&) const {}
    __device__ __forceinline__ void done(const pg8::Unit&) const {}
};
struct EpiNone {
    static constexpr bool PERM = true, AFTER_DRAIN = false;
    float* O; int never;
    __device__ __forceinline__ void operator()(const pg8::f32x4 (&acc)[2][2][4][2], const pg8::Unit& u, int wr, int wc, int fr, int fq) const {
        pg8::f32x4 s = {0.f, 0.f, 0.f, 0.f};
#pragma unroll
        for (int ai = 0; ai < 2; ++ai)
#pragma unroll
            for (int m = 0; m < 4; ++m)
#pragma unroll
                for (int bj = 0; bj < 2; ++bj)
#pragma unroll
                    for (int n = 0; n < 2; ++n) s += acc[ai][bj][m][n];
        if (never < 0) *(pg8::f32x4*)(O + threadIdx.x * 4) = s;
    }
};
template <bool BASE_F32, bool OUT_F32>
struct EpiResNorm {
    static constexpr bool PERM = true, AFTER_DRAIN = false;
    const void* base; void* out; float* rssn; int ldc;
    __device__ __forceinline__ void operator()(const pg8::f32x4 (&acc)[2][2][4][2], const pg8::Unit& u, int wr, int wc, int fr, int fq) const {
        const int row0 = u.pm * 256 + wr * 64 + fr, col0 = u.pn * 256 + wc * 32 + 8 * fq;
        const size_t rbs = (size_t)(ldc >> 5) * 512, lane_blk = ((size_t)(u.pm * 16 + wr * 4) * (ldc >> 5) + u.pn * 8 + wc) * 512 + fr * 32 + 8 * fq;
        pg8::u32x4 bw[2][4][2];
        if (!BASE_F32) {
#pragma unroll
            for (int ai = 0; ai < 2; ++ai)
#pragma unroll
                for (int m = 0; m < 4; ++m)
#pragma unroll
                    for (int bj = 0; bj < 2; ++bj) bw[ai][m][bj] = *(const pg8::u32x4*)((const bf16*)base + lane_blk + (size_t)(ai * 8 + m) * rbs + bj * 2048);
            asm volatile("" ::: "memory");
        }
#pragma unroll
        for (int ai = 0; ai < 2; ++ai) {
            pg8::f32x4 bf[4][2][2];
            if (BASE_F32) {
#pragma unroll
                for (int m = 0; m < 4; ++m)
#pragma unroll
                    for (int bj = 0; bj < 2; ++bj) { const float* p = (const float*)base + (size_t)(row0 + ai * 128 + m * 16) * ldc + col0 + bj * 128; bf[m][bj][0] = *(const pg8::f32x4*)p; bf[m][bj][1] = *(const pg8::f32x4*)(p + 4); }
                asm volatile("" ::: "memory");
            }
#pragma unroll
            for (int m = 0; m < 4; ++m) { const int row = row0 + ai * 128 + m * 16; const size_t off = (size_t)row * ldc + col0; float ss = 0.f;
#pragma unroll
                for (int bj = 0; bj < 2; ++bj) { const size_t i = off + bj * 128; pg8::f32x4 x0, x1;
                    if (BASE_F32) { x0 = bf[m][bj][0]; x1 = bf[m][bj][1]; }
                    else { const pg8::u32x4 w = bw[ai][m][bj];
                        x0 = (pg8::f32x4){__uint_as_float(w.x << 16), __uint_as_float(w.x & 0xffff0000u), __uint_as_float(w.y << 16), __uint_as_float(w.y & 0xffff0000u)};
                        x1 = (pg8::f32x4){__uint_as_float(w.z << 16), __uint_as_float(w.z & 0xffff0000u), __uint_as_float(w.w << 16), __uint_as_float(w.w & 0xffff0000u)}; }
                    x0 += acc[ai][bj][m][0]; x1 += acc[ai][bj][m][1];
                    if (OUT_F32) { *(pg8::f32x4*)((float*)out + i) = x0; *(pg8::f32x4*)((float*)out + i + 4) = x1; }
                    else { pg8::u32x4 w; w.x = pg8::cvt_pk_bf16(x0[0], x0[1]); w.y = pg8::cvt_pk_bf16(x0[2], x0[3]); w.z = pg8::cvt_pk_bf16(x1[0], x1[1]); w.w = pg8::cvt_pk_bf16(x1[2], x1[3]); NT_STORE((pg8::u32x4*)((bf16*)out + lane_blk + (size_t)(ai * 8 + m) * rbs + bj * 2048), w); }
                    ss += ((x0[0] * x0[0] + x0[1] * x0[1]) + (x0[2] * x0[2] + x0[3] * x0[3])) + ((x1[0] * x1[0] + x1[1] * x1[1]) + (x1[2] * x1[2] + x1[3] * x1[3])); }
                ss += __shfl_xor(ss, 16); ss += __shfl_xor(ss, 32);
                if (fq == 0) rssn[(size_t)row * 32 + u.pn * 4 + wc] = ss; }
        }
    }
};
typedef EpiResNorm<true, false> EpiResFirst; typedef EpiResNorm<false, false> EpiResMid; typedef EpiResNorm<false, true> EpiResLast;
__device__ __forceinline__ float dpp_ror1(float v) { return __int_as_float(__builtin_amdgcn_update_dpp(0, __float_as_int(v), 0x121, 0xf, 0xf, false)); }
__device__ __forceinline__ float dpp_ror2(float v) { return __int_as_float(__builtin_amdgcn_update_dpp(0, __float_as_int(v), 0x122, 0xf, 0xf, false)); }
constexpr float LOG2E_ = 1.4426950408889634f;
struct EpiGuFused {
    static constexpr bool PERM = true, AFTER_DRAIN = false;
    bf16* ACT; const float* rss; const float* cw; const float* cb; float* sideG; float* sideU; LAS unsigned char* halo;
    __device__ __forceinline__ void load_rows(int pm, int tid, LAS unsigned char* l) const { RowTile::load(rss, pm, tid, l); }
    __device__ __forceinline__ void operator()(const pg8::f32x4 (&acc)[2][2][4][2], const pg8::Unit& u, int wr, int wc, int fr, int fq) const {
        const int ch0 = u.pn * 128 + wc * 32 + 8 * fq;
        const size_t act_blk = ((size_t)(u.pm * 16 + wr * 4) * (DFF >> 5) + u.pn * 4 + wc) * 512 + fr * 32 + 8 * fq;
        float rsv[8];
#pragma unroll
        for (int q = 0; q < 8; ++q) rsv[q] = ((const LAS float*)(halo - 131072 + ROWTILE_OFF))[wr * 64 + fr + (q >> 2) * 128 + (q & 3) * 16];
        float w0[8], w1[8], w2[8], bb[8];
#pragma unroll
        for (int k = 0; k < 8; ++k) { w0[k] = cw[ch0 + k] * LOG2E_; w1[k] = cw[DFF + ch0 + k] * LOG2E_; w2[k] = cw[2 * DFF + ch0 + k] * LOG2E_; bb[k] = cb[ch0 + k] * LOG2E_; }
        asm volatile("" ::: "memory");
#pragma unroll
        for (int ai = 0; ai < 2; ++ai) { if (fr >= 14) { LAS float* hs = (LAS float*)(halo + (((ai * 2 + wr) * 4 + wc) * 8 + (fr - 14) * 4 + fq) * 32); const float rs = rsv[ai * 4 + 3];
                *(LAS pg8::f32x4*)hs = acc[ai][0][3][0] * rs; *(LAS pg8::f32x4*)(hs + 4) = acc[ai][0][3][1] * rs; } }
        asm volatile("s_waitcnt lgkmcnt(0)" ::: "memory"); __builtin_amdgcn_s_barrier(); asm volatile("" ::: "memory");
#pragma unroll
        for (int ai = 0; ai < 2; ++ai) {
            float rot[5][2][8];
            { const bool has_above = (ai | wr) != 0; const int sa = wr ? ai : 0, sw = wr ? 0 : 1;
              const LAS float* h62 = (const LAS float*)(halo + (((sa * 2 + sw) * 4 + wc) * 8 + fq) * 32); const LAS float* h63 = h62 + 32;
              const pg8::f32x4 a0 = *(const LAS pg8::f32x4*)h62, a1 = *(const LAS pg8::f32x4*)(h62 + 4), b0 = *(const LAS pg8::f32x4*)h63, b1 = *(const LAS pg8::f32x4*)(h63 + 4);
#pragma unroll
              for (int k = 0; k < 8; ++k) { const float r62 = k < 4 ? a0[k & 3] : a1[k & 3], r63 = k < 4 ? b0[k & 3] : b1[k & 3];
                  rot[0][0][k] = has_above ? r63 : 0.f; rot[0][1][k] = has_above ? (fr == 0 ? r62 : r63) : 0.f; } }
#pragma unroll
            for (int m = 0; m < 4; ++m) { const int row = u.pm * 256 + ai * 128 + wr * 64 + m * 16 + fr; const float rs = rsv[ai * 4 + m];
                float g[8], uu[8], o[8];
#pragma unroll
                for (int k = 0; k < 8; ++k) { g[k] = acc[ai][0][m][k >> 2][k & 3] * rs; uu[k] = acc[ai][1][m][k >> 2][k & 3] * (rs * (1.0f / LOG2E_)); }
#pragma unroll
                for (int k = 0; k < 8; ++k) { rot[m + 1][0][k] = dpp_ror1(g[k]); rot[m + 1][1][k] = dpp_ror2(g[k]);
                    const float g1 = (fr == 0) ? rot[m][0][k] : rot[m + 1][0][k], g2 = (fr < 2) ? rot[m][1][k] : rot[m + 1][1][k];
                    const float v = __builtin_fmaf(w2[k], g[k], __builtin_fmaf(w1[k], g1, __builtin_fmaf(w0[k], g2, bb[k])));
                    o[k] = v * __builtin_amdgcn_rcpf(1.0f + __builtin_amdgcn_exp2f(-v)) * uu[k]; }
                pg8::u32x4 ow; ow.x = pg8::cvt_pk_bf16(o[0], o[1]); ow.y = pg8::cvt_pk_bf16(o[2], o[3]); ow.z = pg8::cvt_pk_bf16(o[4], o[5]); ow.w = pg8::cvt_pk_bf16(o[6], o[7]);
                __builtin_nontemporal_store(ow, (pg8::u32x4*)(ACT + act_blk + (size_t)(ai * 8 + m) * ((DFF >> 5) * 512)));
                if (m == 0 && fr < 2 && ai == 0 && wr == 0) { float* sg = sideG + ((size_t)u.pm * 4 + fr) * DFF + ch0; float* su = sideU + ((size_t)u.pm * 2 + fr) * DFF + ch0;
                    *(pg8::f32x4*)sg = (pg8::f32x4){g[0], g[1], g[2], g[3]}; *(pg8::f32x4*)(sg + 4) = (pg8::f32x4){g[4], g[5], g[6], g[7]};
                    *(pg8::f32x4*)su = (pg8::f32x4){uu[0], uu[1], uu[2], uu[3]} * LOG2E_; *(pg8::f32x4*)(su + 4) = (pg8::f32x4){uu[4], uu[5], uu[6], uu[7]} * LOG2E_; }
                if (m == 3 && fr >= 14 && ai == 1 && wr == 1) { float* sg = sideG + ((size_t)u.pm * 4 + 2 + (fr - 14)) * DFF + ch0;
                    *(pg8::f32x4*)sg = (pg8::f32x4){g[0], g[1], g[2], g[3]}; *(pg8::f32x4*)(sg + 4) = (pg8::f32x4){g[4], g[5], g[6], g[7]}; }
            }
        }
    }
};
namespace pg8 { template <> struct RowsLds<EpiGuFused> { static constexpr bool value = true; }; }
struct Args { const float* in[21]; float* out; unsigned char* ws; int ph_lo, ph_hi; };
struct Frame {
    LAS unsigned char* lds;
    int tid, lane, wave, G, vcu;
    unsigned char* ws;
};

__device__ __forceinline__ void ph_ffn_fixup(Frame& F, bf16* ACT, const float* sideG, const float* sideU, const float* cw, const float* cb) {
    const int gt = F.vcu * NTHR + F.tid, NT = F.G * NTHR;
    for (int it = gt; it < 128 * 2 * 704; it += NT) {
        const int oct = it % 704, rr = (it / 704) & 1, pm = it / 1408, ch0 = oct * 8; const bool first = (pm & 7) == 0;
        const float* pm2 = rr == 0 ? sideG + ((size_t)(pm - 1) * 4 + 2) * DFF + ch0 : sideG + ((size_t)(pm - 1) * 4 + 3) * DFF + ch0;
        const float* pm1 = rr == 0 ? sideG + ((size_t)(pm - 1) * 4 + 3) * DFF + ch0 : sideG + ((size_t)pm * 4 + 0) * DFF + ch0;
        const float* p0 = sideG + ((size_t)pm * 4 + rr) * DFF + ch0; const float* pu = sideU + ((size_t)pm * 2 + rr) * DFF + ch0;
        float gm2[8], gm1[8], g0[8], uu[8], o[8];
#pragma unroll
        for (int k = 0; k < 8; ++k) { gm2[k] = first ? 0.f : pm2[k]; gm1[k] = (first && rr == 0) ? 0.f : pm1[k]; g0[k] = p0[k]; uu[k] = pu[k]; }
#pragma unroll
        for (int k = 0; k < 8; ++k) { const float v = cb[ch0 + k] + cw[ch0 + k] * gm2[k] + cw[DFF + ch0 + k] * gm1[k] + cw[2 * DFF + ch0 + k] * g0[k];
            o[k] = v * __builtin_amdgcn_rcpf(1.0f + __builtin_amdgcn_exp2f(-1.4426950408889634f * v)) * uu[k]; }
        v4u ow; ow.x = pk2(o[0], o[1]); ow.y = pk2(o[2], o[3]); ow.z = pk2(o[4], o[5]); ow.w = pk2(o[6], o[7]);
        *(v4u*)(ACT + blk_off(pm * 256 + rr, ch0, DFF)) = ow;
    }
}
__device__ __forceinline__ int dest_row(int kind, int n0) { if (kind == 0) return n0; const int c = n0 < DFF ? n0 : n0 - DFF; return (c >> 7) * 256 + (c & 127) + (n0 < DFF ? 0 : 128); }
__device__ __forceinline__ void p0_transpose_item(const float* W, int K, int N, bf16* WT, int kind, LAS unsigned char* scr, int item, int lane, const float* gain) {
    constexpr int TP = 264;
    const int nblk = (N + 127) / 128;
    const int kb = item / nblk, nb = item % nblk, k0 = 64 * kb, n0 = 128 * nb;
    const int nn = n0 + 4 * (lane & 31); const bool ok = nn < N;
    f32x4 v[32];
#pragma unroll
    for (int i = 0; i < 32; ++i) { const int kk = 2 * i + (lane >> 5); v[i] = ok ? __builtin_nontemporal_load((const f32x4*)(W + (size_t)(k0 + kk) * N + nn)) : (f32x4){0.f, 0.f, 0.f, 0.f}; }
#pragma unroll
    for (int i = 0; i < 32; ++i) { const int kk = 2 * i + (lane >> 5); f32x4 x = v[i]; if (gain) x = x * gain[k0 + kk];
        v2u w; w.x = pk2w(x.x, x.y); w.y = pk2w(x.z, x.w); *(LAS v2u*)(scr + kk * TP + 8 * (lane & 31)) = w; }
    asm volatile("s_waitcnt lgkmcnt(0)" ::: "memory");
    const int r0 = dest_row(kind, n0);
#pragma unroll 4
    for (int i = 0; i < 16; ++i) { const int p = lane + 64 * i, c = p & 7, n = p >> 3; const LAS unsigned char* s = scr + (8 * c) * TP + 2 * n;
        unsigned e[8];
#pragma unroll
        for (int q = 0; q < 8; ++q) e[q] = *(const LAS bf16*)(s + q * TP);
        v4u o; o.x = e[0] | (e[1] << 16); o.y = e[2] | (e[3] << 16); o.z = e[4] | (e[5] << 16); o.w = e[6] | (e[7] << 16);
        { const int cc = n & 31, rho = 16 * ((cc >> 2) & 1) + 4 * (cc >> 3) + (cc & 3);
          v4u* dst_ = (v4u*)(WT + blk_off(r0 + (n & ~31) + rho, k0 + 8 * c, K)); if (gain == nullptr || kind == 1) __builtin_nontemporal_store(o, dst_); else *dst_ = o; } }
    asm volatile("s_waitcnt lgkmcnt(0)" ::: "memory");
}
__device__ __forceinline__ void p0_transpose(const float* W, int K, int N, bf16* WT, int kind, LAS unsigned char* scr, int gw, int NGW, int lane, const float* gain = nullptr) {
    const int nitems = (K / 64) * ((N + 127) / 128);
    for (int item = gw; item < nitems; item += NGW) p0_transpose_item(W, K, N, WT, kind, scr, item, lane, gain);
}
constexpr int L1_I0 = (DM / 64) * ((O_IN + 127) / 128), L1_I1 = (DM / 64) * (DM / 128), L1_I2 = (DM / 64) * (GUW / 128), L1_I3 = (DFF / 64) * (DM / 128), L1_ITEMS = L1_I0 + L1_I1 + L1_I2 + L1_I3;
__device__ __forceinline__ void conv_l1_item(Frame& F, const Args& A, int it, LAS unsigned char* scr) {
    unsigned char* ws = F.ws;
    if (it < L1_I0) { p0_transpose_item(A.in[13], DM, O_IN, (bf16*)(ws + WS_WIN1), 0, scr, it, F.lane, FOLD ? A.in[1] + DM : nullptr); return; } it -= L1_I0;
    if (it < L1_I1) { p0_transpose_item(A.in[14], DM, DM, (bf16*)(ws + WS_WOUT1), 0, scr, it, F.lane, nullptr); return; } it -= L1_I1;
    if (it < L1_I2) { p0_transpose_item(A.in[16] + (size_t)DM * GUW, DM, GUW, (bf16*)(ws + WS_WGU1), 1, scr, it, F.lane, FOLD ? A.in[2] + DM : nullptr); return; } it -= L1_I2;
    p0_transpose_item(A.in[19] + (size_t)DFF * DM, DFF, DM, (bf16*)(ws + WS_WDN1), 0, scr, it, F.lane, nullptr);
}
__device__ __forceinline__ int t5_bucket(int n) {
    if (n < 16) return n;
    int lg = 16 + (int)(logf((float)n / 16.0f) / logf(8.0f) * 16.0f);
    return lg < 31 ? lg : 31;
}
template <bool OUT_BF16>
__device__ __forceinline__ void rmsnorm_rows(Frame& F, const float* X, const float* g, void* out) {
    const int gw = F.vcu * NWAVES + F.wave, NGW = F.G * NWAVES;
    for (int row = gw; row < MTOK; row += NGW) {
        const f32x4* xr = (const f32x4*)(X + (size_t)row * DM) + F.lane;
        f32x4 v[8]; float s = 0.f;
#pragma unroll
        for (int j = 0; j < 8; ++j) { v[j] = xr[64 * j]; s += (v[j].x * v[j].x + v[j].y * v[j].y) + (v[j].z * v[j].z + v[j].w * v[j].w); }
        const float rstd = 1.0f / sqrtf(wave_sum(s) * (1.0f / DM) + EPS);
#pragma unroll
        for (int j = 0; j < 8; ++j) { const f32x4 gg = ((const f32x4*)g)[F.lane + 64 * j]; const f32x4 o = v[j] * rstd * gg;
            if (OUT_BF16) { v2u w; w.x = pk2(o.x, o.y); w.y = pk2(o.z, o.w); *((v2u*)((bf16*)out + (size_t)row * DM) + F.lane + 64 * j) = w; }
            else *((f32x4*)((float*)out + (size_t)row * DM) + F.lane + 64 * j) = o; }
    }
}
__device__ __forceinline__ void p0_prologue(Frame& F, const Args& A) {
    LAS unsigned char* scr = F.lds + F.wave * 17408;
    const int gw = F.vcu * NWAVES + F.wave, NGW = F.G * NWAVES;
    unsigned char* ws = F.ws;
#if DEFER_L1
    { constexpr int I0 = (DM / 64) * (E_IN / 128), I1 = (DM / 64) * (DM / 128), I2 = (DM / 64) * (GUW / 128), I3 = (DFF / 64) * (DM / 128);
      for (int it0 = gw; it0 < I0 + I1 + I2 + I3 + L1_I0 + L1_I1; it0 += NGW) { int it = it0;
          if (it < I0) { p0_transpose_item(A.in[3], DM, E_IN, (bf16*)(ws + WS_WIN0), 0, scr, it, F.lane, FOLD ? A.in[1] : nullptr); continue; } it -= I0;
          if (it < I1) { p0_transpose_item(A.in[12], DM, DM, (bf16*)(ws + WS_WOUT0), 0, scr, it, F.lane, nullptr); continue; } it -= I1;
          if (it < I2) { p0_transpose_item(A.in[16], DM, GUW, (bf16*)(ws + WS_WGU0), 1, scr, it, F.lane, FOLD ? A.in[2] : nullptr); continue; } it -= I2;
          if (it < I3) { p0_transpose_item(A.in[19], DFF, DM, (bf16*)(ws + WS_WDN0), 0, scr, it, F.lane, nullptr); continue; } it -= I3;
          if (it < L1_I0) { p0_transpose_item(A.in[13], DM, O_IN, (bf16*)(ws + WS_WIN1), 0, scr, it, F.lane, FOLD ? A.in[1] + DM : nullptr); continue; } it -= L1_I0;
          p0_transpose_item(A.in[14], DM, DM, (bf16*)(ws + WS_WOUT1), 0, scr, it, F.lane, nullptr); } }
#else
    p0_transpose(A.in[3], DM, E_IN, (bf16*)(ws + WS_WIN0), 0, scr, gw, NGW, F.lane, FOLD ? A.in[1] : nullptr);
    p0_transpose(A.in[12], DM, DM, (bf16*)(ws + WS_WOUT0), 0, scr, gw, NGW, F.lane);
#if !DEFER_L1
    p0_transpose(A.in[13], DM, O_IN, (bf16*)(ws + WS_WIN1), 0, scr, gw, NGW, F.lane, FOLD ? A.in[1] + DM : nullptr);
#endif
#if !DEFER_L1
    p0_transpose(A.in[14], DM, DM, (bf16*)(ws + WS_WOUT1), 0, scr, gw, NGW, F.lane);
#endif
    p0_transpose(A.in[16], DM, GUW, (bf16*)(ws + WS_WGU0), 1, scr, gw, NGW, F.lane, FOLD ? A.in[2] : nullptr);
#if !DEFER_L1
    p0_transpose(A.in[16] + (size_t)DM * GUW, DM, GUW, (bf16*)(ws + WS_WGU1), 1, scr, gw, NGW, F.lane, FOLD ? A.in[2] + DM : nullptr);
#endif
    p0_transpose(A.in[19], DFF, DM, (bf16*)(ws + WS_WDN0), 0, scr, gw, NGW, F.lane);
#if !DEFER_L1
    p0_transpose(A.in[19] + (size_t)DFF * DM, DFF, DM, (bf16*)(ws + WS_WDN1), 0, scr, gw, NGW, F.lane);
#endif
#endif
    const int gt = F.vcu * NTHR + F.tid, NT = F.G * NTHR;
    { v4u* z = (v4u*)((bf16*)(ws + WS_WIN1) + (size_t)4224 * DM); const int n16 = (O_INP - 4224) * DM / 8; for (int i = gt; i < n16; i += NT) z[i] = (v4u){0u, 0u, 0u, 0u}; }
    { f32x2* rot = (f32x2*)(ws + WS_ROT);
      for (int i = gt; i < SEQ * 64; i += NT) { const int t = i >> 6, j = i & 63; const float freq = exp2f(-(float)j * (13.287712379549449f / 64.0f)); const float ang = (float)t * freq;
          const float rev = ang * 0.15915494309189535f; const float fr = rev - floorf(rev); rot[i] = (f32x2){__builtin_amdgcn_cosf(fr), __builtin_amdgcn_sinf(fr)}; } }
    { bf16* waT = (bf16*)(ws + WS_GT); bf16* wxT = waT + 8 * 128 * 128;
      for (int i = gt; i < 8 * 128 * 128; i += NT) { const int n = i >> 14, d = (i >> 7) & 127, e = i & 127;
          waT[(n * 128 + e) * 128 + d] = (bf16)f2bf(A.in[7][i]); wxT[(n * 128 + e) * 128 + d] = (bf16)f2bf(A.in[9][i]); } }
    { float* tb = (float*)(ws + WS_TB); for (int i = gt; i < 128 * 16; i += NT) { const int n = i >> 4, h = i & 15; tb[i] = A.in[15][t5_bucket(n) * 16 + h]; }
      float* sp = (float*)(ws + WS_SP); for (int i = gt; i < 1024; i += NT) { const float x = -A.in[11][i]; sp[i] = fmaxf(x, 0.f) + log1pf(__expf(-fabsf(x))); } }
#if FOLD == 0
    rmsnorm_rows<true>(F, A.in[0], A.in[1], ws + WS_H);
#else
    { bf16* XB = (bf16*)(ws + WS_XB); float* rstd0 = (float*)(ws + WS_RSTD);
      for (int rb = gw; rb < MTOK / 16; rb += NGW) { const int row = rb * 16 + (F.lane >> 2); const float* xr = A.in[0] + (size_t)row * DM + (F.lane & 3) * 8; bf16* ob = XB + (size_t)rb * (DM / 32) * 512 + F.lane * 8; float s = 0.f;
#pragma unroll 8
          for (int cb = 0; cb < DM / 32; ++cb) { const f32x4 v0 = __builtin_nontemporal_load((const f32x4*)(xr + cb * 32)), v1 = __builtin_nontemporal_load((const f32x4*)(xr + cb * 32 + 4));
              s += ((v0.x * v0.x + v0.y * v0.y) + (v0.z * v0.z + v0.w * v0.w)) + ((v1.x * v1.x + v1.y * v1.y) + (v1.z * v1.z + v1.w * v1.w));
              v4u w; w.x = pk2(v0.x, v0.y); w.y = pk2(v0.z, v0.w); w.z = pk2(v1.x, v1.y); w.w = pk2(v1.z, v1.w); *(v4u*)(ob + cb * 512) = w; }
          s += __shfl_xor(s, 1); s += __shfl_xor(s, 2);
          if ((F.lane & 3) == 0) rstd0[row] = rstd_of(s); } }
#endif
}

__device__ __forceinline__ void ret_naive_unit(Frame& F, const Args& A, int b, int h) {
    LAS float* ql = (LAS float*)(F.lds); LAS float* kl = ql + 16 * 128; LAS float* vl = kl + 16 * 128; LAS float* yp = vl + 16 * 128;
    const bf16* PROJ = (const bf16*)(F.ws + WS_PROJ); bf16* MIX = (bf16*)(F.ws + WS_H); const f32x2* rot = (const f32x2*)(F.ws + WS_ROT);
    const float* gn = A.in[4];
    const int tid = F.tid, e = tid & 127, dg = tid >> 7;
    const float gamma = 1.0f - exp2f(-5.0f - (float)h);
    float S[32];
#pragma unroll
    for (int i = 0; i < 32; ++i) S[i] = 0.f;
    for (int t0 = 0; t0 < SEQ; t0 += 16) {
        { const int row = tid >> 5, t = t0 + row; const bf16* prow = PROJ + (size_t)(b * SEQ + t) * E_IN;
#pragma unroll
          for (int rep = 0; rep < 2; ++rep) { const int i = (tid & 31) + 32 * rep; const f32x2 cs = rot[t * 64 + i];
              const float q1 = bf2f(prow[C0_Q + h * 128 + i]), q2 = bf2f(prow[C0_Q + h * 128 + i + 64]);
              const float k1 = bf2f(prow[C0_K + h * 128 + i]), k2 = bf2f(prow[C0_K + h * 128 + i + 64]);
              ql[row * 128 + i] = q1 * cs.x - q2 * cs.y; ql[row * 128 + i + 64] = q2 * cs.x + q1 * cs.y;
              kl[row * 128 + i] = (k1 * cs.x - k2 * cs.y) * 0.08838834764831845f; kl[row * 128 + i + 64] = (k2 * cs.x + k1 * cs.y) * 0.08838834764831845f;
              vl[row * 128 + i] = bf2f(prow[C0_V + h * 128 + i]); vl[row * 128 + i + 64] = bf2f(prow[C0_V + h * 128 + i + 64]); } }
        __syncthreads();
        for (int r = 0; r < 16; ++r) {
            const float vv = vl[r * 128 + e]; float yacc = 0.f;
#pragma unroll
            for (int q4 = 0; q4 < 8; ++q4) { const f32x4 k4 = *(const LAS f32x4*)(kl + r * 128 + dg * 32 + 4 * q4); const f32x4 qq = *(const LAS f32x4*)(ql + r * 128 + dg * 32 + 4 * q4);
#pragma unroll
                for (int j = 0; j < 4; ++j) { S[4 * q4 + j] = gamma * S[4 * q4 + j] + k4[j] * vv; yacc += qq[j] * S[4 * q4 + j]; } }
            yp[(r * 4 + dg) * 128 + e] = yacc;
        }
        __syncthreads();
#pragma unroll
        for (int rr = 0; rr < 2; ++rr) { const int r = 2 * F.wave + rr; const int l = F.lane;
            const float y0 = (yp[(r * 4 + 0) * 128 + l] + yp[(r * 4 + 1) * 128 + l]) + (yp[(r * 4 + 2) * 128 + l] + yp[(r * 4 + 3) * 128 + l]);
            const float y1 = (yp[(r * 4 + 0) * 128 + l + 64] + yp[(r * 4 + 1) * 128 + l + 64]) + (yp[(r * 4 + 2) * 128 + l + 64] + yp[(r * 4 + 3) * 128 + l + 64]);
            const float rstd = 1.0f / sqrtf(wave_sum(y0 * y0 + y1 * y1) * (1.0f / 128.0f) + EPS);
            const size_t tok = (size_t)(b * SEQ + t0 + r);
            const float g0 = bf2f(PROJ[tok * E_IN + C0_G + h * 128 + l]), g1 = bf2f(PROJ[tok * E_IN + C0_G + h * 128 + l + 64]);
            MIX[tok * DM + h * 128 + l] = (bf16)f2bf(y0 * rstd * gn[h * 128 + l] * siluf_(g0));
            MIX[tok * DM + h * 128 + l + 64] = (bf16)f2bf(y1 * rstd * gn[h * 128 + l + 64] * siluf_(g1)); }
        __syncthreads();
    }
}
__device__ __forceinline__ void lru_naive_unit(Frame& F, const Args& A, int b, int n) {
    LAS float* xc = (LAS float*)(F.lds); LAS float* pr = xc + 8 * 128; LAS float* pi = pr + 8 * 4 * 128;
    const bf16* PROJ = (const bf16*)(F.ws + WS_PROJ); bf16* MIX = (bf16*)(F.ws + WS_H);
    const float* cw = A.in[5]; const float* cb = A.in[6]; const float* wa = A.in[7]; const float* ba = A.in[8]; const float* wx = A.in[9]; const float* bx = A.in[10];
    const float* sp = (const float*)(F.ws + WS_SP);
    const int tid = F.tid, e = tid & 127, part = tid >> 7;
    float war[32], wxr[32];
#pragma unroll
    for (int dd = 0; dd < 32; ++dd) { war[dd] = wa[(size_t)(n * 128 + part * 32 + dd) * 128 + e]; wxr[dd] = wx[(size_t)(n * 128 + part * 32 + dd) * 128 + e]; }
    const int ce = n * 128 + e;
    const float bae = ba[ce], bxe = bx[ce], spe = sp[ce];
    float cwr[2][4], cbr[2];
#pragma unroll
    for (int rep = 0; rep < 2; ++rep) { const int c = n * 128 + (tid & 63) + 64 * rep; cbr[rep] = cb[c];
#pragma unroll
        for (int j = 0; j < 4; ++j) cwr[rep][j] = cw[j * 1024 + c]; }
    float hst = 0.f;
    for (int t0 = 0; t0 < SEQ; t0 += 8) {
        { const int row = tid >> 6, t = t0 + row;
#pragma unroll
          for (int rep = 0; rep < 2; ++rep) { const int c = (tid & 63) + 64 * rep; float a = cbr[rep];
#pragma unroll
              for (int j = 0; j < 4; ++j) { const int tt = t - 3 + j; if (tt >= 0) a += cwr[rep][j] * bf2f(PROJ[(size_t)(b * SEQ + tt) * E_IN + C0_XR + n * 128 + c]); }
              xc[row * 128 + c] = a; } }
        __syncthreads();
        for (int r = 0; r < 8; ++r) { float pa = 0.f, px = 0.f;
#pragma unroll
            for (int q4 = 0; q4 < 8; ++q4) { const f32x4 x4 = *(const LAS f32x4*)(xc + r * 128 + part * 32 + 4 * q4);
#pragma unroll
                for (int j = 0; j < 4; ++j) { pa += x4[j] * war[4 * q4 + j]; px += x4[j] * wxr[4 * q4 + j]; } }
            pr[(r * 4 + part) * 128 + e] = pa; pi[(r * 4 + part) * 128 + e] = px; }
        __syncthreads();
        if (tid < 128) {
            for (int r = 0; r < 8; ++r) {
                const float ra = (pr[(r * 4 + 0) * 128 + e] + pr[(r * 4 + 1) * 128 + e]) + (pr[(r * 4 + 2) * 128 + e] + pr[(r * 4 + 3) * 128 + e]) + bae;
                const float ia = (pi[(r * 4 + 0) * 128 + e] + pi[(r * 4 + 1) * 128 + e]) + (pi[(r * 4 + 2) * 128 + e] + pi[(r * 4 + 3) * 128 + e]) + bxe;
                const float rg = sigmoidf_(ra), ig = sigmoidf_(ia);
                const float log_a = -8.0f * rg * spe; const float a = __expf(log_a);
                const float em = -expm1f(2.0f * log_a); const float mult = sqrtf(fmaxf(em, 0.f));
                const float bb = mult * (ig * xc[r * 128 + e]);
                hst = a * hst + bb;
                const size_t tok = (size_t)(b * SEQ + t0 + r);
                const float y = bf2f(PROJ[tok * E_IN + C0_YR + n * 128 + e]);
                MIX[tok * DM + 1024 + n * 128 + e] = (bf16)f2bf(hst * gelu_tanh(y));
            }
        }
        __syncthreads();
    }
}
__device__ __forceinline__ void ph_mixer0_naive(Frame& F, const Args& A) {
    for (int u = F.vcu; u < 256; u += F.G) {
        if (u < 128) ret_naive_unit(F, A, u >> 3, u & 7); else lru_naive_unit(F, A, (u - 128) >> 3, (u - 128) & 7);
        __syncthreads();
    }
}
namespace mx {
typedef float f32x16 __attribute__((ext_vector_type(16)));
typedef short s16x8 __attribute__((ext_vector_type(8)));
constexpr int PB = 272;
constexpr int OFF_KH = 0, OFF_KT = 34816, OFF_VT = 69632, OFF_ST = 104448, OFF_SSQ = 139264;
__device__ __forceinline__ int crow(int r, int hi) { return (r & 3) + 8 * (r >> 2) + 4 * hi; }
__device__ __forceinline__ unsigned cvtpk(float lo, float hi) { unsigned r; asm volatile("v_cvt_pk_bf16_f32 %0, %1, %2" : "=v"(r) : "v"(lo), "v"(hi)); return r; }
__device__ __forceinline__ float blo(unsigned w) { return __uint_as_float(w << 16); }
__device__ __forceinline__ float bhi(unsigned w) { return __uint_as_float(w & 0xffff0000u); }
#define MFMA32(a, b, c) __builtin_amdgcn_mfma_f32_32x32x16_bf16((a), (b), (c), 0, 0, 0)
typedef short s16x4 __attribute__((ext_vector_type(4)));
__device__ __forceinline__ s16x4 trr(int addr) { s16x4 r; asm volatile("ds_read_b64_tr_b16 %0, %1" : "=&v"(r) : "v"(addr) : "memory"); return r; }
#define TRWAIT() do { asm volatile("s_waitcnt lgkmcnt(0)" ::: "memory"); __builtin_amdgcn_sched_barrier(0); } while (0)
__device__ __forceinline__ void rot_cs(int t, float freq, float& c, float& s) {
    const float rev = ((float)t * freq) * 0.15915494309189535f, fr = rev - floorf(rev); c = __builtin_amdgcn_cosf(fr); s = __builtin_amdgcn_sinf(fr);
}
__device__ __forceinline__ void ret_unit(Frame& F, const Args& A, int b, int h) {
    LAS unsigned char* KH = F.lds + OFF_KH; LAS unsigned char* GT = F.lds + OFF_KT;     LAS unsigned char* VT = F.lds + OFF_VT; LAS unsigned char* STB = F.lds + OFF_ST;
    LAS float* SSQ = (LAS float*)(F.lds + OFF_SSQ); LAS float* FRQ = SSQ + 256;
    const bf16* PROJ = (const bf16*)(F.ws + WS_PROJ); bf16* MIX = (bf16*)(F.ws + WS_H);
    const float* gn = A.in[4];
    const int tid = F.tid, lane = F.lane, wave = F.wave, c = lane & 31, hi = lane >> 5, I = wave >> 1, E = wave & 1;
    const float lg = log2f(1.0f - exp2f(-5.0f - (float)h));
    const float g128 = exp2f(128.0f * lg);
    f32x16 st0 = {}, st1 = {};
    const int trl = ((lane & 15) >> 2) * PB + (16 * ((lane >> 4) & 1) + 4 * (lane & 3)) * 2;
    const int vtr = (int)(unsigned)(size_t)VT + trl, ktr = (int)(unsigned)(size_t)KH + trl;
    for (int i = tid; i < 34816 / 16; i += NTHR) ((LAS v4u*)STB)[i] = (v4u){0u, 0u, 0u, 0u};
    if (tid < 64) FRQ[tid] = exp2f(-(float)tid * (13.287712379549449f / 64.0f));
    v4u kraw[2][2], vraw[4], qraw[4][2], graw[4];
    const int il = 32 * I + c;
    const int tcK = (int)blk_off(tid >> 3, C0_K + h * 128 + (tid & 7) * 8, E_IN), tcV = (int)blk_off(tid >> 4, C0_V + h * 128 + (tid & 15) * 8, E_IN), tcQ = (int)blk_off(il, C0_Q + h * 128 + 8 * hi, E_IN);
#define RET_LOAD(n_) do { const bf16* cb_ = PROJ + ((size_t)b * SEQ + (n_) * 128) * E_IN; \
        _Pragma("unroll") for (int rep = 0; rep < 2; ++rep) { kraw[rep][0] = __builtin_nontemporal_load((const v4u*)(cb_ + (size_t)(64 * rep) * E_IN + tcK)); kraw[rep][1] = __builtin_nontemporal_load((const v4u*)(cb_ + (size_t)(64 * rep) * E_IN + tcK + 1024)); } } while (0)
#define RET_LOADVG(n_) do { const bf16* cb_ = PROJ + ((size_t)b * SEQ + (n_) * 128) * E_IN; \
        _Pragma("unroll") for (int rep = 0; rep < 4; ++rep) { vraw[rep] = __builtin_nontemporal_load((const v4u*)(cb_ + (size_t)(32 * rep) * E_IN + tcV)); graw[rep] = __builtin_nontemporal_load((const v4u*)(cb_ + (size_t)(32 * rep) * E_IN + tcV + 32 * 512)); } } while (0)
#define RET_LOADQ(n_) do { const bf16* cb_ = PROJ + ((size_t)b * SEQ + (n_) * 128) * E_IN + tcQ; \
        _Pragma("unroll") for (int ks = 0; ks < 4; ++ks) { qraw[ks][0] = __builtin_nontemporal_load((const v4u*)(cb_ + (ks >> 1) * 512 + 16 * (ks & 1))); qraw[ks][1] = __builtin_nontemporal_load((const v4u*)(cb_ + (ks >> 1) * 512 + 16 * (ks & 1) + 1024)); } } while (0)
    __syncthreads();
    for (int n = 0; n < SEQ / 128; ++n) {
        const size_t tok0 = (size_t)b * SEQ + n * 128;
        RET_LOAD(n);
#pragma unroll
        for (int rep = 0; rep < 2; ++rep) { const int idx = tid + 512 * rep, j = idx >> 3, d0 = (idx & 7) * 8;
            const v4u xlo = kraw[rep][0], xhi = kraw[rep][1];
            const float ks = 0.08838834764831845f * __builtin_amdgcn_exp2f(-(float)j * lg);
            const f32x4 f0 = *(const LAS f32x4*)(FRQ + d0), f1 = *(const LAS f32x4*)(FRQ + d0 + 4); const float fq_[8] = {f0.x, f0.y, f0.z, f0.w, f1.x, f1.y, f1.z, f1.w};
            float o1[8], o2[8];
#pragma unroll
            for (int q = 0; q < 4; ++q) { float c0, s0, c1, s1; rot_cs(n * 128 + j, fq_[2 * q], c0, s0); rot_cs(n * 128 + j, fq_[2 * q + 1], c1, s1);
                const float a1 = blo(xlo[q]), a2 = blo(xhi[q]), b1 = bhi(xlo[q]), b2 = bhi(xhi[q]);
                o1[2 * q] = (a1 * c0 - a2 * s0) * ks; o2[2 * q] = (a2 * c0 + a1 * s0) * ks;
                o1[2 * q + 1] = (b1 * c1 - b2 * s1) * ks; o2[2 * q + 1] = (b2 * c1 + b1 * s1) * ks; }
            v4u w1, w2;
#pragma unroll
            for (int q = 0; q < 4; ++q) { w1[q] = cvtpk(o1[2 * q], o1[2 * q + 1]); w2[q] = cvtpk(o2[2 * q], o2[2 * q + 1]); }
            *(LAS v4u*)(KH + j * PB + d0 * 2) = w1; *(LAS v4u*)(KH + j * PB + (d0 + 64) * 2) = w2; }
        RET_LOADQ(n); RET_LOADVG(n);
        s16x8 qf[8];
        { const float qs = __builtin_amdgcn_exp2f((float)il * lg);
#pragma unroll
          for (int ks = 0; ks < 4; ++ks) { const int d0 = 16 * ks + 8 * hi; const v4u xlo = qraw[ks][0], xhi = qraw[ks][1];
              const f32x4 f0 = *(const LAS f32x4*)(FRQ + d0), f1 = *(const LAS f32x4*)(FRQ + d0 + 4); const float fq_[8] = {f0.x, f0.y, f0.z, f0.w, f1.x, f1.y, f1.z, f1.w}; v4u w1, w2;
#pragma unroll
              for (int q = 0; q < 4; ++q) { float c0, s0, c1, s1; rot_cs(n * 128 + il, fq_[2 * q], c0, s0); rot_cs(n * 128 + il, fq_[2 * q + 1], c1, s1);
                  const float a1 = blo(xlo[q]), a2 = blo(xhi[q]), b1 = bhi(xlo[q]), b2 = bhi(xhi[q]);
                  w1[q] = cvtpk((a1 * c0 - a2 * s0) * qs, (b1 * c1 - b2 * s1) * qs); w2[q] = cvtpk((a2 * c0 + a1 * s0) * qs, (b2 * c1 + b1 * s1) * qs); }
              qf[ks] = *reinterpret_cast<s16x8*>(&w1); qf[ks + 4] = *reinterpret_cast<s16x8*>(&w2); } }
#pragma unroll
        for (int rep = 0; rep < 4; ++rep) { const int idx = tid + 512 * rep, j = idx >> 4, e0 = (idx & 15) * 8; *(LAS v4u*)(VT + j * PB + e0 * 2) = vraw[rep]; *(LAS v4u*)(GT + j * PB + e0 * 2) = graw[rep]; }
        __syncthreads();
        f32x16 y0 = {}, y1 = {};
#pragma unroll
        for (int ks = 0; ks < 8; ++ks) { const s16x8 a0 = *(const LAS s16x8*)(STB + (64 * E + c) * PB + (16 * ks + 8 * hi) * 2), a1 = *(const LAS s16x8*)(STB + (64 * E + 32 + c) * PB + (16 * ks + 8 * hi) * 2);
            y0 = MFMA32(a0, qf[ks], y0); y1 = MFMA32(a1, qf[ks], y1); __builtin_amdgcn_sched_barrier(0); }
        for (int J = 0; J <= I; ++J) {
            f32x16 s = {};
#pragma unroll
            for (int ks = 0; ks < 8; ++ks) { const s16x8 ak = *(const LAS s16x8*)(KH + (32 * J + c) * PB + (16 * ks + 8 * hi) * 2); s = MFMA32(ak, qf[ks], s); if (ks & 1) __builtin_amdgcn_sched_barrier(0); }
            { const int lim = c + 32 * (I - J);
#pragma unroll
              for (int r = 0; r < 16; ++r) s[r] = (crow(r, hi) <= lim) ? s[r] : 0.f; }
#pragma unroll
            for (int s2 = 0; s2 < 2; ++s2) { v4u pw;
#pragma unroll
                for (int q = 0; q < 4; ++q) pw[q] = cvtpk(s[8 * s2 + 2 * q], s[8 * s2 + 2 * q + 1]);
                const s16x8 pb = *reinterpret_cast<s16x8*>(&pw);
                const int jb = 32 * J + 16 * s2 + 4 * hi;
                { const s16x4 l4 = trr(vtr + jb * PB + (64 * E) * 2), h4 = trr(vtr + (jb + 8) * PB + (64 * E) * 2);
                  const s16x4 l5 = trr(vtr + jb * PB + (64 * E + 32) * 2), h5 = trr(vtr + (jb + 8) * PB + (64 * E + 32) * 2);
                  TRWAIT();
                  y0 = MFMA32(((s16x8){l4[0], l4[1], l4[2], l4[3], h4[0], h4[1], h4[2], h4[3]}), pb, y0);
                  y1 = MFMA32(((s16x8){l5[0], l5[1], l5[2], l5[3], h5[0], h5[1], h5[2], h5[3]}), pb, y1); } }
        }
        { const int et = wave >> 1, dt0 = 2 * (wave & 1);
#pragma unroll
          for (int ks = 0; ks < 8; ++ks) { const int jr = 16 * ks + 8 * hi;
              const s16x4 al = trr(vtr + jr * PB + (32 * et) * 2), ah = trr(vtr + (jr + 4) * PB + (32 * et) * 2);
              const s16x4 bl0 = trr(ktr + jr * PB + (32 * dt0) * 2), bh0 = trr(ktr + (jr + 4) * PB + (32 * dt0) * 2), bl1 = trr(ktr + jr * PB + (32 * dt0 + 32) * 2), bh1 = trr(ktr + (jr + 4) * PB + (32 * dt0 + 32) * 2);
              TRWAIT();
              const s16x8 av = {al[0], al[1], al[2], al[3], ah[0], ah[1], ah[2], ah[3]};
              st0 = MFMA32(av, ((s16x8){bl0[0], bl0[1], bl0[2], bl0[3], bh0[0], bh0[1], bh0[2], bh0[3]}), st0);
              st1 = MFMA32(av, ((s16x8){bl1[0], bl1[1], bl1[2], bl1[3], bh1[0], bh1[1], bh1[2], bh1[3]}), st1); }
#pragma unroll
          for (int r = 0; r < 16; ++r) { st0[r] *= g128; st1[r] *= g128; } }
        { float ss = 0.f;
#pragma unroll
          for (int r = 0; r < 16; ++r) ss += y0[r] * y0[r] + y1[r] * y1[r];
          ss += __shfl_xor(ss, 32);
          if (hi == 0) SSQ[(I * 2 + E) * 32 + c] = ss; }
        __syncthreads();
        { const int et = wave >> 1, dt0 = 2 * (wave & 1);
#pragma unroll
          for (int r = 0; r < 16; ++r) { const int e = 32 * et + crow(r, hi);
              *(LAS bf16*)(STB + e * PB + (32 * dt0 + c) * 2) = (bf16)f2bf(st0[r]); *(LAS bf16*)(STB + e * PB + (32 * dt0 + 32 + c) * 2) = (bf16)f2bf(st1[r]); } }
        { const float tot = SSQ[(I * 2) * 32 + c] + SSQ[(I * 2 + 1) * 32 + c]; const float rstd = __builtin_amdgcn_rsqf(tot * (1.0f / 128.0f) + EPS);
#pragma unroll
          for (int et2 = 0; et2 < 2; ++et2)
#pragma unroll
              for (int rg = 0; rg < 4; ++rg) { const int e0 = 64 * E + 32 * et2 + 8 * rg + 4 * hi;
                  LAS v2u* slot = (LAS v2u*)(GT + il * PB + e0 * 2);
                  const v2u gw = *slot; const f32x4 gv = *(const f32x4*)(gn + h * 128 + e0);
                  const f32x16& yy = et2 ? y1 : y0;
                  const float o0 = yy[4 * rg] * rstd * gv.x * siluf_(blo(gw.x)), o1 = yy[4 * rg + 1] * rstd * gv.y * siluf_(bhi(gw.x));
                  const float o2 = yy[4 * rg + 2] * rstd * gv.z * siluf_(blo(gw.y)), o3 = yy[4 * rg + 3] * rstd * gv.w * siluf_(bhi(gw.y));
                  v2u ow; ow.x = cvtpk(o0, o1); ow.y = cvtpk(o2, o3);
                  *slot = ow; } }
        __syncthreads();
#pragma unroll
        for (int rep = 0; rep < 4; ++rep) { const int idx = tid + 512 * rep, j = idx >> 4, e0 = (idx & 15) * 8;
            *(v4u*)(MIX + blk_off((int)(tok0 + j), h * 128 + e0, DM)) = *(const LAS v4u*)(GT + j * PB + e0 * 2); }
        __syncthreads();
    }
}
constexpr int L_RAW = 0;
constexpr int L_XC = 32768;
constexpr int L_AL = L_XC + 17408;
constexpr int L_BL = L_AL + 32768;
constexpr int L_SEG = L_BL + 32768;
constexpr int L_CAR = L_SEG + 4096;
constexpr int L_CW = L_CAR + 1024;
__device__ __forceinline__ float fsig(float x) { return __builtin_amdgcn_rcpf(1.0f + __builtin_amdgcn_exp2f(-1.4426950408889634f * x)); }
__device__ __forceinline__ void lru_unit(Frame& F, const Args& A, int b, int n) {
    LAS unsigned char* RAW = F.lds + L_RAW; LAS unsigned char* XC = F.lds + L_XC; LAS float* AL = (LAS float*)(F.lds + L_AL); LAS float* BL = (LAS float*)(F.lds + L_BL);
    LAS float* SEGA = (LAS float*)(F.lds + L_SEG); LAS float* SEGB = SEGA + 512; LAS float* CAR = (LAS float*)(F.lds + L_CAR);
    const bf16* PROJ = (const bf16*)(F.ws + WS_PROJ); bf16* MIX = (bf16*)(F.ws + WS_H);
    const bf16* waT = (const bf16*)(F.ws + WS_GT); const bf16* wxT = waT + 8 * 128 * 128;
    const int tid = F.tid, lane = F.lane, wave = F.wave, c = lane & 31, hi = lane >> 5, et = wave & 3, tt = wave >> 2;
    const int e = 32 * et + c, ce = n * 128 + e;
    s16x8 wfa[8], wfx[8];
#pragma unroll
    for (int ks = 0; ks < 8; ++ks) { wfa[ks] = *(const s16x8*)(waT + (size_t)ce * 128 + 16 * ks + 8 * hi); wfx[ks] = *(const s16x8*)(wxT + (size_t)ce * 128 + 16 * ks + 8 * hi); }
    const float bae = A.in[8][ce], bxe = A.in[10][ce], spe = ((const float*)(F.ws + WS_SP))[ce];
    const int c0 = 8 * (tid & 15);
    LAS float* CW = (LAS float*)(F.lds + L_CW);
    if (tid < 128) { CW[512 + tid] = A.in[6][n * 128 + tid];
#pragma unroll
        for (int j = 0; j < 4; ++j) CW[j * 128 + tid] = A.in[5][j * 1024 + n * 128 + tid]; }
    const bf16* xrb = PROJ + (size_t)b * SEQ * E_IN + C0_XR + n * 128;
    const bf16* yrb = PROJ + (size_t)b * SEQ * E_IN + C0_YR + n * 128;
    bf16* outb = MIX + (size_t)b * SEQ * DM + 1024 + n * 128;
    const int ch = tid & 127, seg = tid >> 7;
    if (tid < 128) CAR[tid] = 0.f;
    if (tid < 48) *(LAS v4u*)(RAW + (125 + tid / 16) * 256 + (tid & 15) * 16) = (v4u){0u, 0u, 0u, 0u};
#pragma unroll
    for (int rep = 0; rep < 2; ++rep) { const int idx = tid + 512 * rep, r = idx >> 4, o = idx & 15; *(LAS v4u*)(RAW + r * 256 + o * 16) = __builtin_nontemporal_load((const v4u*)(PROJ + blk_off(b * SEQ + r, C0_XR + n * 128 + o * 8, E_IN))); }
    __syncthreads();
    for (int k = 0; k < SEQ / 64; ++k) {
        const int t0 = 64 * k;
        v4u pre[2];
        if (k + 1 < SEQ / 64) {
#pragma unroll
            for (int rep = 0; rep < 2; ++rep) { const int idx = tid + 512 * rep, r = idx >> 4, o = idx & 15; pre[rep] = __builtin_nontemporal_load((const v4u*)(PROJ + blk_off(b * SEQ + t0 + 64 + r, C0_XR + n * 128 + o * 8, E_IN))); } }
        else { pre[0] = (v4u){0u, 0u, 0u, 0u}; pre[1] = pre[0]; }
        unsigned yv[8];
#pragma unroll
        for (int r = 0; r < 8; ++r) yv[r] = (unsigned)PROJ[blk_off(b * SEQ + t0 + 16 * seg + 2 * r, C0_YR + n * 128 + ch, E_IN)] | ((unsigned)PROJ[blk_off(b * SEQ + t0 + 16 * seg + 2 * r + 1, C0_YR + n * 128 + ch, E_IN)] << 16);
#pragma unroll
        for (int rep = 0; rep < 2; ++rep) { const int tl = (tid >> 4) + 32 * rep, t = t0 + tl; float acc[8];
            { const f32x4 b0 = *(const LAS f32x4*)(CW + 512 + c0), b1 = *(const LAS f32x4*)(CW + 512 + c0 + 4);
              acc[0] = b0.x; acc[1] = b0.y; acc[2] = b0.z; acc[3] = b0.w; acc[4] = b1.x; acc[5] = b1.y; acc[6] = b1.z; acc[7] = b1.w; }
#pragma unroll
            for (int j = 0; j < 4; ++j) { const v4u xv = *(const LAS v4u*)(RAW + ((t - 3 + j) & 127) * 256 + c0 * 2);
                const f32x4 w0 = *(const LAS f32x4*)(CW + j * 128 + c0), w1 = *(const LAS f32x4*)(CW + j * 128 + c0 + 4);
                acc[0] += w0.x * blo(xv[0]); acc[1] += w0.y * bhi(xv[0]); acc[2] += w0.z * blo(xv[1]); acc[3] += w0.w * bhi(xv[1]);
                acc[4] += w1.x * blo(xv[2]); acc[5] += w1.y * bhi(xv[2]); acc[6] += w1.z * blo(xv[3]); acc[7] += w1.w * bhi(xv[3]); }
            v4u w;
#pragma unroll
            for (int q = 0; q < 4; ++q) w[q] = cvtpk(acc[2 * q], acc[2 * q + 1]);
            *(LAS v4u*)(XC + tl * PB + c0 * 2) = w; }
        __syncthreads();
        { f32x16 ra = {}, ia = {};
#pragma unroll
          for (int ks = 0; ks < 8; ++ks) { const s16x8 a = *(const LAS s16x8*)(XC + (32 * tt + c) * PB + (16 * ks + 8 * hi) * 2); ra = MFMA32(a, wfa[ks], ra); ia = MFMA32(a, wfx[ks], ia); }
#pragma unroll
          for (int r = 0; r < 16; ++r) { const int tl = 32 * tt + crow(r, hi);
              const float rg = fsig(ra[r] + bae), ig = fsig(ia[r] + bxe);
              const float la2 = -16.0f * rg * spe;
              const float a = __builtin_amdgcn_exp2f(0.7213475204444817f * la2);
              const float em = (la2 > -0.05f) ? -la2 * (1.0f + la2 * (0.5f + la2 * (0.16666667f + la2 * 0.041666668f))) : 1.0f - a * a;
              const float x = bf2f(*(const LAS bf16*)(XC + tl * PB + e * 2));
              AL[tl * 128 + e] = a; BL[tl * 128 + e] = __builtin_amdgcn_sqrtf(fmaxf(em, 0.f)) * (ig * x); } }
        __syncthreads();
        { float As = 1.f, Bs = 0.f;
#pragma unroll
          for (int r = 0; r < 16; ++r) { const float a = AL[(16 * seg + r) * 128 + ch], bb = BL[(16 * seg + r) * 128 + ch]; Bs = a * Bs + bb; As *= a; }
          SEGA[seg * 128 + ch] = As; SEGB[seg * 128 + ch] = Bs; }
#pragma unroll
        for (int rep = 0; rep < 2; ++rep) { const int idx = tid + 512 * rep, r = idx >> 4, o = idx & 15; *(LAS v4u*)(RAW + (((t0 + 64 + r) & 127)) * 256 + o * 16) = pre[rep]; }
        __syncthreads();
        { float hs = CAR[(k & 1) * 128 + ch];
#pragma unroll
          for (int s = 0; s < 3; ++s) if (s < seg) hs = SEGA[s * 128 + ch] * hs + SEGB[s * 128 + ch];
#pragma unroll
          for (int r = 0; r < 16; ++r) { const float a = AL[(16 * seg + r) * 128 + ch], bb = BL[(16 * seg + r) * 128 + ch]; hs = a * hs + bb;
              const float y = (r & 1) ? bhi(yv[r >> 1]) : blo(yv[r >> 1]); const float u = 0.7978845608028654f * (y + 0.044715f * y * y * y);
              const float th = 1.0f - 2.0f * __builtin_amdgcn_rcpf(1.0f + __builtin_amdgcn_exp2f(2.885390081777927f * u));
              MIX[blk_off(b * SEQ + t0 + 16 * seg + r, 1024 + n * 128 + ch, DM)] = (bf16)f2bf(hs * 0.5f * y * (1.0f + th)); }
          if (seg == 3) CAR[((k + 1) & 1) * 128 + ch] = hs; }
    }
}
#undef MFMA32
}
__device__ __forceinline__ void drain_conv_queue(Frame& F, const Args& A, int ctr_word, int lo, int hi) {
    unsigned* ctr = (unsigned*)(F.ws + WS_CTL) + ctr_word; LAS unsigned* slot = (LAS unsigned*)(F.lds + 8 * 17408); LAS unsigned char* scr = F.lds + F.wave * 17408;
    for (;;) { __syncthreads();
        if (F.tid == 0) *slot = __hip_atomic_fetch_add(ctr, 8u, __ATOMIC_RELAXED, __HIP_MEMORY_SCOPE_AGENT);
        __syncthreads();
        const int base = lo + (int)*slot; if (base >= hi) break;
        const int it = base + F.wave; if (it < hi) conv_l1_item(F, A, it, scr); }
}
__device__ __forceinline__ void ph_mixer0(Frame& F, const Args& A) {
#if MIXER0 == 3
    for (int u = F.vcu; u < 128; u += F.G) { __syncthreads(); ret_naive_unit(F, A, u >> 3, u & 7); }
#else
#if PROBE_DUP == 21
    for (int rep_ = 0; rep_ < 2; ++rep_)
#endif
    for (int u = F.vcu; u < 128; u += F.G) { __syncthreads(); mx::ret_unit(F, A, u >> 3, u & 7); }
#endif
#if MIXER0 == 2
    for (int u = F.vcu; u < 256; u += F.G) { if (u < 128) continue; __syncthreads(); lru_naive_unit(F, A, (u - 128) >> 3, (u - 128) & 7); }
#else
#if PROBE_DUP == 22
    for (int rep_ = 0; rep_ < 2; ++rep_)
#endif
    for (int u = F.vcu; u < 256; u += F.G) { if (u < 128) continue; __syncthreads(); mx::lru_unit(F, A, (u - 128) >> 3, (u - 128) & 7); }
#endif
#if DEFER_L1
    drain_conv_queue(F, A, 2048, L1_I0 + L1_I1, L1_I0 + L1_I1);
#endif
}
__device__ __forceinline__ void ph_act_naive(Frame& F, const bf16* GUB, bf16* ACT, const float* cw, const float* cb, int Mh) {
    const int gt = F.vcu * NTHR + F.tid, NT = F.G * NTHR; const int nrb = Mh / 32;
    for (int it = gt; it < nrb * 704; it += NT) {
        const int oct = it % 704, rb = it / 704, c0 = oct * 8, gcol = (c0 >> 7) * 256 + (c0 & 127);
        float w0[8], w1[8], w2[8], bb[8];
#pragma unroll
        for (int k = 0; k < 8; ++k) { w0[k] = cw[c0 + k]; w1[k] = cw[DFF + c0 + k]; w2[k] = cw[2 * DFF + c0 + k]; bb[k] = cb[c0 + k]; }
        const int r0 = rb * 32; const bool first = (r0 % SEQ) == 0;
        float g1[8], g2[8];
        { v4u a = (v4u){0u, 0u, 0u, 0u}, c = a; if (!first) { a = *(const v4u*)(GUB + (size_t)(r0 - 2) * GUW + gcol); c = *(const v4u*)(GUB + (size_t)(r0 - 1) * GUW + gcol); }
#pragma unroll
          for (int k = 0; k < 4; ++k) { g2[2 * k] = __uint_as_float(a[k] << 16); g2[2 * k + 1] = __uint_as_float(a[k] & 0xffff0000u); g1[2 * k] = __uint_as_float(c[k] << 16); g1[2 * k + 1] = __uint_as_float(c[k] & 0xffff0000u); } }
        for (int r = r0; r < r0 + 32; ++r) {
            const v4u gv = *(const v4u*)(GUB + (size_t)r * GUW + gcol), uv = *(const v4u*)(GUB + (size_t)r * GUW + gcol + 128);
            float g[8], u[8], o[8];
#pragma unroll
            for (int k = 0; k < 4; ++k) { g[2 * k] = __uint_as_float(gv[k] << 16); g[2 * k + 1] = __uint_as_float(gv[k] & 0xffff0000u); u[2 * k] = __uint_as_float(uv[k] << 16); u[2 * k + 1] = __uint_as_float(uv[k] & 0xffff0000u); }
#pragma unroll
            for (int k = 0; k < 8; ++k) { const float v = bb[k] + w0[k] * g2[k] + w1[k] * g1[k] + w2[k] * g[k]; o[k] = siluf_(v) * u[k]; g2[k] = g1[k]; g1[k] = g[k]; }
            v4u ov; ov.x = pk2(o[0], o[1]); ov.y = pk2(o[2], o[3]); ov.z = pk2(o[4], o[5]); ov.w = pk2(o[6], o[7]);
            *(v4u*)(ACT + (size_t)r * DFF + c0) = ov;
        }
    }
}
__device__ __forceinline__ unsigned ord_key(float f) { const unsigned u = __float_as_uint(f); return u ^ ((unsigned)((int)u >> 31) | 0x80000000u); }
__device__ __forceinline__ void ph_dsa_naive(Frame& F) {
    LAS float* qil = (LAS float*)(F.lds);
    LAS float* wl = (LAS float*)(F.lds + 4096);
    LAS float* ql = (LAS float*)(F.lds + 8192);
    LAS unsigned* sc = (LAS unsigned*)(F.lds + 16384);
    LAS int* idxl = (LAS int*)(F.lds + 24576);
    LAS float* pl = (LAS float*)(F.lds + 25600);
    LAS float* red = (LAS float*)(F.lds + 26624);
    LAS int* cntl = (LAS int*)(F.lds + 26752);
    LAS int* wtot = (LAS int*)(F.lds + 26880);
    LAS float* op = (LAS float*)(F.lds + 28672);
    const bf16* P1 = (const bf16*)(F.ws + WS_PROJ); bf16* ATT = (bf16*)(F.ws + WS_H); const float* tb = (const float*)(F.ws + WS_TB);
    const int tid = F.tid, lane = F.lane, wave = F.wave;
    for (int unit = F.vcu; unit < MTOK; unit += F.G) {
        const int b = unit >> 11, t = unit & 2047; const bf16* P = P1 + (size_t)unit * O_INP;
        for (int i = tid; i < 1024; i += NTHR) qil[i] = bf2f(P[C1_QI + i]);
        if (tid < 16) wl[tid] = bf2f(P[C1_WI + tid]) * 0.03125f;
        for (int i = tid; i < 2048; i += NTHR) ql[i] = bf2f(P[C1_Q + i]);
        __syncthreads();
        bool sel[4];
        if (t >= 256) {
#pragma unroll 1
            for (int j = 0; j < 4; ++j) { const int s = tid + 512 * j; unsigned key = 0u;
                if (s <= t) { const v4u* kp = (const v4u*)(P1 + (size_t)(b * SEQ + s) * O_INP + C1_KI); float kv[64];
#pragma unroll
                    for (int q = 0; q < 8; ++q) { const v4u w = kp[q];
#pragma unroll
                        for (int k = 0; k < 4; ++k) { kv[8 * q + 2 * k] = __uint_as_float(w[k] << 16); kv[8 * q + 2 * k + 1] = __uint_as_float(w[k] & 0xffff0000u); } }
                    float score = 0.f;
#pragma unroll 1
                    for (int h = 0; h < 16; ++h) { float d = 0.f;
#pragma unroll
                        for (int q = 0; q < 16; ++q) { const f32x4 a = *(const LAS f32x4*)(qil + h * 64 + 4 * q); d += a.x * kv[4 * q] + a.y * kv[4 * q + 1] + a.z * kv[4 * q + 2] + a.w * kv[4 * q + 3]; }
                        score += wl[h] * fmaxf(d, 0.f); }
                    key = ord_key(score); }
                sc[s] = key; }
            __syncthreads();
            const unsigned k0 = sc[tid], k1 = sc[tid + 512], k2 = sc[tid + 1024], k3 = sc[tid + 1536];
            unsigned T = 0u;
#pragma unroll 1
            for (int bit = 31; bit >= 0; --bit) { const unsigned cand = T | (1u << bit);
                int c = (k0 >= cand) + (k1 >= cand) + (k2 >= cand) + (k3 >= cand); c = wave_sum_i(c);
                if (lane == 0) cntl[(bit & 1) * 8 + wave] = c;
                __syncthreads();
                int tot = 0;
#pragma unroll
                for (int w = 0; w < 8; ++w) tot += cntl[(bit & 1) * 8 + w];
                if (tot >= 256) T = cand; }
            int cg = (k0 > T) + (k1 > T) + (k2 > T) + (k3 > T), ce = (k0 == T) + (k1 == T) + (k2 == T) + (k3 == T);
            cg = wave_sum_i(cg); ce = wave_sum_i(ce);
            __syncthreads();
            if (lane == 0) { cntl[wave] = cg; cntl[8 + wave] = ce; }
            __syncthreads();
            int ngt = 0, neq = 0;
#pragma unroll
            for (int w = 0; w < 8; ++w) { ngt += cntl[w]; neq += cntl[8 + w]; }
            const int need = 256 - ngt;
            if (neq > need) {
                if (tid == 0) { int taken = 0; for (int s = 0; s <= t; ++s) if (sc[s] == T) { if (taken < need) ++taken; else sc[s] = 0u; } }
                __syncthreads();
            }
#pragma unroll
            for (int j = 0; j < 4; ++j) { const int s = tid + 512 * j; sel[j] = (s <= t) && (sc[s] >= T); }
        } else {
#pragma unroll
            for (int j = 0; j < 4; ++j) sel[j] = (tid + 512 * j) <= t;
        }
        int pre[4];
#pragma unroll
        for (int j = 0; j < 4; ++j) { const unsigned long long bal = __ballot(sel[j]); pre[j] = __popcll(bal & ((1ull << lane) - 1ull)); if (lane == 0) wtot[j * 8 + wave] = __popcll(bal); }
        __syncthreads();
        int nsel = 0;
        { int run = 0; int base[4];
#pragma unroll
          for (int j = 0; j < 4; ++j) {
#pragma unroll
              for (int w = 0; w < 8; ++w) { if (w == wave) base[j] = run; run += wtot[j * 8 + w]; } }
          nsel = run;
#pragma unroll
          for (int j = 0; j < 4; ++j) if (sel[j]) idxl[base[j] + pre[j]] = tid + 512 * j; }
        __syncthreads();
        for (int hq = 0; hq < 16; ++hq) { const int kvh = hq >> 2;
            float logit = -INFINITY;
            if (tid < nsel) { const int s = idxl[tid]; const v4u* kp = (const v4u*)(P1 + (size_t)(b * SEQ + s) * O_INP + C1_K + kvh * 128); float d = 0.f;
#pragma unroll
                for (int q = 0; q < 16; ++q) { const v4u w = kp[q]; const f32x4 a0 = *(const LAS f32x4*)(ql + hq * 128 + 8 * q), a1 = *(const LAS f32x4*)(ql + hq * 128 + 8 * q + 4);
                    d += a0.x * __uint_as_float(w.x << 16) + a0.y * __uint_as_float(w.x & 0xffff0000u) + a0.z * __uint_as_float(w.y << 16) + a0.w * __uint_as_float(w.y & 0xffff0000u)
                       + a1.x * __uint_as_float(w.z << 16) + a1.y * __uint_as_float(w.z & 0xffff0000u) + a1.z * __uint_as_float(w.w << 16) + a1.w * __uint_as_float(w.w & 0xffff0000u); }
                const int dist = t - s; logit = d * 0.08838834764831845f + tb[(dist < 127 ? dist : 127) * 16 + hq]; }
            float mx = wave_max(logit); if (lane == 0) red[wave] = mx;
            __syncthreads();
            mx = fmaxf(fmaxf(fmaxf(red[0], red[1]), fmaxf(red[2], red[3])), fmaxf(fmaxf(red[4], red[5]), fmaxf(red[6], red[7])));
            const float p = (tid < nsel) ? __expf(logit - mx) : 0.f;
            if (tid < 256) pl[tid] = p;
            float sm = wave_sum(p); if (lane == 0) red[8 + wave] = sm;
            __syncthreads();
            sm = ((red[8] + red[9]) + (red[10] + red[11])) + ((red[12] + red[13]) + (red[14] + red[15]));
            { const int d = tid & 127, part = tid >> 7; float a = 0.f; const int j1 = (part * 64 + 64) < nsel ? (part * 64 + 64) : nsel;
              for (int j = part * 64; j < j1; ++j) a += pl[j] * bf2f(P1[(size_t)(b * SEQ + idxl[j]) * O_INP + C1_V + kvh * 128 + d]);
              op[part * 128 + d] = a; }
            __syncthreads();
            if (tid < 128) ATT[(size_t)unit * DM + hq * 128 + tid] = (bf16)f2bf(((op[tid] + op[128 + tid]) + (op[256 + tid] + op[384 + tid])) / sm);
            __syncthreads();
        }
    }
}

typedef float f32x16 __attribute__((ext_vector_type(16)));
typedef short s16x8 __attribute__((ext_vector_type(8)));
typedef short s16x4 __attribute__((ext_vector_type(4)));
constexpr int IDX_ROWB = 144;
constexpr int IDX_CHUNK = 256 * IDX_ROWB;
__device__ __forceinline__ int half_sum_i(int v) {
#pragma unroll
    for (int o = 1; o < 32; o <<= 1) v += __shfl_xor(v, o);
    return v;
}
__device__ __forceinline__ void half_sums(int v, int& s0, int& s1) {
    v += __builtin_amdgcn_update_dpp(0, v, 0x111, 0xf, 0xf, true);
    v += __builtin_amdgcn_update_dpp(0, v, 0x112, 0xf, 0xf, true);
    v += __builtin_amdgcn_update_dpp(0, v, 0x114, 0xf, 0xf, true);
    v += __builtin_amdgcn_update_dpp(0, v, 0x118, 0xf, 0xf, true);
    s0 = __builtin_amdgcn_readlane(v, 15) + __builtin_amdgcn_readlane(v, 31); s1 = __builtin_amdgcn_readlane(v, 47) + __builtin_amdgcn_readlane(v, 63);
}
typedef unsigned short us2 __attribute__((ext_vector_type(2)));
__device__ __forceinline__ void ph_indexer(Frame& F) {
    const bf16* P1 = (const bf16*)(F.ws + WS_PROJ); unsigned* SEL = (unsigned*)(F.ws + WS_SEL);
    const int wave = F.wave;
    LAS unsigned char* kl = F.lds;
    bool pref = false;
    for (int u = F.vcu; u < 2048; u += F.G) {
        const int it = u >> 8, cc = u & 255, tg0 = cc & 127, tg = (it & 1) ? 127 - tg0 : tg0, b = (cc >> 7) + 2 * it;
        int tid = F.tid; asm volatile("" : "+v"(tid));
        const int lane = tid & 63, c = lane & 31, hh = lane >> 5;
        const int t0 = tg * 16, tq = t0 + 2 * wave + hh;
        unsigned* selb = SEL + (size_t)b * 32 * SEQ * 2; const int tw0 = t0 + 2 * wave;
        if (t0 < 256) {
#pragma unroll
            for (int q = 0; q < 2; ++q) { const int t = tw0 + q, lo = 32 * lane;
                selb[((size_t)(lane >> 1) * SEQ + t) * 2 + (lane & 1)] = (t >= lo + 31) ? 0xffffffffu : (t < lo ? 0u : ((2u << (t - lo)) - 1u)); }
            pref = false; continue;
        }
        LAS unsigned char* pf = kl + 2 * IDX_CHUNK + 4096 + 8192 + wave * 6144;
#define PF_DMA(bb, tt0) do { const int qrw_ = (bb) * SEQ + (tt0) + 2 * wave + ((c >> 2) & 1), qcl_ = C1_QI + ((c & 3) + 4 * (c >> 3)) * 64 + 8 * hh; \
            _Pragma("unroll") for (int ks = 0; ks < 4; ++ks) __builtin_amdgcn_global_load_lds((const unsigned*)(P1 + blk_off(qrw_, qcl_ + 16 * ks, O_INP)), (LAS unsigned*)(pf + ks * 1024), 16, 0, 0); \
            const bf16* wp_ = P1 + blk_off((bb) * SEQ + (tt0) + 2 * wave + hh, C1_WI, O_INP); \
            __builtin_amdgcn_global_load_lds((const unsigned*)wp_, (LAS unsigned*)(pf + 4096), 16, 0, 0); __builtin_amdgcn_global_load_lds((const unsigned*)(wp_ + 8), (LAS unsigned*)(pf + 5120), 16, 0, 0); } while (0)
        const int nch = (t0 + 15) / 256 + 1;
        const bf16* kib = P1 + (size_t)(b * SEQ) * O_INP + C1_KI;
        if (!pref) __syncthreads();
#define IDX_DMA_B(b, chunk, buf) do { _Pragma("unroll") for (int n_ = 0; n_ < 5; ++n_) { const int n = wave + 8 * n_; if (n < 36) { const int q = 64 * n + lane, row = q / 9, sg0 = q - 9 * row, sg = sg0 < 8 ? sg0 : 7; \
            __builtin_amdgcn_global_load_lds((const unsigned*)(P1 + blk_off(b * SEQ + (chunk) * 256 + row, C1_KI + sg * 8, O_INP)), (LAS unsigned*)(kl + (buf) * IDX_CHUNK + n * 1024), 16, 0, 0); } } } while (0)
#define IDX_DMA(chunk, buf) IDX_DMA_B(b, chunk, buf)
        if (!pref) { IDX_DMA(0, 0); PF_DMA(b, t0); }
        __syncthreads();
        s16x8 Afr[4];
#pragma unroll
        for (int ks = 0; ks < 4; ++ks) Afr[ks] = *(const LAS s16x8*)(pf + ks * 1024 + lane * 16);
        const v4u w0 = *(const LAS v4u*)(pf + 4096 + lane * 16), w1 = *(const LAS v4u*)(pf + 5120 + lane * 16);
        float wv[16];
        {
#pragma unroll
          for (int k = 0; k < 4; ++k) { wv[2 * k] = __uint_as_float(w0[k] << 16) * 0.03125f; wv[2 * k + 1] = __uint_as_float(w0[k] & 0xffff0000u) * 0.03125f;
              wv[8 + 2 * k] = __uint_as_float(w1[k] << 16) * 0.03125f; wv[8 + 2 * k + 1] = __uint_as_float(w1[k] & 0xffff0000u) * 0.03125f; } }
        unsigned key[64];
#pragma unroll
        for (int ch = 0; ch < 8; ++ch) {
            if (ch < nch) {
                if (ch < 7) IDX_DMA(ch + 1, (ch + 1) & 1);
                const LAS unsigned char* kb = kl + (ch & 1) * IDX_CHUNK;
#pragma unroll
                for (int tp = 0; tp < 4; ++tp) { const int tl = 2 * tp, T = ch * 8 + tl;
                    if (32 * (T + 1) <= t0 + 15) {
                        f32x16 acc = {0.f, 0.f, 0.f, 0.f, 0.f, 0.f, 0.f, 0.f, 0.f, 0.f, 0.f, 0.f, 0.f, 0.f, 0.f, 0.f}, acd = acc;
#pragma unroll
                        for (int ks = 0; ks < 4; ++ks) { const s16x8 Bfr = *(const LAS s16x8*)(kb + (tl * 32 + c) * IDX_ROWB + ks * 32 + hh * 16), Bfs = *(const LAS s16x8*)(kb + (tl * 32 + 32 + c) * IDX_ROWB + ks * 32 + hh * 16);
                            acc = __builtin_amdgcn_mfma_f32_32x32x16_bf16(Afr[ks], Bfr, acc, 0, 0, 0); acd = __builtin_amdgcn_mfma_f32_32x32x16_bf16(Afr[ks], Bfs, acd, 0, 0, 0); }
                        float sc = 0.f, sd = 0.f;
#pragma unroll
                        for (int i = 0; i < 16; ++i) { const int rb = (int)__float_as_uint(acc[i]), rd = (int)__float_as_uint(acd[i]);
                            sc = fmaf(wv[i], __uint_as_float((unsigned)(rb > 0 ? rb : 0)), sc); sd = fmaf(wv[i], __uint_as_float((unsigned)(rd > 0 ? rd : 0)), sd); }
                        key[T] = (32 * T + c <= tq) ? ord_key(sc) : 0u; key[T + 1] = (32 * T + 32 + c <= tq) ? ord_key(sd) : 0u;
                        __builtin_amdgcn_sched_barrier(0);
                    } else if (32 * T <= t0 + 15) {
                        f32x16 acc = {0.f, 0.f, 0.f, 0.f, 0.f, 0.f, 0.f, 0.f, 0.f, 0.f, 0.f, 0.f, 0.f, 0.f, 0.f, 0.f};
#pragma unroll
                        for (int ks = 0; ks < 4; ++ks) { const s16x8 Bfr = *(const LAS s16x8*)(kb + (tl * 32 + c) * IDX_ROWB + ks * 32 + hh * 16);
                            acc = __builtin_amdgcn_mfma_f32_32x32x16_bf16(Afr[ks], Bfr, acc, 0, 0, 0); }
                        float sc = 0.f;
#pragma unroll
                        for (int i = 0; i < 16; ++i) { const int rb = (int)__float_as_uint(acc[i]); sc = fmaf(wv[i], __uint_as_float((unsigned)(rb > 0 ? rb : 0)), sc); }
                        key[T] = (32 * T + c <= tq) ? ord_key(sc) : 0u; key[T + 1] = 0u;
                        __builtin_amdgcn_sched_barrier(0);
                    } else { key[T] = 0u; key[T + 1] = 0u; }
                }
                __syncthreads();
            } else {
#pragma unroll
                for (int tl = 0; tl < 8; ++tl) key[ch * 8 + tl] = 0u;
            }
        }
        { const int un = u + F.G; pref = false;
          if (un < 2048) { const int itn = un >> 8, ccn = un & 255, tg0n = ccn & 127, tgn = (itn & 1) ? 127 - tg0n : tg0n, bn = (ccn >> 7) + 2 * itn;
              if (tgn * 16 >= 256) { IDX_DMA_B(bn, 0, 0); PF_DMA(bn, tgn * 16); pref = true; } } }
#undef PF_DMA
#undef IDX_DMA
#undef IDX_DMA_B
        unsigned T0 = 0u, T1 = 0u; int A0 = 1 << 20, A1 = 1 << 20;
        bool compact = false; int G0 = 0, G1 = 0; unsigned cs0 = 0u, cs1 = 0u, cs2 = 0u, cs3 = 0u;
        unsigned hp[32];
#pragma unroll
        for (int j = 0; j < 32; ++j) hp[j] = __builtin_amdgcn_perm(key[2 * j + 1], key[2 * j], 0x07060302u);
#pragma unroll 1
        for (int bit = 31; bit >= 0; --bit) {
            if (bit == 15) { const unsigned Th = (hh ? T1 : T0) >> 16; LAS unsigned* cs = (LAS unsigned*)(kl + 2 * IDX_CHUNK + 4096 + wave * 1024) + lane; int n = 0;
#pragma unroll
                for (int g8 = 0; g8 < 8; ++g8) if (g8 < nch) {
#pragma unroll
                    for (int i = 0; i < 8; ++i) { const unsigned kv = key[g8 * 8 + i]; if ((kv >> 16) == Th) { if (n < 4) cs[n * 64] = (kv & 0xffffu) + 1u; ++n; } } }
                int q0, q1; half_sums(n, q0, q1);
                if (!__any(n > 4)) { compact = true; G0 = A0 - q0; G1 = A1 - q1;
                    asm volatile("s_waitcnt lgkmcnt(0)" ::: "memory");
                    const unsigned r0 = cs[0], r1 = cs[64], r2 = cs[128], r3 = cs[192]; cs0 = n > 0 ? r0 : 0u; cs1 = n > 1 ? r1 : 0u; cs2 = n > 2 ? r2 : 0u; cs3 = n > 3 ? r3 : 0u; } }
            const unsigned c0 = T0 | (1u << bit), c1 = T1 | (1u << bit), cand = hh ? c1 : c0; int cnt = 0;
            if (bit >= 16) {
                const unsigned cm = (cand >> 16) - 1u, pr = cm | (cm << 16), one2 = 0x00010001u; unsigned accp = 0u;
#pragma unroll
                for (int g8 = 0; g8 < 8; ++g8) if (g8 < nch) {
#pragma unroll
                    for (int i = 0; i < 4; ++i) { unsigned d_, f_; asm("v_pk_sub_u16 %0, %1, %2 clamp" : "=v"(d_) : "v"(hp[g8 * 4 + i]), "v"(pr)); asm("v_pk_min_u16 %0, %1, %2" : "=v"(f_) : "v"(d_), "v"(one2));
                        asm("v_pk_add_u16 %0, %1, %2" : "=v"(accp) : "v"(accp), "v"(f_)); } }
                cnt = (int)((accp & 0xffffu) + (accp >> 16));
            } else if (compact) { const unsigned cl = (cand & 0xffffu) + 1u;
                cnt = (cs0 >= cl ? 1 : 0) + (cs1 >= cl ? 1 : 0) + (cs2 >= cl ? 1 : 0) + (cs3 >= cl ? 1 : 0);
            } else {
#pragma unroll
            for (int g8 = 0; g8 < 8; ++g8) if (g8 < nch) {
#pragma unroll
                for (int i = 0; i < 8; ++i) cnt += (key[g8 * 8 + i] >= cand) ? 1 : 0; }
            }
            int n0, n1; half_sums(cnt, n0, n1); if (compact) { n0 += G0; n1 += G1; }
            if (n0 >= 256) { T0 = c0; A0 = n0; } if (n1 >= 256) { T1 = c1; A1 = n1; }
            if (n0 == 256 && n1 == 256) break; }
        const unsigned Tm = hh ? T1 : T0;
        LAS unsigned long long* selw = (LAS unsigned long long*)(kl + 2 * IDX_CHUNK + wave * 512);
        if (A0 == 256 && A1 == 256) {
#pragma unroll
            for (int i = 0; i < 64; ++i) { const unsigned long long bs = ((i >> 3) < nch) ? __ballot(key[i] >= Tm) : 0ull; if (lane == 0) selw[i] = bs; }
        } else {
        int cg = 0;
#pragma unroll
        for (int g8 = 0; g8 < 8; ++g8) if (g8 < nch) {
#pragma unroll
            for (int i = 0; i < 8; ++i) cg += (key[g8 * 8 + i] > Tm) ? 1 : 0; }
        int g0, g1; half_sums(cg, g0, g1);
        const int need = 256 - (hh ? g1 : g0);
        int run = 0;
#pragma unroll
        for (int i = 0; i < 64; ++i) { if ((i >> 3) >= nch) { if (lane == 0) selw[i] = 0ull; continue; }
            const bool gt = key[i] > Tm, eq = key[i] == Tm;
            const unsigned long long beq = __ballot(eq); const unsigned meq = hh ? (unsigned)(beq >> 32) : (unsigned)beq;
            const int rank = __popc(meq & ((1u << c) - 1u));
            const bool sl = gt || (eq && (run + rank < need));
            run += __popc(meq);
            const unsigned long long bs = __ballot(sl);
            if (lane == 0) selw[i] = bs; }
        }
        asm volatile("s_waitcnt lgkmcnt(0)" ::: "memory");
        unsigned wlo, whi;
        { const unsigned long long mine = selw[lane]; wlo = (unsigned)mine; whi = (unsigned)(mine >> 32); }
        selb[((size_t)(lane >> 1) * SEQ + tw0) * 2 + (lane & 1)] = wlo; selb[((size_t)(lane >> 1) * SEQ + tw0 + 1) * 2 + (lane & 1)] = whi;
    }
}

namespace att {
constexpr int D = 128, NW = 8, QBLK = 32, KVBLK = 64, LD = O_INP;
constexpr float SCALE = 0.088388347648318440f, THR = 8.f;
constexpr int SHM_V = KVBLK * D * 2, SHM_K = KVBLK * D * 2;
constexpr int OFF_Q = 2 * SHM_V + 2 * SHM_K, OFF_WS = OFF_Q + 65536, OFF_TB = OFF_WS + NW * 64 * 4;
#define KSWZ(row, colB) ((row) * 256 + ((colB) ^ (((row) & 7) << 4)))
#define SBAR() __builtin_amdgcn_sched_barrier(0)
__device__ __forceinline__ int crow(int r, int hi) { return (r & 3) + 8 * (r >> 2) + 4 * hi; }
__device__ __forceinline__ unsigned cvtpk(float lo, float hi) { unsigned r; asm volatile("v_cvt_pk_bf16_f32 %0, %1, %2" : "=v"(r) : "v"(lo), "v"(hi)); return r; }
__device__ __forceinline__ void partialSM(f32x16& p0, f32x16& p1, float& m_reg, float& mn, float& alpha, bool far, float bfar, const LAS float* tbq, int dbase) {
    constexpr float C = SCALE * 1.4426950408889634f;
    float boff = bfar;
    if (!far) { boff = 0.f;
#pragma unroll
        for (int r = 0; r < 16; ++r) { const int cbr = (r & 3) + 8 * (r >> 2);
            p0[r] += tbq[59 - cbr]; p1[r] += tbq[27 - cbr]; }
    }
    float pmax = p0[0];
#pragma unroll
    for (int r = 1; r < 16; ++r) pmax = fmaxf(pmax, p0[r]);
#pragma unroll
    for (int r = 0; r < 16; ++r) pmax = fmaxf(pmax, p1[r]);
    { auto rr = __builtin_amdgcn_permlane32_swap(__float_as_uint(pmax), __float_as_uint(pmax), false, false);
      pmax = fmaxf(__uint_as_float(rr[0]), __uint_as_float(rr[1])) + boff; }
    if (__builtin_expect(__all(pmax - m_reg <= THR / SCALE), 1)) { mn = m_reg; alpha = 1.f; }
    else { mn = fmaxf(m_reg, pmax); alpha = __builtin_amdgcn_exp2f((m_reg - mn) * C); m_reg = mn; }
    const float mnC = (boff - mn) * C;
#pragma unroll
    for (int r = 0; r < 16; ++r) p0[r] = fmaf(p0[r], C, mnC);
#pragma unroll
    for (int r = 0; r < 16; ++r) p1[r] = fmaf(p1[r], C, mnC);
#pragma unroll
    for (int r = 0; r < 16; ++r) p0[r] = __builtin_amdgcn_exp2f(p0[r]);
}
template <int R> __device__ __forceinline__ void mask1(f32x16& p0, f32x16& p1, unsigned m0, unsigned m1) {
    constexpr int cb = (R & 3) + 8 * (R >> 2); int t0, t1;
    asm("v_bfe_i32 %0, %1, %2, 1" : "=v"(t0) : "v"(m0), "n"(cb));
    asm("v_bfe_i32 %0, %1, %2, 1" : "=v"(t1) : "v"(m1), "n"(cb));
    p0[R] = __uint_as_float(__float_as_uint(p0[R]) & (unsigned)t0); p1[R] = __uint_as_float(__float_as_uint(p1[R]) & (unsigned)t1);
}
__device__ __forceinline__ void mask16(f32x16& p0, f32x16& p1, unsigned m0, unsigned m1) {
    mask1<0>(p0, p1, m0, m1); mask1<1>(p0, p1, m0, m1); mask1<2>(p0, p1, m0, m1); mask1<3>(p0, p1, m0, m1); mask1<4>(p0, p1, m0, m1); mask1<5>(p0, p1, m0, m1); mask1<6>(p0, p1, m0, m1); mask1<7>(p0, p1, m0, m1);
    mask1<8>(p0, p1, m0, m1); mask1<9>(p0, p1, m0, m1); mask1<10>(p0, p1, m0, m1); mask1<11>(p0, p1, m0, m1); mask1<12>(p0, p1, m0, m1); mask1<13>(p0, p1, m0, m1); mask1<14>(p0, p1, m0, m1); mask1<15>(p0, p1, m0, m1);
}
__device__ __forceinline__ void finishSM(f32x16& p0, f32x16& p1, float alpha, float& l_reg, unsigned m0, unsigned m1, s16x8& pa0, s16x8& pa1, s16x8& pa2, s16x8& pa3) {
#pragma unroll
    for (int r = 0; r < 16; ++r) p1[r] = __builtin_amdgcn_exp2f(p1[r]);
    mask16(p0, p1, m0, m1);
    float ps = 0.f;
#pragma unroll
    for (int r = 0; r < 16; ++r) ps += p0[r];
#pragma unroll
    for (int r = 0; r < 16; ++r) ps += p1[r];
    { auto rr = __builtin_amdgcn_permlane32_swap(__float_as_uint(ps), __float_as_uint(ps), false, false);
      ps = __uint_as_float(rr[0]) + __uint_as_float(rr[1]); }
    l_reg = l_reg * alpha + ps;
#define PK4(P, BASE, OUT) do { unsigned a0 = cvtpk(P[BASE + 0], P[BASE + 1]), a1 = cvtpk(P[BASE + 2], P[BASE + 3]);   \
    unsigned b0 = cvtpk(P[BASE + 4], P[BASE + 5]), b1 = cvtpk(P[BASE + 6], P[BASE + 7]);                              \
    auto r0 = __builtin_amdgcn_permlane32_swap(a0, b0, false, false); auto r1 = __builtin_amdgcn_permlane32_swap(a1, b1, false, false); \
    v4u w = {r0[0], r1[0], r0[1], r1[1]}; OUT = *reinterpret_cast<s16x8*>(&w); } while (0)
    PK4(p0, 0, pa0); PK4(p0, 8, pa1); PK4(p1, 0, pa2); PK4(p1, 8, pa3);
#undef PK4
}
__device__ __forceinline__ void qkt(f32x16& p0, f32x16& p1, const int (&ka)[4], const int (&qa)[4], int koff) {
    p0 = f32x16{}; p1 = f32x16{};
#pragma unroll
    for (int d0 = 0; d0 < 8; ++d0) {
        const LAS unsigned char* kp = (const LAS unsigned char*)(size_t)(unsigned)ka[d0 & 3] + koff + (d0 >> 2) * 128;
        const LAS unsigned char* qp = (const LAS unsigned char*)(size_t)(unsigned)qa[d0 & 3] + (d0 >> 2) * 128;
        const s16x8 b0 = *(const LAS s16x8*)(kp);
        const s16x8 b1 = *(const LAS s16x8*)(kp + 8192);
        const s16x8 q = *(const LAS s16x8*)(qp);
        p0 = __builtin_amdgcn_mfma_f32_32x32x16_bf16(b0, q, p0, 0, 0, 0);
        p1 = __builtin_amdgcn_mfma_f32_32x32x16_bf16(b1, q, p1, 0, 0, 0); }
}
__device__ __forceinline__ int v_st(int k, int c) { const int kk = (k & ~0xC) | ((k & 4) << 1) | ((k & 8) >> 1); return ((kk >> 3) * 4 + (c >> 5)) * 512 + ((kk & 7) * 32 + (c & 31)) * 2; }
__device__ __forceinline__ int v_rd_base(int lane) { return ((lane & 3) << 3) | (((lane >> 2) & 3) << 6) | (((lane >> 4) & 1) << 5) | (((lane >> 5) & 1) << 8); }
constexpr int v_rd_off(int d0, int ks, int half) { return d0 * 512 + ks * 4096 + half * 2048; }
template <int OFF> __device__ __forceinline__ s16x4 tr_read(int vb) {
    s16x4 r; asm volatile("ds_read_b64_tr_b16 %0, %1 offset:%2" : "=&v"(r) : "v"(vb), "i"(OFF) : "memory"); return r;
}
template <int D0> __device__ __forceinline__ void pv_one(f32x16& od, int vb, s16x8 pa0, s16x8 pa1, s16x8 pa2, s16x8 pa3) {
    const s16x4 l0 = tr_read<v_rd_off(D0, 0, 0)>(vb), h0 = tr_read<v_rd_off(D0, 0, 1)>(vb), l1 = tr_read<v_rd_off(D0, 1, 0)>(vb), h1 = tr_read<v_rd_off(D0, 1, 1)>(vb);
    const s16x4 l2 = tr_read<v_rd_off(D0, 2, 0)>(vb), h2 = tr_read<v_rd_off(D0, 2, 1)>(vb), l3 = tr_read<v_rd_off(D0, 3, 0)>(vb), h3 = tr_read<v_rd_off(D0, 3, 1)>(vb);
    asm volatile("s_waitcnt lgkmcnt(0)" ::: "memory"); SBAR();
#define PK(L, H) (s16x8){L[0], L[1], L[2], L[3], H[0], H[1], H[2], H[3]}
    od = __builtin_amdgcn_mfma_f32_32x32x16_bf16(pa0, PK(l0, h0), od, 0, 0, 0);
    od = __builtin_amdgcn_mfma_f32_32x32x16_bf16(pa1, PK(l1, h1), od, 0, 0, 0);
    od = __builtin_amdgcn_mfma_f32_32x32x16_bf16(pa2, PK(l2, h2), od, 0, 0, 0);
    od = __builtin_amdgcn_mfma_f32_32x32x16_bf16(pa3, PK(l3, h3), od, 0, 0, 0);
#undef PK
}
__device__ __forceinline__ void pv_d0(f32x16* o, int vb, s16x8 pa0, s16x8 pa1, s16x8 pa2, s16x8 pa3) {
    pv_one<0>(o[0], vb, pa0, pa1, pa2, pa3); pv_one<1>(o[1], vb, pa0, pa1, pa2, pa3); pv_one<2>(o[2], vb, pa0, pa1, pa2, pa3); pv_one<3>(o[3], vb, pa0, pa1, pa2, pa3);
}
__device__ __forceinline__ void attn_unit(const bf16* __restrict__ Qb, int qrow0, int qcol0, int krow0, int kcol0, int vcol0, bf16* __restrict__ Ob, int orow0, int ocol0, int NT,
                                          const unsigned* __restrict__ selq, int i0, LAS unsigned char* lds, float tbv) {
    int tid_ = threadIdx.x; asm volatile("" : "+v"(tid_));
    const int tid = tid_, wid = __builtin_amdgcn_readfirstlane(tid >> 6), lane = tid & 63, r32 = lane & 31, hi = lane >> 5;
    LAS unsigned char* V_lds = lds; LAS unsigned char* K_lds = lds + 2 * SHM_V;
    LAS float* ws = (LAS float*)(lds + OFF_WS) + wid * 64; LAS float* li_l = ws; LAS float* al_l = ws + 32;
    const LAS float* tbq = (const LAS float*)(lds + OFF_TB);
    const int tq = i0 + wid * QBLK + r32, tqmin = i0 + wid * QBLK;
    float m_reg = -1e30f, l_reg = 0.f; f32x16 o[4] = {};
    LAS unsigned char* Q_lds = lds + OFF_Q; const int qrow = wid * QBLK + r32;
    const int sr = tid >> 4, sc = (tid & 15) * 8;
    const int vb0 = (int)(unsigned)(size_t)V_lds + v_rd_base(lane);
    { const int tcQ = (int)blk_off(sr, qcol0 + sc, LD);
#pragma unroll
      for (int r = 0; r < 8; ++r) { const int row = sr + 32 * r; *(LAS s16x8*)(Q_lds + KSWZ(row, sc * 2)) = __builtin_nontemporal_load((const s16x8*)(Qb + (size_t)(qrow0 + 32 * r) * LD + tcQ)); } }
    int gK, gV;
    { const int L = tid * 16;
      { const int row = L >> 8, cb = (L & 255) ^ ((row & 7) << 4); gK = (int)blk_off(row, kcol0 + (cb >> 1), LD); }
      { const int s = L >> 9, w = (L & 511) >> 1, kk = ((s >> 2) << 3) | (w >> 5), k = (kk & ~0xC) | ((kk & 4) << 1) | ((kk & 8) >> 1), c = (s & 3) * 32 + (w & 31); gV = (int)blk_off(k, vcol0 + c, LD); } }
    const int dmaw = __builtin_amdgcn_readfirstlane(wid) * 1024;
    int ka[4], qa[4];
#pragma unroll
    for (int i = 0; i < 4; ++i) { ka[i] = (int)(unsigned)(size_t)K_lds + KSWZ(r32, i * 32 + hi * 16); qa[i] = (int)(unsigned)(size_t)Q_lds + KSWZ(qrow, i * 32 + hi * 16); }
#define KDMA(b, k0) do { const bf16* tb_ = Qb + (size_t)(krow0 + (k0)) * LD; _Pragma("unroll") for (int i_ = 0; i_ < 2; ++i_) \
    __builtin_amdgcn_global_load_lds((const unsigned*)(tb_ + (size_t)i_ * 32 * LD + gK), (LAS unsigned*)(K_lds + (b) * SHM_K + dmaw + i_ * 8192), 16, 0, 0); } while (0)
#define VDMA(b, k0) do { const bf16* tb_ = Qb + (size_t)(krow0 + (k0)) * LD; _Pragma("unroll") for (int i_ = 0; i_ < 2; ++i_) \
    __builtin_amdgcn_global_load_lds((const unsigned*)(tb_ + (size_t)i_ * 32 * LD + gV), (LAS unsigned*)(V_lds + (b) * SHM_V + dmaw + i_ * 8192), 16, 0, 0); } while (0)
#define VMW(n) asm volatile("s_waitcnt vmcnt(" #n ")" ::: "memory")
#define WGBAR() asm volatile("s_barrier" ::: "memory")
#define RESC(a) do { if (__any((a) < 1.f)) { if (hi == 0) al_l[r32] = (a); asm volatile("s_waitcnt lgkmcnt(0)" ::: "memory"); \
    _Pragma("unroll") for (int d = 0; d < 4; ++d) _Pragma("unroll") for (int r = 0; r < 16; ++r) o[d][r] *= al_l[crow(r, hi)]; } } while (0)
#define FAR(j) (64 * (j) + 63 + 113 <= tqmin)
#define DBASE(j) (tq - 64 * (j) - 4 * hi)
#define MLOAD(j) (*(const unsigned long long*)mptr)
    f32x16 pA0, pA1, pB0, pB1; float mnA, mnB, alA, alB; s16x8 pa0, pa1, pa2, pa3; const unsigned* mptr = selq; unsigned long long mwA, mwB;
#define MNEXT(mw) do { mw = *(const unsigned long long*)mptr; mptr += SEQ * 2; } while (0)
#define FIN(P0, P1, AL, MW) finishSM(P0, P1, AL, l_reg, (unsigned)(MW) >> (4 * hi), (unsigned)((MW) >> 32) >> (4 * hi), pa0, pa1, pa2, pa3)
    KDMA(0, 0); VDMA(0, 0); MNEXT(mwA); KDMA(1, KVBLK); MNEXT(mwB);
    ((LAS float*)(lds + OFF_TB))[tid] = tbv;
    VMW(0); __syncthreads();
    const float bfar = tbq[256 + 127];
    qkt(pA0, pA1, ka, qa, 0); partialSM(pA0, pA1, m_reg, mnA, alA, FAR(0), bfar, tbq + (DBASE(0) + 197), 0);
    WGBAR();
    for (int j = 1; j + 1 < NT - 2; j += 2) {
        KDMA(0, (j + 1) * KVBLK); VDMA(1, j * KVBLK);
        SBAR(); qkt(pB0, pB1, ka, qa, (int)SHM_K);
        FIN(pA0, pA1, alA, mwA); SBAR();
        MNEXT(mwA); SBAR();
        pv_d0(o, vb0, pa0, pa1, pa2, pa3); partialSM(pB0, pB1, m_reg, mnB, alB, FAR(j), bfar, tbq + (DBASE(j) + 197), 0);
        RESC(alB); VMW(0); asm volatile("" : "+v"(mwA)); WGBAR();
        KDMA(1, (j + 2) * KVBLK); VDMA(0, (j + 1) * KVBLK);
        SBAR(); qkt(pA0, pA1, ka, qa, 0);
        FIN(pB0, pB1, alB, mwB); SBAR();
        MNEXT(mwB); SBAR();
        pv_d0(o, vb0 + (int)SHM_V, pa0, pa1, pa2, pa3); partialSM(pA0, pA1, m_reg, mnA, alA, FAR(j + 1), bfar, tbq + (DBASE(j + 1) + 197), 0);
        RESC(alA); VMW(0); asm volatile("" : "+v"(mwB)); WGBAR();
    }
    { const int j = NT - 3, jmax = (i0 + wid * QBLK + QBLK - 1) >> 6; const bool a1 = j <= jmax, a2 = j + 1 <= jmax, a3 = j + 2 <= jmax;
      KDMA(0, (j + 1) * KVBLK); VDMA(1, j * KVBLK);
      SBAR(); if (a1) qkt(pB0, pB1, ka, qa, (int)SHM_K);
      FIN(pA0, pA1, alA, mwA); SBAR();
      MNEXT(mwA); SBAR();
      pv_d0(o, vb0, pa0, pa1, pa2, pa3);
      if (a1) { partialSM(pB0, pB1, m_reg, mnB, alB, FAR(j), bfar, tbq + (DBASE(j) + 197), 0); RESC(alB); }
      VMW(0); asm volatile("" : "+v"(mwA)); WGBAR();
      KDMA(1, (j + 2) * KVBLK); VDMA(0, (j + 1) * KVBLK);
      SBAR(); if (a2) qkt(pA0, pA1, ka, qa, 0);
      if (a1) { FIN(pB0, pB1, alB, mwB); } SBAR();
      MNEXT(mwB); SBAR();
      if (a1) pv_d0(o, vb0 + (int)SHM_V, pa0, pa1, pa2, pa3);
      if (a2) { partialSM(pA0, pA1, m_reg, mnA, alA, FAR(j + 1), bfar, tbq + (DBASE(j + 1) + 197), 0); RESC(alA); }
      VMW(0); asm volatile("" : "+v"(mwB)); WGBAR();
      VDMA(1, (NT - 1) * KVBLK);
      SBAR(); if (a3) qkt(pB0, pB1, ka, qa, (int)SHM_K);
      if (a2) { FIN(pA0, pA1, alA, mwA); SBAR(); pv_d0(o, vb0, pa0, pa1, pa2, pa3); }
      if (a3) { partialSM(pB0, pB1, m_reg, mnB, alB, FAR(NT - 1), bfar, tbq + (DBASE(NT - 1) + 197), 0); RESC(alB); }
      VMW(0); __syncthreads();
      if (a3) { FIN(pB0, pB1, alB, mwB); SBAR(); pv_d0(o, vb0 + (int)SHM_V, pa0, pa1, pa2, pa3); } }
    __syncthreads();
#undef MNEXT
#undef FIN
    if (hi == 0) li_l[r32] = l_reg; asm volatile("s_waitcnt lgkmcnt(0)" ::: "memory");
    { LAS unsigned char* osl = lds + wid * 8704;
      int le = lane; asm volatile("" : "+v"(le)); const int r32e = le & 31, hie = le >> 5;
#pragma unroll
      for (int r = 0; r < 16; ++r) { const int orow = crow(r, hie); const float rl = __builtin_amdgcn_rcpf(li_l[orow]);
#pragma unroll
          for (int d0 = 0; d0 < 4; ++d0) *(LAS bf16*)(osl + orow * 272 + (d0 * 32 + r32e) * 2) = (bf16)f2bf(o[d0][r] * rl); }
      asm volatile("s_waitcnt lgkmcnt(0)" ::: "memory");
#pragma unroll
      for (int i = 0; i < 8; ++i) { const int p = le + 64 * i, row = p >> 4, pc = p & 15; *(v4u*)(Ob + blk_off(orow0 + wid * QBLK + row, ocol0 + pc * 8, DM)) = *(const LAS v4u*)(osl + row * 272 + pc * 16); }
      asm volatile("s_waitcnt lgkmcnt(0)" ::: "memory"); }
#undef KDMA
#undef VDMA
#undef VMW
#undef WGBAR
#undef RESC
#undef FAR
#undef DBASE
#undef MLOAD
}
}
__device__ __forceinline__ void ph_attention(Frame& F) {
    const bf16* P1 = (const bf16*)(F.ws + WS_PROJ); bf16* ATT = (bf16*)(F.ws + WS_H); const unsigned* SEL = (const unsigned*)(F.ws + WS_SEL); const float* tb = (const float*)(F.ws + WS_TB);
    LAS float* tbq = (LAS float*)(F.lds + att::OFF_TB);
    for (int pi = F.vcu; pi < 1024; pi += F.G) {
        const int combo = pi >> 4, within = pi & 15, b = combo >> 2, kvh = combo & 3, hq = kvh * 4 + (within >> 2), pr = within & 3;
        for (int half = 0; half < 2; ++half) {
            const int qb = half ? 7 - pr : pr, i0 = qb * 256;
            __syncthreads();
            int t_ = threadIdx.x; asm volatile("" : "+v"(t_));
            const int d_ = t_ - 256; const float tbv = tb[(d_ < 0 ? 0 : (d_ > 127 ? 127 : d_)) * 16 + hq] * (1.0f / att::SCALE);
            const size_t tok0 = (size_t)b * SEQ;
            att::attn_unit(P1, (int)(tok0 + i0), C1_Q + hq * 128, (int)tok0, C1_K + kvh * 128, C1_V + kvh * 128,
                           ATT, (int)(tok0 + i0), hq * 128, 4 * (qb + 1), SEL + (size_t)b * 32 * SEQ * 2 + (size_t)(i0 + F.wave * 32 + (t_ & 31)) * 2, i0, F.lds, tbv);
        }
    }
}
__device__ __forceinline__ void ph_dsa_naive_sel(Frame& F) {
    LAS float* qil = (LAS float*)(F.lds);
    LAS float* wl = (LAS float*)(F.lds + 4096);
    LAS float* ql = (LAS float*)(F.lds + 8192);
    LAS unsigned* sc = (LAS unsigned*)(F.lds + 16384);
    LAS int* idxl = (LAS int*)(F.lds + 24576);
    LAS float* pl = (LAS float*)(F.lds + 25600);
    LAS float* red = (LAS float*)(F.lds + 26624);
    LAS int* cntl = (LAS int*)(F.lds + 26752);
    LAS int* wtot = (LAS int*)(F.lds + 26880);
    LAS float* op = (LAS float*)(F.lds + 28672);
    const bf16* P1 = (const bf16*)(F.ws + WS_PROJ); bf16* ATT = (bf16*)(F.ws + WS_H); const float* tb = (const float*)(F.ws + WS_TB);
    const int tid = F.tid, lane = F.lane, wave = F.wave;
    for (int unit = F.vcu; unit < MTOK; unit += F.G) {
        const int b = unit >> 11, t = unit & 2047; const bf16* P = P1 + (size_t)unit * O_INP;
        for (int i = tid; i < 1024; i += NTHR) qil[i] = bf2f(P[C1_QI + i]);
        if (tid < 16) wl[tid] = bf2f(P[C1_WI + tid]) * 0.03125f;
        for (int i = tid; i < 2048; i += NTHR) ql[i] = bf2f(P[C1_Q + i]);
        __syncthreads();
        bool sel[4];
        { const unsigned* SELr = (const unsigned*)(F.ws + WS_SEL) + (size_t)unit * 64;
#pragma unroll
          for (int j = 0; j < 4; ++j) { const int s = tid + 512 * j; sel[j] = (SELr[s >> 5] >> (s & 31)) & 1u; } }
        int pre[4];
#pragma unroll
        for (int j = 0; j < 4; ++j) { const unsigned long long bal = __ballot(sel[j]); pre[j] = __popcll(bal & ((1ull << lane) - 1ull)); if (lane == 0) wtot[j * 8 + wave] = __popcll(bal); }
        __syncthreads();
        int nsel = 0;
        { int run = 0; int base[4];
#pragma unroll
          for (int j = 0; j < 4; ++j) {
#pragma unroll
              for (int w = 0; w < 8; ++w) { if (w == wave) base[j] = run; run += wtot[j * 8 + w]; } }
          nsel = run;
#pragma unroll
          for (int j = 0; j < 4; ++j) if (sel[j]) idxl[base[j] + pre[j]] = tid + 512 * j; }
        __syncthreads();
        for (int hq = 0; hq < 16; ++hq) { const int kvh = hq >> 2;
            float logit = -INFINITY;
            if (tid < nsel) { const int s = idxl[tid]; const v4u* kp = (const v4u*)(P1 + (size_t)(b * SEQ + s) * O_INP + C1_K + kvh * 128); float d = 0.f;
#pragma unroll
                for (int q = 0; q < 16; ++q) { const v4u w = kp[q]; const f32x4 a0 = *(const LAS f32x4*)(ql + hq * 128 + 8 * q), a1 = *(const LAS f32x4*)(ql + hq * 128 + 8 * q + 4);
                    d += a0.x * __uint_as_float(w.x << 16) + a0.y * __uint_as_float(w.x & 0xffff0000u) + a0.z * __uint_as_float(w.y << 16) + a0.w * __uint_as_float(w.y & 0xffff0000u)
                       + a1.x * __uint_as_float(w.z << 16) + a1.y * __uint_as_float(w.z & 0xffff0000u) + a1.z * __uint_as_float(w.w << 16) + a1.w * __uint_as_float(w.w & 0xffff0000u); }
                const int dist = t - s; logit = d * 0.08838834764831845f + tb[(dist < 127 ? dist : 127) * 16 + hq]; }
            float mx = wave_max(logit); if (lane == 0) red[wave] = mx;
            __syncthreads();
            mx = fmaxf(fmaxf(fmaxf(red[0], red[1]), fmaxf(red[2], red[3])), fmaxf(fmaxf(red[4], red[5]), fmaxf(red[6], red[7])));
            const float p = (tid < nsel) ? __expf(logit - mx) : 0.f;
            if (tid < 256) pl[tid] = p;
            float sm = wave_sum(p); if (lane == 0) red[8 + wave] = sm;
            __syncthreads();
            sm = ((red[8] + red[9]) + (red[10] + red[11])) + ((red[12] + red[13]) + (red[14] + red[15]));
            { const int d = tid & 127, part = tid >> 7; float a = 0.f; const int j1 = (part * 64 + 64) < nsel ? (part * 64 + 64) : nsel;
              for (int j = part * 64; j < j1; ++j) a += pl[j] * bf2f(P1[(size_t)(b * SEQ + idxl[j]) * O_INP + C1_V + kvh * 128 + d]);
              op[part * 128 + d] = a; }
            __syncthreads();
            if (tid < 128) ATT[(size_t)unit * DM + hq * 128 + tid] = (bf16)f2bf(((op[tid] + op[128 + tid]) + (op[256 + tid] + op[384 + tid])) / sm);
            __syncthreads();
        }
    }
}


constexpr int N_PHASES = 15;
#ifndef PROBE_DUP
#define PROBE_DUP -1
#endif
#ifndef MIXER0
#define MIXER0 1
#endif
#ifndef DSA_ATT
#define DSA_ATT 1
#endif

__device__ __forceinline__ void nts4(float* p, f32x4 v) { __builtin_nontemporal_store(v, (f32x4*)p); }
__global__ void __launch_bounds__(NTHR, 2) mega_fwd(Args args) {
    extern __shared__ __attribute__((aligned(16))) unsigned char lds_raw[];
    Frame F;
    F.lds = (LAS unsigned char*)lds_raw;
    F.tid = threadIdx.x; F.lane = F.tid & 63; F.wave = __builtin_amdgcn_readfirstlane(F.tid >> 6);
    F.G = gridDim.x; { const int bx = blockIdx.x; F.vcu = (F.G % 8 == 0) ? (bx % 8) * (F.G / 8) + bx / 8 : bx; }
    F.ws = args.ws;
    unsigned char* ws = args.ws;
    volatile LAS unsigned* MISC = (volatile LAS unsigned*)(F.lds + MISC_OFF);
    if (F.tid < 32) ((LAS unsigned*)(F.lds + MISC_OFF))[F.tid] = 0u;
    __syncthreads();
    const int lo = args.ph_lo, hi = args.ph_hi;
    const bool multi = (hi - lo) > 1;
    XcdBarrier bar; bar.bar = (unsigned*)(ws + WS_CTL) + CW_BAR; bar.x = 0; bar.st = nullptr;
    if (multi) bar = xcd_barrier_post((unsigned*)(ws + WS_CTL) + CW_BAR, MISC + 8);
#define IN(k) (lo <= (k) && (k) < hi)
#define SEAM(k) do { if (IN(k) && IN((k) + 1)) xcd_barrier(bar); { int t_ = threadIdx.x; asm volatile("" : "+v"(t_)); F.tid = t_; F.lane = t_ & 63; } } while (0)
    float* const rss = (float*)(ws + WS_RSS); float* const rstd = (float*)(ws + WS_RSTD);
#define RSTD_PHASE(k, site) do { if (IN(k)) { int t_ = threadIdx.x; asm volatile("" : "+v"(t_));   const int gt = F.vcu * NTHR + t_; if (gt < MTOK) { const f32x4* p = (const f32x4*)(rss + (site) * RSW + (size_t)gt * 32); float s = 0.f; \
            _Pragma("unroll") for (int q = 0; q < 8; ++q) { const f32x4 v = p[q]; s += (v.x + v.y) + (v.z + v.w); } rstd[(site) * MTOK + gt] = rstd_of(s); } } SEAM(k); } while (0)
#define GEMM_PHASE_(k, ABLK, EpiT, Aptr, Wptr, N_, K_, ...) do { if (IN(k)) { pg8::Gemm g{(const bf16*)(Aptr), (const bf16*)(Wptr), MTOK, (N_), (K_)}; pg8::StaticOrder S; S.init(MTOK, (N_), F.G, (int)blockIdx.x); \
            EpiT E{__VA_ARGS__}; pg8::gemm_phase<EpiT, pg8::StaticOrder, true, true, ABLK, true>(F.lds, g, S, E); } SEAM(k); } while (0)
#define GEMM_PHASE(k, ...) GEMM_PHASE_(k, false, __VA_ARGS__)
#define GEMM_PHASE_B(k, ...) GEMM_PHASE_(k, true, __VA_ARGS__)
    if (IN(0)) p0_prologue(F, args);
    SEAM(0);
    GEMM_PHASE_B(1, EpiBf16Rs, ws + WS_XB, ws + WS_WIN0, E_IN, DM, (bf16*)(ws + WS_PROJ), E_IN, rstd);
    if (IN(2)) ph_mixer0(F, args);
    SEAM(2);
    GEMM_PHASE_B(3, EpiResMid, ws + WS_H, ws + WS_WOUT0, DM, DM, (const void*)(ws + WS_XB), (void*)(ws + WS_XB), rss + RSW, DM);
    GEMM_PHASE_B(4, EpiGuFused, ws + WS_XB, ws + WS_WGU0, GUW, DM, (bf16*)(ws + WS_ACTF), rss + RSW, args.in[17], args.in[18], (float*)(ws + WS_SIDEG), (float*)(ws + WS_SIDEU), F.lds + 131072);
    if (IN(5)) ph_ffn_fixup(F, (bf16*)(ws + WS_ACTF), (const float*)(ws + WS_SIDEG), (const float*)(ws + WS_SIDEU), args.in[17], args.in[18]);
    SEAM(5);
    GEMM_PHASE_B(6, EpiResMid, ws + WS_ACTF, ws + WS_WDN0, DM, DFF, (const void*)(ws + WS_XB), (void*)(ws + WS_XB), rss + 2 * RSW, DM);
    if (IN(7)) { pg8::Gemm g{(const bf16*)(ws + WS_XB), (const bf16*)(ws + WS_WIN1), MTOK, O_INP, DM}; pg8::StaticOrder S; S.init(MTOK, O_INP, F.G, (int)blockIdx.x);
        EpiBf16RsP E{(bf16*)(ws + WS_PROJ), O_INP, rss + 2 * RSW, F.lds}; pg8::gemm_phase<EpiBf16RsP, pg8::StaticOrder, true, true, true, true>(F.lds, g, S, E);
        drain_conv_queue(F, args, 2112, L1_I0 + L1_I1, L1_ITEMS); }
    SEAM(7);
    if (IN(8)) ph_indexer(F);
    SEAM(8);
    if (IN(9)) ph_attention(F);
    SEAM(9);
    GEMM_PHASE_B(10, EpiResMid, ws + WS_H, ws + WS_WOUT1, DM, DM, (const void*)(ws + WS_XB), (void*)(ws + WS_XB), rss + 3 * RSW, DM);
    GEMM_PHASE_B(11, EpiGuFused, ws + WS_XB, ws + WS_WGU1, GUW, DM, (bf16*)(ws + WS_ACTF), rss + 3 * RSW, args.in[17] + 3 * DFF, args.in[18] + DFF, (float*)(ws + WS_SIDEG), (float*)(ws + WS_SIDEU), F.lds + 131072);
    if (IN(12)) ph_ffn_fixup(F, (bf16*)(ws + WS_ACTF), (const float*)(ws + WS_SIDEG), (const float*)(ws + WS_SIDEU), args.in[17] + 3 * DFF, args.in[18] + DFF);
    SEAM(12);
    GEMM_PHASE_B(13, EpiResMid, ws + WS_ACTF, ws + WS_WDN1, DM, DFF, (const void*)(ws + WS_XB), (void*)(ws + WS_XB), rss + 4 * RSW, DM);
    if (IN(14)) { const int ln = (int)__builtin_amdgcn_mbcnt_hi(~0u, __builtin_amdgcn_mbcnt_lo(~0u, 0u));
        const int gw = F.vcu * NWAVES + F.wave, NGW = F.G * NWAVES; const bf16* xb_ = (const bf16*)(ws + WS_XB);
        for (int rb = gw; rb < MTOK / 16; rb += NGW) { const int row = rb * 16 + (ln >> 2); float rs;
            { const f32x4* p = (const f32x4*)(rss + 4 * RSW + (size_t)row * 32) + 2 * (ln & 3); const f32x4 a = p[0], b = p[1];
              float s = ((a.x + a.y) + (a.z + a.w)) + ((b.x + b.y) + (b.z + b.w)); s += __shfl_xor(s, 1); s += __shfl_xor(s, 2); rs = rstd_of(s); }
            const bf16* ib = xb_ + (size_t)rb * (DM / 32) * 512 + ln * 8; float* orow = args.out + (size_t)row * DM + (ln & 3) * 8; const float* gp = args.in[20] + (ln & 3) * 8;
#pragma unroll 8
            for (int cb = 0; cb < DM / 32; ++cb) { const v4u w = __builtin_nontemporal_load((const v4u*)(ib + cb * 512)); const f32x4 ga = *(const f32x4*)(gp + cb * 32), gb = *(const f32x4*)(gp + cb * 32 + 4);
                nts4(orow + cb * 32, (f32x4){__uint_as_float(w.x << 16), __uint_as_float(w.x & 0xffff0000u), __uint_as_float(w.y << 16), __uint_as_float(w.y & 0xffff0000u)} * rs * ga);
                nts4(orow + cb * 32 + 4, (f32x4){__uint_as_float(w.z << 16), __uint_as_float(w.z & 0xffff0000u), __uint_as_float(w.w << 16), __uint_as_float(w.w & 0xffff0000u)} * rs * gb); } } }
#undef IN
#undef SEAM
}

#ifndef ONE_LAUNCH
#define ONE_LAUNCH 0
#endif
extern "C" void kernel_launch(void* const* d_in, const int* in_sizes, int n_in, void* d_out, int out_size, void* d_ws, size_t ws_size, hipStream_t stream) {
    static int grid = 0;
    if (grid == 0) {
        if (n_in != 21 || in_sizes[0] != MTOK * DM || out_size != MTOK * DM || ws_size < WS_END) { fprintf(stderr, "kernel_launch: unexpected shapes (n_in %d in0 %d out %d ws %zu)\n", n_in, n_in > 0 ? in_sizes[0] : -1, out_size, ws_size); grid = -1; return; }
        int dev = 0, cus = 0, per_cu = 0;
        if (hipGetDevice(&dev) != hipSuccess || hipDeviceGetAttribute(&cus, hipDeviceAttributeMultiprocessorCount, dev) != hipSuccess) { grid = -1; return; }
        if (hipFuncSetAttribute((const void*)mega_fwd, hipFuncAttributeMaxDynamicSharedMemorySize, LDS_BYTES) != hipSuccess) { fprintf(stderr, "kernel_launch: hipFuncSetAttribute failed\n"); grid = -1; return; }
        if (hipOccupancyMaxActiveBlocksPerMultiprocessor(&per_cu, (const void*)mega_fwd, NTHR, LDS_BYTES) != hipSuccess || per_cu < 1) { fprintf(stderr, "kernel_launch: occupancy query says %d\n", per_cu); }
        (void)hipGetLastError();
        grid = cus;
    }
    if (grid < 0) return;
    (void)hipMemsetAsync((char*)d_ws + WS_CTL, 0, CTL_ZERO_BYTES, stream);
    Args a{};
    for (int i = 0; i < 21; ++i) a.in[i] = (const float*)d_in[i];
    a.out = (float*)d_out; a.ws = (unsigned char*)d_ws;
#if ONE_LAUNCH
    a.ph_lo = 0; a.ph_hi = N_PHASES;
    hipLaunchKernelGGL(mega_fwd, dim3(grid), dim3(NTHR), LDS_BYTES, stream, a);
#else
    for (int p = 0; p < N_PHASES; ++p) { a.ph_lo = p; a.ph_hi = p + 1; hipLaunchKernelGGL(mega_fwd, dim3(grid), dim3(NTHR), LDS_BYTES, stream, a); }
#endif
}
```
